# Optimizing an MI355X kernel written in HIP

```python
import jax, jax.numpy as jnp
from jax import lax
import numpy as np

D_MODEL = 1024
BATCH = 32
SEQ = 2048
DEPTH = 1

ATT_HEADS = 8
ATT_HEAD_DIM = 64
ATT_WIDTH = ATT_HEADS * ATT_HEAD_DIM
Q_BLOCK = 128
FORGET_BIAS_INIT = 3.0
RNN_WIDTH = D_MODEL
RNN_BLOCKS = 16
RNN_BLOCK_DIM = RNN_WIDTH // RNN_BLOCKS
CONV_WIDTH = 4
RGLRU_C = 8.0
N_EXPERTS = 64
TOP_K = 6
N_GROUPS = 8
TOPK_GROUPS = 4
EXPERT_FF = D_MODEL // 4
SHARED_FF = EXPERT_FF
ROUTE_SCALE = 2.5
DISPATCH_ROWS = 256
NORM_EPS = 1e-6
IN_SPLITS = (ATT_WIDTH, ATT_WIDTH, ATT_WIDTH, ATT_HEADS, RNN_WIDTH, RNN_WIDTH, D_MODEL, D_MODEL)
IN_COLS = sum(IN_SPLITS)
IN_OFFSETS = tuple(int(o) for o in np.cumsum(IN_SPLITS)[:-1])

kernel_name = 'hybrid_fox_rglru_moe_block'


def rmsnorm(x, g):
    xf = x.astype(jnp.float32)
    y = xf * lax.rsqrt(jnp.mean(xf * xf, axis=-1, keepdims=True) + NORM_EPS)
    return (y * g.astype(jnp.float32)).astype(x.dtype)


def swiglu(x, w_gate, w_up, w_down):
    return (jax.nn.silu(x @ w_gate) * (x @ w_up)) @ w_down


def forgetting_attention(q, k, v, f_logit):
    S = q.shape[1]
    log_f = jax.nn.log_sigmoid(f_logit.astype(jnp.float32))
    cum = jnp.transpose(jnp.cumsum(log_f, axis=1), (0, 2, 1))
    scale = ATT_HEAD_DIM ** -0.5
    outs = []
    for i in range(S // Q_BLOCK):
        q0, q1 = i * Q_BLOCK, (i + 1) * Q_BLOCK
        kb, vb = k[:, :q1], v[:, :q1]
        s = jnp.einsum('bqhd,bkhd->bhqk', q[:, q0:q1], kb, preferred_element_type=jnp.float32) * scale
        s = s + cum[:, :, q0:q1, None] - cum[:, :, None, :q1]
        causal = jnp.arange(q1)[None, :] <= jnp.arange(q0, q1)[:, None]
        s = jnp.where(causal, s, -jnp.inf)
        p = jax.nn.softmax(s, axis=-1)
        outs.append(jnp.einsum('bhqk,bkhd->bqhd', p.astype(v.dtype), vb))
    return jnp.concatenate(outs, axis=1)


def causal_depthwise_conv(x, w, b):
    S = x.shape[1]
    xp = jnp.pad(x, ((0, 0), (CONV_WIDTH - 1, 0), (0, 0)))
    y = b
    for j in range(CONV_WIDTH):
        y = y + w[j] * xp[:, j:j + S]
    return y


def rg_lru(u, w_rg, b_rg, w_ig, b_ig, lam):
    B, S, _ = u.shape
    ub = u.reshape(B, S, RNN_BLOCKS, RNN_BLOCK_DIM)
    r = jax.nn.sigmoid((jnp.einsum('bsni,nij->bsnj', ub, w_rg).reshape(B, S, RNN_WIDTH) + b_rg).astype(jnp.float32))
    ig = jax.nn.sigmoid((jnp.einsum('bsni,nij->bsnj', ub, w_ig).reshape(B, S, RNN_WIDTH) + b_ig).astype(jnp.float32))
    log_a = -RGLRU_C * r * jax.nn.softplus(-lam.astype(jnp.float32))
    a = jnp.exp(log_a)
    mult = jnp.sqrt(-jnp.expm1(2.0 * log_a))
    b_in = mult * ig * u.astype(jnp.float32)

    def combine(left, right):
        a1, b1 = left
        a2, b2 = right
        return a1 * a2, a2 * b1 + b2

    _, h = lax.associative_scan(combine, (a, b_in), axis=1)
    return h.astype(u.dtype)


def route(h_flat, w_router, router_bias):
    T = h_flat.shape[0]
    scores = jax.nn.sigmoid(h_flat.astype(jnp.float32) @ w_router.astype(jnp.float32))
    sel = scores + router_bias.astype(jnp.float32)
    grp = sel.reshape(T, N_GROUPS, N_EXPERTS // N_GROUPS)
    grp_score = lax.top_k(grp, 2)[0].sum(-1)
    _, gidx = lax.top_k(grp_score, TOPK_GROUPS)
    gmask = jnp.any(gidx[..., None] == jnp.arange(N_GROUPS)[None, None, :], axis=1)
    emask = jnp.repeat(gmask, N_EXPERTS // N_GROUPS, axis=1)
    _, eidx = lax.top_k(jnp.where(emask, sel, -jnp.inf), TOP_K)
    w = jnp.take_along_axis(scores, eidx, axis=-1)
    w = w / jnp.sum(w, axis=-1, keepdims=True) * ROUTE_SCALE
    return eidx.astype(jnp.int32), w


def routed_experts(h_flat, eidx, ew, w_gate, w_up, w_down):
    T, D = h_flat.shape
    P = T * TOP_K
    C = DISPATCH_ROWS
    n_blocks = -(-P // C) + N_EXPERTS
    flat_e = eidx.reshape(-1)
    flat_tok = jnp.repeat(jnp.arange(T, dtype=jnp.int32), TOP_K)
    flat_w = ew.reshape(-1)
    order = jnp.argsort(flat_e)
    se, stok, sw = flat_e[order], flat_tok[order], flat_w[order]
    counts = jnp.bincount(flat_e, length=N_EXPERTS).astype(jnp.int32)
    start = jnp.cumsum(counts) - counts
    padded = ((counts + C - 1) // C) * C
    pend = jnp.cumsum(padded)
    pstart = pend - padded
    dest = pstart[se] + (jnp.arange(P, dtype=jnp.int32) - start[se])
    buf_tok = jnp.full((n_blocks * C,), T, jnp.int32).at[dest].set(stok)
    buf_w = jnp.zeros((n_blocks * C,), jnp.float32).at[dest].set(sw)
    block_e = jnp.minimum(jnp.searchsorted(pend, jnp.arange(n_blocks, dtype=jnp.int32) * C, side='right'),
                          N_EXPERTS - 1).astype(jnp.int32)
    h_pad = jnp.concatenate([h_flat, jnp.zeros((1, D), h_flat.dtype)], axis=0)

    def expert_block(args):
        tok, wt, e = args
        y = swiglu(h_pad[tok], w_gate[e], w_up[e], w_down[e])
        return y * wt[:, None].astype(y.dtype)

    y_buf = lax.map(expert_block, (buf_tok.reshape(n_blocks, C), buf_w.reshape(n_blocks, C), block_e))
    return jax.ops.segment_sum(y_buf.reshape(-1, D), buf_tok, num_segments=T + 1)[:T]


def setup_inputs(seed: int = 0) -> dict:
    key = jax.random.key(seed)
    ks = jax.random.split(key, 28)
    f32 = jnp.float32
    L, D = DEPTH, D_MODEL

    def nrm(k, shape, scale):
        return jax.random.normal(k, shape, f32) * scale

    a0 = jax.random.uniform(ks[16], (L, RNN_WIDTH), f32, 0.9, 0.999)
    return {
        'x': nrm(ks[0], (BATCH, SEQ, D), 1.0),
        'c': nrm(ks[1], (BATCH, D), 1.0),
        'w_ada': nrm(ks[2], (L, D, 6 * D), 0.5 * D ** -0.5),
        'b_ada': nrm(ks[3], (L, 6 * D), 0.02),
        'g_pre_mix': 1.0 + nrm(ks[4], (L, D), 0.1),
        'g_post_mix': 1.0 + nrm(ks[5], (L, D), 0.1),
        'g_pre_ffn': 1.0 + nrm(ks[6], (L, D), 0.1),
        'g_post_ffn': 1.0 + nrm(ks[7], (L, D), 0.1),
        'w_in': nrm(ks[8], (L, D, IN_COLS), D ** -0.5),
        'b_forget': FORGET_BIAS_INIT + nrm(ks[9], (L, ATT_HEADS), 0.5),
        'w_conv': nrm(ks[10], (L, CONV_WIDTH, RNN_WIDTH), CONV_WIDTH ** -0.5),
        'b_conv': nrm(ks[11], (L, RNN_WIDTH), 0.02),
        'w_rg': nrm(ks[12], (L, RNN_BLOCKS, RNN_BLOCK_DIM, RNN_BLOCK_DIM), RNN_BLOCK_DIM ** -0.5),
        'b_rg': nrm(ks[13], (L, RNN_WIDTH), 0.02),
        'w_ig': nrm(ks[14], (L, RNN_BLOCKS, RNN_BLOCK_DIM, RNN_BLOCK_DIM), RNN_BLOCK_DIM ** -0.5),
        'b_ig': nrm(ks[15], (L, RNN_WIDTH), 0.02),
        'rglru_lambda': jnp.log(a0) - jnp.log1p(-a0),
        'w_branch_attn': nrm(ks[17], (L, ATT_WIDTH, D), ATT_WIDTH ** -0.5),
        'w_branch_rnn': nrm(ks[18], (L, RNN_WIDTH, D), RNN_WIDTH ** -0.5),
        'w_out': nrm(ks[19], (L, D, D), D ** -0.5),
        'w_router': nrm(ks[20], (L, D, N_EXPERTS), D ** -0.5),
        'router_bias': nrm(ks[21], (L, N_EXPERTS), 0.01),
        'w_exp_gate': nrm(ks[22], (L, N_EXPERTS, D, EXPERT_FF), D ** -0.5),
        'w_exp_up': nrm(ks[23], (L, N_EXPERTS, D, EXPERT_FF), D ** -0.5),
        'w_exp_down': nrm(ks[24], (L, N_EXPERTS, EXPERT_FF, D), EXPERT_FF ** -0.5),
        'w_sh_gate': nrm(ks[25], (L, D, SHARED_FF), D ** -0.5),
        'w_sh_up': nrm(ks[26], (L, D, SHARED_FF), D ** -0.5),
        'w_sh_down': nrm(ks[27], (L, SHARED_FF, D), SHARED_FF ** -0.5),
    }


def reference(x, c, w_ada, b_ada, g_pre_mix, g_post_mix, g_pre_ffn, g_post_ffn, w_in, b_forget,
              w_conv, b_conv, w_rg, b_rg, w_ig, b_ig, rglru_lambda, w_branch_attn, w_branch_rnn, w_out,
              w_router, router_bias, w_exp_gate, w_exp_up, w_exp_down, w_sh_gate, w_sh_up, w_sh_down):
    B, S, _ = x.shape
    for l in range(DEPTH):
        mod = jax.nn.silu(c) @ w_ada[l] + b_ada[l]
        shift_m, scale_m, gate_m, shift_f, scale_f, gate_f = jnp.split(mod[:, None, :], 6, axis=-1)

        h = rmsnorm(x, g_pre_mix[l]) * (1.0 + scale_m) + shift_m
        proj = h @ w_in[l]
        q, k, v, f_logit, x_rnn, g_rnn, gate_a, gate_r = jnp.split(proj, IN_OFFSETS, axis=-1)
        y_attn = forgetting_attention(q.reshape(B, S, ATT_HEADS, ATT_HEAD_DIM),
                                      k.reshape(B, S, ATT_HEADS, ATT_HEAD_DIM),
                                      v.reshape(B, S, ATT_HEADS, ATT_HEAD_DIM),
                                      f_logit + b_forget[l]).reshape(B, S, ATT_WIDTH)
        u = causal_depthwise_conv(x_rnn, w_conv[l], b_conv[l])
        y_rnn = rg_lru(u, w_rg[l], b_rg[l], w_ig[l], b_ig[l], rglru_lambda[l]) * jax.nn.gelu(g_rnn)
        merged = (jax.nn.sigmoid(gate_a) * (y_attn @ w_branch_attn[l])
                  + jax.nn.sigmoid(gate_r) * (y_rnn @ w_branch_rnn[l]))
        x = x + gate_m * rmsnorm(merged @ w_out[l], g_post_mix[l])

        h = rmsnorm(x, g_pre_ffn[l]) * (1.0 + scale_f) + shift_f
        h_flat = h.reshape(B * S, D_MODEL)
        eidx, ew = route(h_flat, w_router[l], router_bias[l])
        routed = routed_experts(h_flat, eidx, ew, w_exp_gate[l], w_exp_up[l], w_exp_down[l])
        shared = swiglu(h_flat, w_sh_gate[l], w_sh_up[l], w_sh_down[l])
        x = x + gate_f * rmsnorm((routed + shared).reshape(B, S, D_MODEL), g_post_ffn[l])
    return x
```

```cpp
#include <hip/hip_runtime.h>
#include <cstdio>
#include <cstdint>

#ifndef MK_N_LAUNCHES
#define MK_N_LAUNCHES 13
#endif

#define LAS __attribute__((address_space(3)))
#define GAS __attribute__((address_space(1)))
typedef unsigned short bf16_t;
typedef short bf16x8 __attribute__((ext_vector_type(8)));
typedef short s16x4 __attribute__((ext_vector_type(4)));
typedef float f32x4 __attribute__((ext_vector_type(4)));
typedef float f32x2 __attribute__((ext_vector_type(2)));
typedef float f32x16 __attribute__((ext_vector_type(16)));
typedef unsigned u32x4 __attribute__((ext_vector_type(4)));
typedef unsigned u32x2 __attribute__((ext_vector_type(2)));
typedef GAS unsigned gu32;

constexpr int T = 65536, D = 1024, NBATCH = 32, SEQ = 2048, NHEAD = 8, HD = 64;
constexpr int NIN = 5632;
constexpr int INCOLS = 5640;
constexpr int NEXP = 64, TOPK = 6, EFF = 256;
constexpr int RT_MAX = 832;
constexpr int SH_TILES = 128;
constexpr int RND_TILES = RT_MAX + SH_TILES;
constexpr int HALF_T = T / 2;
constexpr float NORM_EPS = 1e-6f;
constexpr float LOG2E = 1.4426950408889634f;
constexpr float QSCALE = 0.125f * LOG2E;

constexpr size_t MiB = 1u << 20, KiB = 1u << 10;
constexpr size_t WS_CTL = 0, CTL_ZERO_BYTES = 1 * MiB;
constexpr size_t WS_MOD = 1 * MiB;
constexpr size_t WS_TOT = 1 * MiB + 768 * KiB;
constexpr size_t WS_HIST = 2 * MiB;
constexpr size_t WS_RTAB = 2 * MiB + 64 * KiB;
constexpr size_t WS_LCUM = 3 * MiB;
constexpr size_t WS_SSQ = 5 * MiB;
constexpr size_t WS_EP = 9 * MiB;
constexpr size_t WS_EW = 11 * MiB;
constexpr size_t WS_POS = 13 * MiB;
constexpr size_t WS_SLOTTOK = 15 * MiB;
constexpr size_t WS_WF = 17 * MiB;
constexpr size_t WS_WRNN = 17 * MiB + 64 * KiB;
constexpr size_t WS_WROUT = 17 * MiB + 512 * KiB;
constexpr size_t WS_WIN = 18 * MiB;
constexpr size_t WS_WBA = 29 * MiB;
constexpr size_t WS_WBR = 30 * MiB;
constexpr size_t WS_WOUT = 32 * MiB;
constexpr size_t WS_WGU = 34 * MiB;
constexpr size_t WS_WDN = 99 * MiB;
constexpr size_t R_H = 144 * MiB;
constexpr size_t R_QKV = 272 * MiB;
constexpr size_t R_XG = 464 * MiB;
constexpr size_t R_GT = 720 * MiB;
constexpr size_t R_ACT = 272 * MiB;
constexpr size_t R_Y = 392 * MiB;
constexpr size_t WS_END = 976 * MiB;
static_assert(WS_WDN + (size_t)65 * 1024 * 256 * 2 <= R_H, "weights fit");
static_assert(R_Y + (size_t)RND_TILES * 256 * 1024 * 2 <= WS_END, "y fits");
static_assert(R_ACT + (size_t)RND_TILES * 256 * 256 * 2 <= R_Y, "act fits");

constexpr int CW_TMO = 0, CW_CODE = 1;
constexpr int CW_BAR = 4096;

constexpr int RING_BYTES = 131072;
constexpr int LDSCTL_OFF = RING_BYTES;
constexpr int MISC_OFF = LDSCTL_OFF + 320;
constexpr int TOK_OFF = RING_BYTES + 1024;
constexpr int LDS_BYTES = RING_BYTES + 1024 + 16384;
constexpr int NWAVES = 8;

#define RLX_AGENT __ATOMIC_RELAXED, __HIP_MEMORY_SCOPE_AGENT
#define LDS_WAIT() asm volatile("s_waitcnt lgkmcnt(0)" ::: "memory")
#define VM_WAIT() asm volatile("s_waitcnt vmcnt(0)" ::: "memory")

__device__ __forceinline__ unsigned f2bf(float f) { unsigned u = __builtin_bit_cast(unsigned, f); return (u + 0x7fffu + ((u >> 16) & 1u)) >> 16; }
__device__ __forceinline__ unsigned pk2(float lo, float hi) { return f2bf(lo) | (f2bf(hi) << 16); }
__device__ __forceinline__ float bf2f(unsigned short b) { return __builtin_bit_cast(float, (unsigned)b << 16); }
__device__ __forceinline__ float bflo(unsigned w) { return __builtin_bit_cast(float, w << 16); }
__device__ __forceinline__ float bfhi(unsigned w) { return __builtin_bit_cast(float, w & 0xffff0000u); }
__device__ __forceinline__ float fast_exp2(float x) { return __builtin_amdgcn_exp2f(x); }
__device__ __forceinline__ float fast_rcp(float x) { return __builtin_amdgcn_rcpf(x); }
__device__ __forceinline__ float sigmoidf_(float x) { return fast_rcp(1.0f + fast_exp2(-x * LOG2E)); }
__device__ __forceinline__ float wave_sum(float v) {
#pragma unroll
    for (int o = 1; o < 64; o <<= 1) v += __shfl_xor(v, o);
    return v;
}

namespace pg8 {
constexpr int BM = 256, BK = 64, HALF = 128, HTB = HALF * BK * 2, STAGE_BYTES = 8 * HTB;
__host__ __device__ __forceinline__ int lds_byte(int r, int c) { const int st = (r >> 4) * 2 + (c >> 5), rr = r & 15, cc = c & 31, ob = rr * 64 + cc * 2; return st * 1024 + (ob ^ (((ob >> 9) & 1) << 5)); }
__host__ __device__ __forceinline__ void stage_rc(int b, int& R, int& C) { const int st = b / 1024, sb = b % 1024, swz = sb ^ (((sb >> 9) & 1) << 5); R = (st >> 1) * 16 + swz / 64; C = (st & 1) * 32 + (swz % 64) / 2; }
__host__ __device__ __forceinline__ int perm32(int rho) { const int n = rho >> 4, i = rho & 15; return 8 * (i >> 2) + 4 * n + (i & 3); }

struct Unit { int pm, pn, e, aux; };

__device__ __forceinline__ unsigned cvt_pk_bf16(float lo, float hi) { unsigned r; asm volatile("v_cvt_pk_bf16_f32 %0, %1, %2" : "=v"(r) : "v"(lo), "v"(hi)); return r; }

template <class Epi, class Sched, bool GATHER>
__device__ __forceinline__ void gemm_phase(LAS unsigned char* lds, const int K, const int lda, const int ldb, const Sched& S, const Epi& E, const LAS int* tokLDS) {
    const int tid = threadIdx.x, wid = __builtin_amdgcn_readfirstlane(tid >> 6), lane = tid & 63, wr = wid >> 2, wc = wid & 3, fr = lane & 15, fq = lane >> 4;
    const int nt = K / BK;
    int Rr[2], Cc[2];
    unsigned voffB[2];
#pragma unroll
    for (int i = 0; i < 2; ++i) { int R, C; stage_rc(tid * 16 + i * 8192, R, C); Rr[i] = R; Cc[i] = C; const int Rb = (R & ~31) + perm32(R & 31); voffB[i] = (unsigned)(Rb * ldb + C) * 2u; }
    const size_t kstep = (size_t)(BK * 2);
    const size_t hstepB = (size_t)HALF * ldb * 2;
    const unsigned ldsw = (unsigned)wid * 1024u;
    const int aoff = lds_byte(wr * 64 + fr, fq * 8), boff = lds_byte(wc * 32 + fr, fq * 8);
#define PG8_SA(b, h) (((b) * 2 + (h)) * HTB)
#define PG8_SB(b, h) ((4 + (b) * 2 + (h)) * HTB)
#define PG8_STAGE2(bufoff, gbase, v0, v1) do { \
        __builtin_amdgcn_global_load_lds((const unsigned*)((const char*)(gbase) + (v0)), (LAS unsigned*)(lds + (bufoff) + ldsw), 16, 0, 0); \
        __builtin_amdgcn_global_load_lds((const unsigned*)((const char*)(gbase) + (v1)), (LAS unsigned*)(lds + (bufoff) + ldsw + 8192), 16, 0, 0); } while (0)
#define PG8_STAGEB(bufoff, gbase) PG8_STAGE2(bufoff, gbase, voffB[0], voffB[1])
#define PG8_LDA(dst, b, h) do { _Pragma("unroll") for (int m = 0; m < 4; ++m) _Pragma("unroll") for (int k = 0; k < 2; ++k) dst[m][k] = *(const LAS bf16x8*)(lds + PG8_SA(b, h) + aoff + m * 2048 + k * 1024); } while (0)
#define PG8_LDB(dst, b, h) do { _Pragma("unroll") for (int n = 0; n < 2; ++n) _Pragma("unroll") for (int k = 0; k < 2; ++k) dst[n][k] = *(const LAS bf16x8*)(lds + PG8_SB(b, h) + boff + n * 2048 + k * 1024); } while (0)
#define PG8_MMA(ai, bj, At, Bt) do { __builtin_amdgcn_s_setprio(1); _Pragma("unroll") for (int m = 0; m < 4; ++m) _Pragma("unroll") for (int n = 0; n < 2; ++n) _Pragma("unroll") for (int k = 0; k < 2; ++k) \
        acc[ai][bj][m][n] = __builtin_amdgcn_mfma_f32_16x16x32_bf16(Bt[n][k], At[m][k], acc[ai][bj][m][n], 0, 0, 0); __builtin_amdgcn_s_setprio(0); } while (0)
#define PG8_WAIT_V(n) asm volatile("s_waitcnt vmcnt(" #n ")" ::: "memory")
#define PG8_WAIT_L(n) asm volatile("s_waitcnt lgkmcnt(" #n ")" ::: "memory")
#define PG8_BAR __builtin_amdgcn_s_barrier()
#define PG8_SCHED __builtin_amdgcn_sched_barrier(0)
    Unit cur, nxt; int ui = 0;
    if (!S.next(0, cur)) return;
    unsigned vA0[2], vA1[2], nA0[2], nA1[2];
#pragma unroll
    for (int i = 0; i < 2; ++i) {
        if constexpr (GATHER) { vA0[i] = (unsigned)(tokLDS[Rr[i]] * lda + Cc[i]) * 2u; vA1[i] = (unsigned)(tokLDS[HALF + Rr[i]] * lda + Cc[i]) * 2u; }
        else { vA0[i] = (unsigned)(Rr[i] * lda + Cc[i]) * 2u; vA1[i] = (unsigned)((HALF + Rr[i]) * lda + Cc[i]) * 2u; }
        nA0[i] = vA0[i]; nA1[i] = vA1[i];
    }
    f32x4 acc[2][2][4][2];
#pragma unroll
    for (int a = 0; a < 2; ++a)
#pragma unroll
        for (int b = 0; b < 2; ++b)
#pragma unroll
            for (int m = 0; m < 4; ++m)
#pragma unroll
                for (int n = 0; n < 2; ++n) acc[a][b][m][n] = (f32x4){0.f, 0.f, 0.f, 0.f};
    bf16x8 At[4][2], B0[2][2], B1[2][2];
    const char* cA = S.aptr(cur); const char* cB = S.bptr(cur);
    PG8_STAGEB(PG8_SB(0, 0), cB); PG8_STAGEB(PG8_SB(0, 1), cB + hstepB); PG8_STAGE2(PG8_SA(0, 0), cA, vA0[0], vA0[1]); PG8_STAGE2(PG8_SA(0, 1), cA, vA1[0], vA1[1]);
    if (wr == 1) PG8_BAR;
    PG8_WAIT_V(2); PG8_BAR;
    PG8_STAGEB(PG8_SB(1, 0), cB + kstep); PG8_STAGE2(PG8_SA(1, 0), cA + kstep, vA0[0], vA0[1]); PG8_STAGEB(PG8_SB(1, 1), cB + hstepB + kstep);
    PG8_WAIT_V(6); PG8_BAR;
    for (;;) {
        const bool has_next = S.next(ui + 1, nxt);
        const char* nAp = has_next ? S.aptr(nxt) : cA; const char* nBp = has_next ? S.bptr(nxt) : cB;
        if constexpr (GATHER) {
            if (has_next) {
#pragma unroll
                for (int i = 0; i < 2; ++i) { nA0[i] = (unsigned)(tokLDS[(ui + 1) * 256 + Rr[i]] * lda + Cc[i]) * 2u; nA1[i] = (unsigned)(tokLDS[(ui + 1) * 256 + HALF + Rr[i]] * lda + Cc[i]) * 2u; }
            } else {
#pragma unroll
                for (int i = 0; i < 2; ++i) { nA0[i] = vA0[i]; nA1[i] = vA1[i]; }
            }
        }
        for (int t = 0; t < nt; t += 2) {
            const bool last = (t == nt - 2);
            const char* a1 = cA + (size_t)(t + 1) * kstep;
            const char* a2 = last ? nAp : cA + (size_t)(t + 2) * kstep; const char* b2 = last ? nBp : cB + (size_t)(t + 2) * kstep;
            const char* a3 = a2 + kstep; const char* b3 = b2 + kstep;
            unsigned w0[2], w1[2];
#pragma unroll
            for (int i = 0; i < 2; ++i) { w0[i] = (GATHER && last) ? nA0[i] : vA0[i]; w1[i] = (GATHER && last) ? nA1[i] : vA1[i]; }
            PG8_LDB(B0, 0, 0); PG8_LDB(B1, 0, 1); PG8_SCHED; PG8_LDA(At, 0, 0); PG8_STAGE2(PG8_SA(1, 1), a1, vA1[0], vA1[1]);
            PG8_WAIT_V(8); PG8_WAIT_L(0); PG8_BAR; PG8_MMA(0, 0, At, B0); PG8_MMA(0, 1, At, B1); PG8_BAR; PG8_SCHED;
            PG8_LDA(At, 0, 1); PG8_STAGEB(PG8_SB(0, 0), b2); PG8_STAGEB(PG8_SB(0, 1), b2 + hstepB); PG8_STAGE2(PG8_SA(0, 0), a2, w0[0], w0[1]);
            PG8_WAIT_V(8); PG8_WAIT_L(0); PG8_BAR; PG8_MMA(1, 0, At, B0); PG8_MMA(1, 1, At, B1); PG8_BAR; PG8_SCHED;
            PG8_LDB(B0, 1, 0); PG8_LDB(B1, 1, 1); PG8_SCHED; PG8_LDA(At, 1, 0); PG8_STAGE2(PG8_SA(0, 1), a2, w1[0], w1[1]);
            PG8_WAIT_V(8); PG8_WAIT_L(0); PG8_BAR; PG8_MMA(0, 0, At, B0); PG8_MMA(0, 1, At, B1); PG8_BAR; PG8_SCHED;
            PG8_LDA(At, 1, 1); PG8_STAGEB(PG8_SB(1, 0), b3); PG8_STAGEB(PG8_SB(1, 1), b3 + hstepB); PG8_STAGE2(PG8_SA(1, 0), a3, w0[0], w0[1]);
            PG8_WAIT_V(8); PG8_WAIT_L(0); PG8_BAR; PG8_MMA(1, 0, At, B0); PG8_MMA(1, 1, At, B1); PG8_BAR; PG8_SCHED;
        }
        if (wr == 0) PG8_BAR;
        E(acc, cur, wr, wc, fr, fq);
        if (!has_next) break;
#pragma unroll
        for (int a = 0; a < 2; ++a)
#pragma unroll
            for (int b = 0; b < 2; ++b)
#pragma unroll
                for (int m = 0; m < 4; ++m)
#pragma unroll
                    for (int n = 0; n < 2; ++n) acc[a][b][m][n] = (f32x4){0.f, 0.f, 0.f, 0.f};
        cur = nxt; cA = nAp; cB = nBp; ++ui;
        if constexpr (GATHER) {
#pragma unroll
            for (int i = 0; i < 2; ++i) { vA0[i] = nA0[i]; vA1[i] = nA1[i]; }
        }
        if (wr == 1) PG8_BAR;
    }
    PG8_WAIT_V(0);
    PG8_BAR;
#undef PG8_SA
#undef PG8_SB
#undef PG8_STAGE2
#undef PG8_STAGEB
#undef PG8_LDA
#undef PG8_LDB
#undef PG8_MMA
#undef PG8_WAIT_V
#undef PG8_WAIT_L
#undef PG8_BAR
#undef PG8_SCHED
}
}

struct DenseSched {
    int nM, nN, nwg, G, c; const char* A; const char* B; size_t atile, btile;
    __device__ __forceinline__ void init(int M, int N, int G_, int c_, const void* A_, int lda, const void* B_, int ldb) {
        nM = M / 256; nN = N / 256; nwg = nM * nN; G = G_; c = c_; A = (const char*)A_; B = (const char*)B_; atile = (size_t)256 * lda * 2; btile = (size_t)256 * ldb * 2; }
    __device__ __forceinline__ bool next(int i, pg8::Unit& u) const {
        const long L = (long)i * G + c; if (L >= nwg) return false;
        int wgid = (int)L; { const int q = nwg / 8, r = nwg % 8, xcd = wgid % 8, off = wgid / 8; wgid = (xcd < r ? xcd * (q + 1) : r * (q + 1) + (xcd - r) * q) + off; }
        const int nig = 8 * nN, gid = wgid / nig, fm = gid * 8, gsz = (nM - fm) < 8 ? (nM - fm) : 8;
        u.pm = fm + ((wgid % nig) % gsz); u.pn = (wgid % nig) / gsz; u.e = 0; u.aux = 0; return true;
    }
    __device__ __forceinline__ const char* aptr(const pg8::Unit& u) const { return A + (size_t)u.pm * atile; }
    __device__ __forceinline__ const char* bptr(const pg8::Unit& u) const { return B + (size_t)u.pn * btile; }
};

struct MoeSched {
    const LAS int* tab;
    int NT, U, G, vcu, npn, lg; const char* A; const char* B; size_t atile, btile_e, btile_n;
    __device__ __forceinline__ bool next(int i, pg8::Unit& u) const {
        const int id = i * G + vcu; if (id >= U) return false;
        const int ri = id >> lg; u.pn = id & (npn - 1);
        if (ri < NT) { int e = 0;
#pragma unroll 8
            for (int j = 1; j <= 64; ++j) e += (tab[j] <= ri) ? 1 : 0;
            u.e = e; u.pm = ri; u.aux = 1; }
        else { u.e = 64; u.pm = RT_MAX + (ri - NT); u.aux = 0; }
        return true;
    }
    __device__ __forceinline__ const char* aptr(const pg8::Unit& u) const { return A + (size_t)u.pm * atile; }
    __device__ __forceinline__ const char* bptr(const pg8::Unit& u) const { return B + (size_t)u.e * btile_e + (size_t)u.pn * btile_n; }
};

#define EPI_ARGS const f32x4 (&acc)[2][2][4][2], const pg8::Unit& u, int wr, int wc, int fr, int fq
struct EpiInProj {
    bf16_t* qkv; bf16_t* xg; bf16_t* gt;
    __device__ __forceinline__ void operator()(EPI_ARGS) const {
        bf16_t* base; int ld, colt; float sc = 1.f;
        if (u.pn < 6) { base = qkv; ld = 1536; colt = u.pn * 256; if (u.pn < 2) sc = QSCALE; }
        else if (u.pn < 14) { base = xg; ld = 2048; colt = (u.pn - 6) * 256; }
        else { base = gt; ld = 2048; colt = (u.pn - 14) * 256; }
        const int row0 = u.pm * 256 + wr * 64 + fr, col0 = colt + wc * 32 + 8 * fq;
#pragma unroll
        for (int ai = 0; ai < 2; ++ai)
#pragma unroll
            for (int m = 0; m < 4; ++m) { bf16_t* rowp = base + (size_t)(row0 + ai * 128 + m * 16) * ld + col0;
#pragma unroll
                for (int bj = 0; bj < 2; ++bj) { const f32x4 v0 = acc[ai][bj][m][0] * sc, v1 = acc[ai][bj][m][1] * sc;
                    u32x4 w; w.x = pg8::cvt_pk_bf16(v0[0], v0[1]); w.y = pg8::cvt_pk_bf16(v0[2], v0[3]); w.z = pg8::cvt_pk_bf16(v1[0], v1[1]); w.w = pg8::cvt_pk_bf16(v1[2], v1[3]);
                    *(u32x4*)(rowp + bj * 128) = w; } }
    }
};
template <int MODE> struct EpiBranch {
    const bf16_t* gate; int ldg; bf16_t* mg; int ldm;
    __device__ __forceinline__ void operator()(EPI_ARGS) const {
        const int row0 = u.pm * 256 + wr * 64 + fr, col0 = u.pn * 256 + wc * 32 + 8 * fq;
#pragma unroll
        for (int ai = 0; ai < 2; ++ai)
#pragma unroll
            for (int m = 0; m < 4; ++m) { const size_t r = (size_t)(row0 + ai * 128 + m * 16);
#pragma unroll
                for (int bj = 0; bj < 2; ++bj) {
                    const u32x4 g = *(const u32x4*)(gate + r * ldg + col0 + bj * 128);
                    bf16_t* mp = mg + r * ldm + col0 + bj * 128;
                    f32x4 v0 = acc[ai][bj][m][0], v1 = acc[ai][bj][m][1];
                    v0[0] *= sigmoidf_(bflo(g.x)); v0[1] *= sigmoidf_(bfhi(g.x)); v0[2] *= sigmoidf_(bflo(g.y)); v0[3] *= sigmoidf_(bfhi(g.y));
                    v1[0] *= sigmoidf_(bflo(g.z)); v1[1] *= sigmoidf_(bfhi(g.z)); v1[2] *= sigmoidf_(bflo(g.w)); v1[3] *= sigmoidf_(bfhi(g.w));
                    if (MODE == 1) { const u32x4 o = *(const u32x4*)mp;
                        v0[0] += bflo(o.x); v0[1] += bfhi(o.x); v0[2] += bflo(o.y); v0[3] += bfhi(o.y); v1[0] += bflo(o.z); v1[1] += bfhi(o.z); v1[2] += bflo(o.w); v1[3] += bfhi(o.w); }
                    u32x4 w; w.x = pg8::cvt_pk_bf16(v0[0], v0[1]); w.y = pg8::cvt_pk_bf16(v0[2], v0[3]); w.z = pg8::cvt_pk_bf16(v1[0], v1[1]); w.w = pg8::cvt_pk_bf16(v1[2], v1[3]);
                    *(u32x4*)mp = w; } }
    }
};
struct EpiOut {
    bf16_t* mo; float* ssq;
    __device__ __forceinline__ void operator()(EPI_ARGS) const {
        const int row0 = u.pm * 256 + wr * 64 + fr, col0 = u.pn * 256 + wc * 32 + 8 * fq;
#pragma unroll
        for (int ai = 0; ai < 2; ++ai)
#pragma unroll
            for (int m = 0; m < 4; ++m) { const size_t r = (size_t)(row0 + ai * 128 + m * 16); float s = 0.f;
#pragma unroll
                for (int bj = 0; bj < 2; ++bj) { const f32x4 v0 = acc[ai][bj][m][0], v1 = acc[ai][bj][m][1];
                    s += (v0[0] * v0[0] + v0[1] * v0[1]) + (v0[2] * v0[2] + v0[3] * v0[3]) + (v1[0] * v1[0] + v1[1] * v1[1]) + (v1[2] * v1[2] + v1[3] * v1[3]);
                    u32x4 w; w.x = pg8::cvt_pk_bf16(v0[0], v0[1]); w.y = pg8::cvt_pk_bf16(v0[2], v0[3]); w.z = pg8::cvt_pk_bf16(v1[0], v1[1]); w.w = pg8::cvt_pk_bf16(v1[2], v1[3]);
                    *(u32x4*)(mo + r * 1024 + col0 + bj * 128) = w; }
                s += __shfl_xor(s, 16); s += __shfl_xor(s, 32);
                if (fq == 0) ssq[r * 16 + u.pn * 4 + wc] = s; }
    }
};
struct EpiGateUp {
    bf16_t* act;
    __device__ __forceinline__ void operator()(EPI_ARGS) const {
        const int row0 = u.pm * 256 + wr * 64 + fr, col0 = u.pn * 128 + wc * 32 + 8 * fq;
#pragma unroll
        for (int ai = 0; ai < 2; ++ai)
#pragma unroll
            for (int m = 0; m < 4; ++m) { const size_t r = (size_t)(row0 + ai * 128 + m * 16);
                float v[8];
#pragma unroll
                for (int n = 0; n < 2; ++n)
#pragma unroll
                    for (int e = 0; e < 4; ++e) { const float g = acc[ai][0][m][n][e], up = acc[ai][1][m][n][e]; v[n * 4 + e] = g * sigmoidf_(g) * up; }
                u32x4 w; w.x = pg8::cvt_pk_bf16(v[0], v[1]); w.y = pg8::cvt_pk_bf16(v[2], v[3]); w.z = pg8::cvt_pk_bf16(v[4], v[5]); w.w = pg8::cvt_pk_bf16(v[6], v[7]);
                *(u32x4*)(act + r * 256 + col0) = w; }
    }
};
struct EpiDown {
    bf16_t* y;
    __device__ __forceinline__ void operator()(EPI_ARGS) const {
        const int row0 = u.pm * 256 + wr * 64 + fr, col0 = u.pn * 256 + wc * 32 + 8 * fq;
#pragma unroll
        for (int ai = 0; ai < 2; ++ai)
#pragma unroll
            for (int m = 0; m < 4; ++m) { bf16_t* rowp = y + (size_t)(row0 + ai * 128 + m * 16) * 1024 + col0;
#pragma unroll
                for (int bj = 0; bj < 2; ++bj) { const f32x4 v0 = acc[ai][bj][m][0], v1 = acc[ai][bj][m][1];
                    u32x4 w; w.x = pg8::cvt_pk_bf16(v0[0], v0[1]); w.y = pg8::cvt_pk_bf16(v0[2], v0[3]); w.z = pg8::cvt_pk_bf16(v1[0], v1[1]); w.w = pg8::cvt_pk_bf16(v1[2], v1[3]);
                    *(u32x4*)(rowp + bj * 128) = w; } }
    }
};

namespace att {
constexpr int PITCH = 1536, QB = 256, KVBLK = 64, SLOTB = 8192;
constexpr int L_K = 0, L_V = 2 * SLOTB, L_WS = 4 * SLOTB, L_CUM = L_WS + 8 * 64 * 4, L_OST = L_CUM + SEQ * 4, L_END = L_OST + 8 * 4096;
static_assert(L_END <= RING_BYTES, "attention LDS");
__device__ __forceinline__ int crow(int r, int hi) { return (r & 3) + 8 * (r >> 2) + 4 * hi; }
__device__ __forceinline__ void glds16(const void* gsrc, unsigned lds_dst) { unsigned keep;
    asm volatile("s_mov_b32 %0, m0\n\ts_mov_b32 m0, %2\n\ts_nop 0\n\tglobal_load_lds_dwordx4 %1, off\n\ts_mov_b32 m0, %0" : "=&s"(keep) : "v"(gsrc), "s"(lds_dst) : "memory"); }
__device__ __forceinline__ unsigned cvtpk(float lo, float hi) { unsigned r; asm volatile("v_cvt_pk_bf16_f32 %0, %1, %2" : "=v"(r) : "v"(lo), "v"(hi)); return r; }

__device__ __forceinline__ void pv(f32x16* o, int vb, bf16x8 pa0, bf16x8 pa1, bf16x8 pa2, bf16x8 pa3) {
#pragma unroll
    for (int d0 = 0; d0 < 2; ++d0) { s16x4 lo[4], hi[4];
#pragma unroll
        for (int ks = 0; ks < 4; ++ks) {
            asm volatile("ds_read_b64_tr_b16 %0,%1 offset:%c2" : "=&v"(lo[ks]) : "v"(vb), "i"(d0 * 4096 + ks * 1024) : "memory");
            asm volatile("ds_read_b64_tr_b16 %0,%1 offset:%c2" : "=&v"(hi[ks]) : "v"(vb), "i"(d0 * 4096 + ks * 1024 + 512) : "memory"); }
        asm volatile("s_waitcnt lgkmcnt(0)" ::: "memory"); __builtin_amdgcn_sched_barrier(0);
#define PK(k) (bf16x8){lo[k][0], lo[k][1], lo[k][2], lo[k][3], hi[k][0], hi[k][1], hi[k][2], hi[k][3]}
        o[d0] = __builtin_amdgcn_mfma_f32_32x32x16_bf16(pa0, PK(0), o[d0], 0, 0, 0);
        o[d0] = __builtin_amdgcn_mfma_f32_32x32x16_bf16(pa1, PK(1), o[d0], 0, 0, 0);
        o[d0] = __builtin_amdgcn_mfma_f32_32x32x16_bf16(pa2, PK(2), o[d0], 0, 0, 0);
        o[d0] = __builtin_amdgcn_mfma_f32_32x32x16_bf16(pa3, PK(3), o[d0], 0, 0, 0);
#undef PK
    }
}

__device__ __forceinline__ void attn_bh(int b, int h, bf16_t* qkv, const float* lcum, const float* tot, LAS unsigned char* lds) {
    const int tid = threadIdx.x, lane = tid & 63, r32 = lane & 31, hi = lane >> 5; const int wid = __builtin_amdgcn_readfirstlane(tid >> 6);
    LAS float* cumT = (LAS float*)(lds + L_CUM);
    LAS float* wsf = (LAS float*)(lds + L_WS) + wid * 64;
    const long rowbase = (long)b * SEQ;
    for (int i = tid; i < SEQ; i += 512) { float off = 0.f; const int ti = i >> 8;
        for (int j = 0; j < ti; ++j) off += tot[(b * 8 + j) * 8 + h];
        cumT[i] = lcum[(rowbase + i) * 8 + h] + off; }
    LDS_WAIT(); __syncthreads();
    const unsigned lds0 = (unsigned)(uintptr_t)lds;
    const bf16_t* Kh = qkv + rowbase * PITCH + 512 + h * 64; const bf16_t* Vh = qkv + rowbase * PITCH + 1024 + h * 64;
    const bf16_t* ksrc = Kh + (long)lane * PITCH + wid * 8;
    const bf16_t* vsrc = Vh + (long)(16 * (wid & 3) + (lane >> 2)) * PITCH + (wid >> 2) * 32 + (lane & 3) * 8;
    const unsigned kdst = lds0 + L_K + wid * 1024, vdst = lds0 + L_V + wid * 1024;
    const int vb0 = (int)(lds0 + L_V) + ((lane >> 4) & 1) * 32 + (lane & 3) * 8 + (4 * hi + ((lane & 15) >> 2)) * 64;
    for (int qb = 7; qb >= 0; --qb) {
        const int q0 = qb * QB;
        bf16_t* Qw = qkv + (rowbase + q0 + wid * 32) * PITCH + h * 64;
        bf16x8 qr[4];
#pragma unroll
        for (int d0 = 0; d0 < 4; ++d0) qr[d0] = *(const bf16x8*)(Qw + (long)r32 * PITCH + d0 * 16 + hi * 8);
        const int qrel = wid * 32 + r32;
        const float cq = cumT[q0 + qrel];
        float mrun = -1e30f, lrun = 0.f; f32x16 o[2]; o[0] = f32x16{}; o[1] = f32x16{};
        const int NT = (q0 + QB) / KVBLK;
        glds16(ksrc, (unsigned)__builtin_amdgcn_readfirstlane(kdst)); glds16(vsrc, (unsigned)__builtin_amdgcn_readfirstlane(vdst));
        for (int t = 0; t < NT; ++t) {
            const int slot = (t & 1) * SLOTB;
            asm volatile("s_waitcnt vmcnt(0) lgkmcnt(0)\n\ts_barrier" ::: "memory");
            if (t + 1 < NT) { const int ns = ((t + 1) & 1) * SLOTB;
                glds16(ksrc + (long)(t + 1) * KVBLK * PITCH, (unsigned)__builtin_amdgcn_readfirstlane(kdst + ns));
                glds16(vsrc + (long)(t + 1) * KVBLK * PITCH, (unsigned)__builtin_amdgcn_readfirstlane(vdst + ns)); }
            f32x16 p0, p1;
            const LAS float* ck = cumT + t * KVBLK + 4 * hi;
#pragma unroll
            for (int g = 0; g < 4; ++g) { const f32x4 c0 = *(const LAS f32x4*)(ck + 8 * g), c1 = *(const LAS f32x4*)(ck + 32 + 8 * g);
#pragma unroll
                for (int e = 0; e < 4; ++e) { p0[4 * g + e] = cq - c0[e]; p1[4 * g + e] = cq - c1[e]; } }
            const LAS unsigned char* kb = lds + L_K + slot + hi * 1024 + r32 * 16;
#pragma unroll
            for (int d0 = 0; d0 < 4; ++d0) { const bf16x8 b0 = *(const LAS bf16x8*)(kb + d0 * 2048), b1 = *(const LAS bf16x8*)(kb + d0 * 2048 + 512);
                p0 = __builtin_amdgcn_mfma_f32_32x32x16_bf16(b0, qr[d0], p0, 0, 0, 0); p1 = __builtin_amdgcn_mfma_f32_32x32x16_bf16(b1, qr[d0], p1, 0, 0, 0); }
            const int jb = t - (NT - 4);
            if (jb >= 0) { const int kb0 = 64 * jb + 4 * hi;
#pragma unroll
                for (int r = 0; r < 16; ++r) { const int kv = kb0 + (r & 3) + 8 * (r >> 2); if (kv > qrel) p0[r] = -INFINITY; if (kv + 32 > qrel) p1[r] = -INFINITY; } }
            float rm = p0[0];
#pragma unroll
            for (int r = 1; r < 16; ++r) rm = fmaxf(rm, p0[r]);
#pragma unroll
            for (int r = 0; r < 16; ++r) rm = fmaxf(rm, p1[r]);
            rm = fmaxf(rm, __shfl_xor(rm, 32));
            const float mn = fmaxf(mrun, rm), alpha = fast_exp2(mrun - mn); mrun = mn;
            float ls = 0.f;
#pragma unroll
            for (int r = 0; r < 16; ++r) { p0[r] = fast_exp2(p0[r] - mn); p1[r] = fast_exp2(p1[r] - mn); ls += p0[r] + p1[r]; }
            lrun = lrun * alpha + ls;
            if (hi == 0) wsf[r32] = alpha;
            asm volatile("s_waitcnt lgkmcnt(0)" ::: "memory");
#pragma unroll
            for (int r = 0; r < 16; ++r) { const float a = wsf[crow(r, hi)]; o[0][r] *= a; o[1][r] *= a; }
            u32x4 pw0, pw1, pw2, pw3;
            pw0 = (u32x4){cvtpk(p0[0], p0[1]), cvtpk(p0[2], p0[3]), cvtpk(p0[4], p0[5]), cvtpk(p0[6], p0[7])};
            pw1 = (u32x4){cvtpk(p0[8], p0[9]), cvtpk(p0[10], p0[11]), cvtpk(p0[12], p0[13]), cvtpk(p0[14], p0[15])};
            pw2 = (u32x4){cvtpk(p1[0], p1[1]), cvtpk(p1[2], p1[3]), cvtpk(p1[4], p1[5]), cvtpk(p1[6], p1[7])};
            pw3 = (u32x4){cvtpk(p1[8], p1[9]), cvtpk(p1[10], p1[11]), cvtpk(p1[12], p1[13]), cvtpk(p1[14], p1[15])};
            asm volatile("s_waitcnt lgkmcnt(0)" ::: "memory"); __builtin_amdgcn_sched_barrier(0);
            pv(o, vb0 + slot, __builtin_bit_cast(bf16x8, pw0), __builtin_bit_cast(bf16x8, pw1), __builtin_bit_cast(bf16x8, pw2), __builtin_bit_cast(bf16x8, pw3));
        }
        lrun += __shfl_xor(lrun, 32);
        if (hi == 0) wsf[32 + r32] = lrun;
        asm volatile("s_waitcnt lgkmcnt(0)" ::: "memory");
        float rli[16];
#pragma unroll
        for (int r = 0; r < 16; ++r) rli[r] = fast_rcp(wsf[32 + crow(r, hi)]);
        { LAS bf16_t* stg = (LAS bf16_t*)(lds + L_OST) + wid * 2048;
#pragma unroll
            for (int r = 0; r < 16; ++r) { const int orow = crow(r, hi);
#pragma unroll
                for (int d0 = 0; d0 < 2; ++d0) stg[orow * 64 + d0 * 32 + r32] = (bf16_t)f2bf(o[d0][r] * rli[r]); }
            asm volatile("s_waitcnt lgkmcnt(0)" ::: "memory");
#pragma unroll
            for (int i = 0; i < 4; ++i) { const int row = i * 8 + (lane >> 3), ch = lane & 7; const u32x4 v = *(const LAS u32x4*)(stg + row * 64 + ch * 8); *(u32x4*)(Qw + (long)row * PITCH + ch * 8) = v; } }
        asm volatile("s_waitcnt vmcnt(0) lgkmcnt(0)\n\ts_barrier" ::: "memory");
    }
}
}

namespace rnn {
constexpr int L_W = 0, L_CW = 24576, L_GB = 26112, L_SUM = 28672, L_PARK = 36864, L_CARRY = 40960;
__device__ __forceinline__ void rnn_unit(int b, int blk, bf16_t* xg, const bf16_t* wfrag, const float* w_conv, const float* b_conv,
                                         const float* b_rg, const float* b_ig, const float* lam, LAS unsigned char* lds) {
    const int tid = threadIdx.x, lane = tid & 63, n31 = lane & 31, hh = lane >> 5; const int wid = __builtin_amdgcn_readfirstlane(tid >> 6);
    LAS float* cw = (LAS float*)(lds + L_CW);
    LAS float* gb = (LAS float*)(lds + L_GB);
    LAS float* sum = (LAS float*)(lds + L_SUM);
    LAS float* carry = (LAS float*)(lds + L_CARRY);
    LAS float* park = (LAS float*)(lds + L_PARK);
    __syncthreads();
    for (int i = tid; i < 1536; i += 512) *(LAS u32x4*)(lds + L_W + i * 16) = *(const u32x4*)((const char*)wfrag + (size_t)blk * 24576 + i * 16);
    if (tid < 256) cw[tid] = w_conv[(tid >> 6) * 1024 + blk * 64 + (tid & 63)];
    else if (tid < 320) cw[tid] = b_conv[blk * 64 + (tid - 256)];
    if (tid < 64) { gb[tid] = b_rg[blk * 64 + tid]; gb[64 + tid] = b_ig[blk * 64 + tid];
        const float l = lam[blk * 64 + tid]; const float sp = log1pf(expf(-l)); gb[128 + tid] = -8.0f * sp * LOG2E; carry[tid] = 0.f; }
    LDS_WAIT(); __syncthreads();
    const size_t colx = (size_t)blk * 64;
    for (int seg = 0; seg < 8; ++seg) {
        const int tl = seg * 256 + wid * 32;
        bf16x8 ua[4];
        { const int tok = tl + n31;
#pragma unroll
          for (int ks = 0; ks < 4; ++ks) { const int ch0 = 16 * ks + 8 * hh; float a8[8];
#pragma unroll
              for (int j = 0; j < 8; ++j) a8[j] = cw[256 + ch0 + j];
#pragma unroll
              for (int tap = 0; tap < 4; ++tap) { const int tt = tok - 3 + tap;
                  if (tt >= 0) { const u32x4 xv = *(const u32x4*)(xg + ((size_t)b * SEQ + tt) * 2048 + colx + ch0);
                      const LAS float* cwt = cw + tap * 64 + ch0;
                      a8[0] += cwt[0] * bflo(xv.x); a8[1] += cwt[1] * bfhi(xv.x); a8[2] += cwt[2] * bflo(xv.y); a8[3] += cwt[3] * bfhi(xv.y);
                      a8[4] += cwt[4] * bflo(xv.z); a8[5] += cwt[5] * bfhi(xv.z); a8[6] += cwt[6] * bflo(xv.w); a8[7] += cwt[7] * bfhi(xv.w); } }
              u32x4 w; w.x = pk2(a8[0], a8[1]); w.y = pk2(a8[2], a8[3]); w.z = pk2(a8[4], a8[5]); w.w = pk2(a8[6], a8[7]);
              ua[ks] = __builtin_bit_cast(bf16x8, w); } }
        f32x16 C[6];
#pragma unroll
        for (int nb = 0; nb < 6; ++nb) { C[nb] = f32x16{};
#pragma unroll
            for (int ks = 0; ks < 4; ++ks) { const bf16x8 wf = *(const LAS bf16x8*)(lds + L_W + ((nb * 4 + ks) * 64 + lane) * 16);
                C[nb] = __builtin_amdgcn_mfma_f32_32x32x16_bf16(ua[ks], wf, C[nb], 0, 0, 0); } }
        float hl[2][16], Pl[2][16];
#pragma unroll
        for (int cb = 0; cb < 2; ++cb) { const int n = 32 * cb + n31; const float brg = gb[n], big = gb[64 + n], cA = gb[128 + n];
#pragma unroll
            for (int r = 0; r < 16; ++r) { const float rg = sigmoidf_(C[cb][r] + brg), ig = sigmoidf_(C[2 + cb][r] + big);
                const float a = fast_exp2(cA * rg); const float mult = sqrtf(fmaxf(1.0f - a * a, 0.f));
                Pl[cb][r] = a; hl[cb][r] = mult * ig * C[4 + cb][r]; }
#pragma unroll
            for (int j = 0; j < 4; ++j) {
#pragma unroll
                for (int k = 1; k < 4; ++k) { hl[cb][4 * j + k] = Pl[cb][4 * j + k] * hl[cb][4 * j + k - 1] + hl[cb][4 * j + k]; Pl[cb][4 * j + k] *= Pl[cb][4 * j + k - 1]; } }
            float cin = 0.f, pin = 1.f, cinj[4], pinj[4];
#pragma unroll
            for (int g = 0; g < 8; ++g) { const int j = g >> 1; const bool own = (hh == (g & 1));
                if (own) { cinj[j] = cin; pinj[j] = pin; }
                const float co = Pl[cb][4 * j + 3] * cin + hl[cb][4 * j + 3], po = pin * Pl[cb][4 * j + 3];
                const float co_o = __shfl_xor(co, 32), po_o = __shfl_xor(po, 32);
                cin = own ? co : co_o; pin = own ? po : po_o; }
#pragma unroll
            for (int j = 0; j < 4; ++j)
#pragma unroll
                for (int k = 0; k < 4; ++k) { hl[cb][4 * j + k] += Pl[cb][4 * j + k] * cinj[j]; Pl[cb][4 * j + k] *= pinj[j]; }
            if (hh == 0) { sum[(wid * 64 + n) * 2] = pin; sum[(wid * 64 + n) * 2 + 1] = cin; }
        }
        LDS_WAIT(); __syncthreads();
#pragma unroll
        for (int cb = 0; cb < 2; ++cb) { const int n = 32 * cb + n31; float hin = carry[n];
            for (int w = 0; w < wid; ++w) hin = sum[(w * 64 + n) * 2] * hin + sum[(w * 64 + n) * 2 + 1];
            float hend = 0.f;
#pragma unroll
            for (int r = 0; r < 16; ++r) { const float hv = hl[cb][r] + Pl[cb][r] * hin; if (r == 15) hend = hv;
                const int tok = tl + att::crow(r, hh);
                bf16_t* gp = xg + ((size_t)b * SEQ + tok) * 2048 + 1024 + colx + n;
                const float g = bf2f(*gp); const float ge = g * sigmoidf_(1.5957691216057308f * (g + 0.044715f * g * g * g));
                *gp = (bf16_t)f2bf(hv * ge); }
            if (wid == 7 && hh == 1) park[n] = hend;
        }
        LDS_WAIT(); __syncthreads();
        if (tid < 64) carry[tid] = park[tid];
        LDS_WAIT(); __syncthreads();
    }
}
}

__device__ __forceinline__ void transpose_block(const float* W, int ldw, bf16_t* dst, int ldd, LAS float* scr, int lane) {
#pragma unroll 8
    for (int i = 0; i < 32; ++i) { const int kk = 2 * i + (lane >> 5); scr[kk * 33 + (lane & 31)] = W[(size_t)kk * ldw + (lane & 31)]; }
    LDS_WAIT(); asm volatile("" ::: "memory");
    const int c = lane & 7;
#pragma unroll
    for (int j = 0; j < 4; ++j) { const int n = (lane >> 3) + 8 * j; const LAS float* s = scr + (8 * c) * 33 + n;
        u32x4 o; o.x = pk2(s[0 * 33], s[1 * 33]); o.y = pk2(s[2 * 33], s[3 * 33]); o.z = pk2(s[4 * 33], s[5 * 33]); o.w = pk2(s[6 * 33], s[7 * 33]);
        *(u32x4*)(dst + (size_t)n * ldd + 8 * c) = o; }
    LDS_WAIT(); asm volatile("" ::: "memory");
}

struct In {
    const float *x, *c, *w_ada, *b_ada, *g_pre_mix, *g_post_mix, *g_pre_ffn, *g_post_ffn, *w_in, *b_forget, *w_conv, *b_conv, *w_rg, *b_rg, *w_ig, *b_ig, *lam,
        *w_ba, *w_br, *w_out, *w_router, *r_bias, *w_eg, *w_eu, *w_ed, *w_sg, *w_su, *w_sd;
};

__device__ __forceinline__ bool conv_mat(int& r, const float* W, int K, int N, int ldw, bf16_t* dst, int ldd, LAS float* scr, int lane) {
    const int nblk = N / 32, items = (K / 64) * nblk;
    if (r >= items) { r -= items; return false; }
    const int kb = r / nblk, nb = r % nblk;
    transpose_block(W + (size_t)(64 * kb) * ldw + 32 * nb, ldw, dst + (size_t)(32 * nb) * ldd + 64 * kb, ldd, scr, lane);
    return true;
}

__device__ __forceinline__ void p0_prologue(const In& in, unsigned char* ws, LAS unsigned char* lds, int vcu, int G) {
    const int tid = threadIdx.x, lane = tid & 63; const int wave = __builtin_amdgcn_readfirstlane(tid >> 6);
    bf16_t* WIN = (bf16_t*)(ws + WS_WIN); bf16_t* WBA = (bf16_t*)(ws + WS_WBA); bf16_t* WBR = (bf16_t*)(ws + WS_WBR); bf16_t* WOUT = (bf16_t*)(ws + WS_WOUT);
    bf16_t* WROUT = (bf16_t*)(ws + WS_WROUT); bf16_t* WGU = (bf16_t*)(ws + WS_WGU); bf16_t* WDN = (bf16_t*)(ws + WS_WDN);
    if (vcu < 192) {
        LAS float* s = (LAS float*)lds;
        for (int i = tid; i < 32 * 1024; i += 512) { const float v = in.c[i]; s[i] = v * sigmoidf_(v); }
        LDS_WAIT(); __syncthreads();
        const int kq = tid >> 5, col = tid & 31, col0 = vcu * 32;
        float acc[32];
#pragma unroll
        for (int bb = 0; bb < 32; ++bb) acc[bb] = 0.f;
        for (int k4 = 0; k4 < 16; ++k4) { const int k = 64 * kq + 4 * k4; float w[4];
#pragma unroll
            for (int e = 0; e < 4; ++e) w[e] = in.w_ada[(size_t)(k + e) * 6144 + col0 + col];
#pragma unroll
            for (int bb = 0; bb < 32; ++bb) { const f32x4 sv = *(const LAS f32x4*)(s + bb * 1024 + k); acc[bb] += (sv[0] * w[0] + sv[1] * w[1]) + (sv[2] * w[2] + sv[3] * w[3]); } }
        __syncthreads();
        LAS float* red = (LAS float*)lds;
#pragma unroll
        for (int bb = 0; bb < 32; ++bb) red[(kq * 32 + bb) * 32 + col] = acc[bb];
        LDS_WAIT(); __syncthreads();
        float* mod = (float*)(ws + WS_MOD);
        for (int o = tid; o < 1024; o += 512) { const int bb = o >> 5, cc = o & 31; float v = in.b_ada[col0 + cc];
#pragma unroll
            for (int q = 0; q < 16; ++q) v += red[(q * 32 + bb) * 32 + cc];
            mod[(size_t)bb * 6144 + col0 + cc] = v; }
        __syncthreads();
    }
    { const int gt = vcu * 512 + tid, GT = G * 512;
      float* WF = (float*)(ws + WS_WF);
      for (int i = gt; i < 8 * 1024; i += GT) { const int hd = i >> 10, k = i & 1023; WF[i] = in.w_in[(size_t)k * INCOLS + 1536 + hd]; }
      bf16_t* WR = (bf16_t*)(ws + WS_WRNN);
      for (int i = gt; i < 16 * 6 * 4 * 64 * 8; i += GT) { const int jj = i & 7, ln = (i >> 3) & 63, ks = (i >> 9) & 3, nbk = (i >> 11); const int nb = nbk % 6, blk = nbk / 6;
          const int c = 16 * ks + 8 * (ln >> 5) + jj, n = 32 * nb + (ln & 31); float v;
          if (n < 64) v = in.w_rg[((size_t)blk * 64 + c) * 64 + n]; else if (n < 128) v = in.w_ig[((size_t)blk * 64 + c) * 64 + (n - 64)]; else v = (c == n - 128) ? 1.f : 0.f;
          WR[i] = (bf16_t)f2bf(v); } }
    LAS float* scr = (LAS float*)(lds + wave * 16384);
    const int gw = vcu * NWAVES + wave, NGW = G * NWAVES;
    constexpr int I_EXP = (1024 / 64) * (256 / 32);
    constexpr int NITEMS = 768 + 2048 + 256 + 512 + 512 + 32 + 3 * 65 * I_EXP;
    for (int it = gw; it < NITEMS; it += NGW) {
        int r = it;
        if (conv_mat(r, in.w_in, 1024, 1536, INCOLS, WIN, 1024, scr, lane)) continue;
        if (conv_mat(r, in.w_in + 1544, 1024, 4096, INCOLS, WIN + (size_t)1536 * 1024, 1024, scr, lane)) continue;
        if (conv_mat(r, in.w_ba, 512, 1024, 1024, WBA, 512, scr, lane)) continue;
        if (conv_mat(r, in.w_br, 1024, 1024, 1024, WBR, 1024, scr, lane)) continue;
        if (conv_mat(r, in.w_out, 1024, 1024, 1024, WOUT, 1024, scr, lane)) continue;
        if (conv_mat(r, in.w_router, 1024, 64, 64, WROUT, 1024, scr, lane)) continue;
        const int kind = r / (65 * I_EXP), rr = r % (65 * I_EXP), e = rr / I_EXP, ii = rr % I_EXP;
        if (kind < 2) {
            const float* W = (e < 64) ? ((kind == 0 ? in.w_eg : in.w_eu) + (size_t)e * 1024 * 256) : (kind == 0 ? in.w_sg : in.w_su);
            const int kb = ii / 8, nb = ii % 8, n0 = 32 * nb;
            transpose_block(W + (size_t)(64 * kb) * 256 + n0, 256, WGU + ((size_t)e * 512 + (n0 >> 7) * 256 + kind * 128 + (n0 & 127)) * 1024 + 64 * kb, 1024, scr, lane);
        } else {
            const float* W = (e < 64) ? (in.w_ed + (size_t)e * 256 * 1024) : in.w_sd;
            const int kb = ii / 32, nb = ii % 32;
            transpose_block(W + (size_t)(64 * kb) * 1024 + 32 * nb, 1024, WDN + ((size_t)e * 1024 + 32 * nb) * 256 + 64 * kb, 256, scr, lane);
        }
    }
}

__device__ __forceinline__ void p1_norm(int tile, const In& in, unsigned char* ws, LAS unsigned char* lds) {
    const int tid = threadIdx.x, lane = tid & 63; const int wave = __builtin_amdgcn_readfirstlane(tid >> 6);
    const int b = tile >> 3;
    LAS float* wf = (LAS float*)lds;
    LAS float* lc = (LAS float*)(lds + 32768);
    LAS float* wtot = (LAS float*)(lds + 40960);
    const float* WF = (const float*)(ws + WS_WF); const float* mod = (const float*)(ws + WS_MOD) + (size_t)b * 6144;
    __syncthreads();
    for (int i = tid; i < 2048; i += 512) *(LAS f32x4*)(wf + 4 * i) = *(const f32x4*)(WF + 4 * i);
    f32x4 A[4], B[4];
#pragma unroll
    for (int j = 0; j < 4; ++j) { const int col = 4 * lane + 256 * j; const f32x4 g = *(const f32x4*)(in.g_pre_mix + col), sc = *(const f32x4*)(mod + 1024 + col); A[j] = g * (sc + 1.0f); B[j] = *(const f32x4*)(mod + col); }
    const float bfg = in.b_forget[lane & 7];
    LDS_WAIT(); __syncthreads();
    bf16_t* H = (bf16_t*)(ws + R_H);
    float run = 0.f;
    for (int i = 0; i < 32; ++i) { const size_t tok = (size_t)tile * 256 + wave * 32 + i;
        f32x4 v[4]; float ss = 0.f;
#pragma unroll
        for (int j = 0; j < 4; ++j) { v[j] = *(const f32x4*)(in.x + tok * 1024 + 4 * lane + 256 * j); ss += (v[j][0] * v[j][0] + v[j][1] * v[j][1]) + (v[j][2] * v[j][2] + v[j][3] * v[j][3]); }
        const float rstd = 1.0f / sqrtf(wave_sum(ss) * (1.0f / 1024.0f) + NORM_EPS);
#pragma unroll
        for (int j = 0; j < 4; ++j) { v[j] = v[j] * rstd * A[j] + B[j];
            u32x2 w; w.x = pk2(v[j][0], v[j][1]); w.y = pk2(v[j][2], v[j][3]); *(u32x2*)(H + tok * 1024 + 4 * lane + 256 * j) = w; }
        float p[8];
#pragma unroll
        for (int hd = 0; hd < 8; ++hd) { float a = 0.f;
#pragma unroll
            for (int j = 0; j < 4; ++j) { const f32x4 w4 = *(const LAS f32x4*)(wf + hd * 1024 + 4 * lane + 256 * j); a += (v[j][0] * w4[0] + v[j][1] * w4[1]) + (v[j][2] * w4[2] + v[j][3] * w4[3]); }
            p[hd] = wave_sum(a); }
        const int l7 = lane & 7;
        float f = p[0]; f = (l7 == 1) ? p[1] : f; f = (l7 == 2) ? p[2] : f; f = (l7 == 3) ? p[3] : f; f = (l7 == 4) ? p[4] : f; f = (l7 == 5) ? p[5] : f; f = (l7 == 6) ? p[6] : f; f = (l7 == 7) ? p[7] : f;
        f += bfg;
        const float ls = -log1pf(expf(-f)) * LOG2E;
        run += ls;
        if (lane < 8) lc[(wave * 32 + i) * 8 + lane] = run;
    }
    if (lane < 8) wtot[wave * 8 + lane] = run;
    LDS_WAIT(); __syncthreads();
    float* LC = (float*)(ws + WS_LCUM); float* TOT = (float*)(ws + WS_TOT);
    for (int i = tid; i < 2048; i += 512) { const int tk = i >> 3, hd = i & 7; float off = 0.f; const int w = tk >> 5;
        for (int q = 0; q < w; ++q) off += wtot[q * 8 + hd];
        LC[((size_t)tile * 256 + tk) * 8 + hd] = lc[i] + off; }
    if (tid < 8) { float t = 0.f;
#pragma unroll
        for (int q = 0; q < 8; ++q) t += wtot[q * 8 + tid];
        TOT[tile * 8 + tid] = t; }
}

namespace p6 {
constexpr int HP = 2064;
constexpr int L_H2 = 0, L_PART = 66560, L_HIST = 99328;
__device__ __forceinline__ void run(int tile, const In& in, float* out, unsigned char* ws, LAS unsigned char* lds) {
    const int tid = threadIdx.x, lane = tid & 63, n31 = lane & 31, hh = lane >> 5; const int wave = __builtin_amdgcn_readfirstlane(tid >> 6);
    const int b = tile >> 3;
    const float* mod = (const float*)(ws + WS_MOD) + (size_t)b * 6144;
    bf16_t* H = (bf16_t*)(ws + R_H); const float* SSQ = (const float*)(ws + WS_SSQ); const bf16_t* WROUT = (const bf16_t*)(ws + WS_WROUT);
    int* EP = (int*)(ws + WS_EP); float* EW = (float*)(ws + WS_EW); int* HIST = (int*)(ws + WS_HIST);
    LAS float* part = (LAS float*)(lds + L_PART); LAS int* histl = (LAS int*)(lds + L_HIST);
    f32x4 G1[4], A2[4], B2[4];
#pragma unroll
    for (int j = 0; j < 4; ++j) { const int col = 4 * lane + 256 * j;
        G1[j] = *(const f32x4*)(mod + 2048 + col) * *(const f32x4*)(in.g_post_mix + col);
        A2[j] = *(const f32x4*)(in.g_pre_ffn + col) * (*(const f32x4*)(mod + 4096 + col) + 1.0f);
        B2[j] = *(const f32x4*)(mod + 3072 + col); }
    const int kq = wave >> 1, nb = wave & 1;
    bf16x8 wr[16];
#pragma unroll
    for (int ks = 0; ks < 16; ++ks) wr[ks] = *(const bf16x8*)(WROUT + (size_t)(32 * nb + n31) * 1024 + 256 * kq + 16 * ks + 8 * hh);
    const float rbias = in.r_bias[lane];
    __syncthreads();
    if (tid < 64) histl[tid] = 0;
    LDS_WAIT(); __syncthreads();
    for (int sub = 0; sub < 8; ++sub) {
        for (int i = 0; i < 4; ++i) { const int tl = wave * 4 + i; const size_t tok = (size_t)tile * 256 + sub * 32 + tl;
            u32x2 mv[4]; f32x4 xv[4];
#pragma unroll
            for (int j = 0; j < 4; ++j) { mv[j] = *(const u32x2*)(H + tok * 1024 + 4 * lane + 256 * j); xv[j] = *(const f32x4*)(in.x + tok * 1024 + 4 * lane + 256 * j); }
            const float s1 = wave_sum(lane < 16 ? SSQ[tok * 16 + lane] : 0.f);
            const float rstd1 = 1.0f / sqrtf(s1 * (1.0f / 1024.0f) + NORM_EPS);
            float ss = 0.f;
#pragma unroll
            for (int j = 0; j < 4; ++j) { f32x4 m; m[0] = bflo(mv[j].x); m[1] = bfhi(mv[j].x); m[2] = bflo(mv[j].y); m[3] = bfhi(mv[j].y);
                xv[j] = xv[j] + G1[j] * (m * rstd1);
                *(f32x4*)(out + tok * 1024 + 4 * lane + 256 * j) = xv[j];
                ss += (xv[j][0] * xv[j][0] + xv[j][1] * xv[j][1]) + (xv[j][2] * xv[j][2] + xv[j][3] * xv[j][3]); }
            const float rstd2 = 1.0f / sqrtf(wave_sum(ss) * (1.0f / 1024.0f) + NORM_EPS);
#pragma unroll
            for (int j = 0; j < 4; ++j) { const f32x4 hv = xv[j] * rstd2 * A2[j] + B2[j];
                u32x2 w; w.x = pk2(hv[0], hv[1]); w.y = pk2(hv[2], hv[3]);
                *(u32x2*)(H + tok * 1024 + 4 * lane + 256 * j) = w;
                *(LAS u32x2*)(lds + L_H2 + tl * HP + (4 * lane + 256 * j) * 2) = w; }
        }
        LDS_WAIT(); __syncthreads();
        { f32x16 acc = f32x16{};
#pragma unroll
          for (int ks = 0; ks < 16; ++ks) { const bf16x8 a = *(const LAS bf16x8*)(lds + L_H2 + n31 * HP + (256 * kq + 16 * ks + 8 * hh) * 2);
              acc = __builtin_amdgcn_mfma_f32_32x32x16_bf16(a, wr[ks], acc, 0, 0, 0); }
#pragma unroll
          for (int r = 0; r < 16; ++r) part[(kq * 32 + att::crow(r, hh)) * 64 + 32 * nb + n31] = acc[r]; }
        LDS_WAIT(); __syncthreads();
        for (int i = 0; i < 4; ++i) { const int tl = wave * 4 + i; const size_t tok = (size_t)tile * 256 + sub * 32 + tl;
            const float logit = (part[(0 * 32 + tl) * 64 + lane] + part[(1 * 32 + tl) * 64 + lane]) + (part[(2 * 32 + tl) * 64 + lane] + part[(3 * 32 + tl) * 64 + lane]);
            const float score = 1.0f / (1.0f + expf(-logit)); const float sel = score + rbias;
            int rin = 0;
#pragma unroll
            for (int j = 0; j < 8; ++j) { const float o = __shfl(sel, (lane & ~7) + j); rin += (o > sel || (o == sel && j < (lane & 7))) ? 1 : 0; }
            float gs = rin < 2 ? sel : 0.f; gs += __shfl_xor(gs, 1); gs += __shfl_xor(gs, 2); gs += __shfl_xor(gs, 4);
            int gr = 0; const int g = lane >> 3;
#pragma unroll
            for (int j = 0; j < 8; ++j) { const float o = __shfl(gs, j * 8); gr += (o > gs || (o == gs && j < g)) ? 1 : 0; }
            const bool gsel = gr < 4; const float msel = gsel ? sel : -INFINITY;
            int rk = 0;
            for (int j = 0; j < 64; ++j) { const float o = __shfl(msel, j); rk += (o > msel || (o == msel && j < lane)) ? 1 : 0; }
            const bool chosen = gsel && rk < 6;
            const float wsum = wave_sum(chosen ? score : 0.f);
            if (chosen) { const int li = __hip_atomic_fetch_add(histl + lane, 1, __ATOMIC_RELAXED, __HIP_MEMORY_SCOPE_WORKGROUP);
                EP[tok * 6 + rk] = lane | (li << 8); EW[tok * 6 + rk] = score / wsum * 2.5f; }
        }
    }
    LDS_WAIT(); __syncthreads();
    if (tid < 64) HIST[tile * 64 + tid] = histl[tid];
}
}

__device__ __forceinline__ void p7_place(int tile, unsigned char* ws, LAS unsigned char* lds) {
    const int tid = threadIdx.x; const int r = tile >> 7;
    LAS int* cntb = (LAS int*)lds; LAS int* tot = cntb + 64; LAS int* base = cntb + 128; LAS int* tst = cntb + 192;
    const int* HIST = (const int*)(ws + WS_HIST); const int* EP = (const int*)(ws + WS_EP); int* POS = (int*)(ws + WS_POS);
    int* SLOTTOK = (int*)(ws + WS_SLOTTOK) + (size_t)r * RT_MAX * 256; int* RTAB = (int*)(ws + WS_RTAB) + r * 256;
    __syncthreads();
    if (tid < 64) { int cb = 0, tt = 0;
        for (int i = 0; i < 128; ++i) { const int v = HIST[(r * 128 + i) * 64 + tid]; tt += v; if (r * 128 + i < tile) cb += v; }
        cntb[tid] = cb; tot[tid] = tt; }
    LDS_WAIT(); __syncthreads();
    if (tid == 0) { int ts = 0; for (int e = 0; e < 64; ++e) { tst[e] = ts; ts += (tot[e] + 255) >> 8; } tst[64] = ts; }
    LDS_WAIT(); __syncthreads();
    if (tid < 64) base[tid] = tst[tid] * 256 + cntb[tid];
    if ((tile & 127) == 0) { if (tid < 65) RTAB[tid] = tst[tid]; if (tid < 64) RTAB[128 + tid] = tot[tid]; }
    LDS_WAIT(); __syncthreads();
    for (int p = tid; p < 1536; p += 512) { const int token = tile * 256 + p / 6; const int ep = EP[(size_t)tile * 1536 + p]; const int e = ep & 255, li = ep >> 8;
        const int slot = base[e] + li; POS[(size_t)tile * 1536 + p] = slot; SLOTTOK[slot] = token; }
}

__device__ __forceinline__ void combine_round(int r, const In& in, float* out, unsigned char* ws, int gw, int NGW) {
    const int lane = threadIdx.x & 63;
    const bf16_t* Y = (const bf16_t*)(ws + R_Y); const int* POS = (const int*)(ws + WS_POS); const float* EW = (const float*)(ws + WS_EW);
    for (int idx = gw; idx < HALF_T; idx += NGW) { const size_t tok = (size_t)r * HALF_T + idx; const int b = (int)(tok >> 11);
        const float* mod = (const float*)(ws + WS_MOD) + (size_t)b * 6144;
        int slot = 0; float w = 1.0f;
        if (lane < 6) { slot = POS[tok * 6 + lane]; w = EW[tok * 6 + lane]; }
        if (lane == 6) slot = (RT_MAX + (idx >> 8)) * 256 + (idx & 255);
        f32x4 a[4];
#pragma unroll
        for (int j = 0; j < 4; ++j) a[j] = (f32x4){0.f, 0.f, 0.f, 0.f};
#pragma unroll
        for (int k = 0; k < 7; ++k) { const int sl = __shfl(slot, k); const float wk = __shfl(w, k);
#pragma unroll
            for (int j = 0; j < 4; ++j) { const u32x2 v = *(const u32x2*)(Y + (size_t)sl * 1024 + 4 * lane + 256 * j);
                a[j][0] += wk * bflo(v.x); a[j][1] += wk * bfhi(v.x); a[j][2] += wk * bflo(v.y); a[j][3] += wk * bfhi(v.y); } }
        float ss = 0.f;
#pragma unroll
        for (int j = 0; j < 4; ++j) ss += (a[j][0] * a[j][0] + a[j][1] * a[j][1]) + (a[j][2] * a[j][2] + a[j][3] * a[j][3]);
        const float rstd = 1.0f / sqrtf(wave_sum(ss) * (1.0f / 1024.0f) + NORM_EPS);
#pragma unroll
        for (int j = 0; j < 4; ++j) { const int col = 4 * lane + 256 * j;
            const f32x4 gf = *(const f32x4*)(mod + 5120 + col) * *(const f32x4*)(in.g_post_ffn + col);
            f32x4 x1 = *(const f32x4*)(out + tok * 1024 + col);
            x1 = x1 + gf * (a[j] * rstd);
            *(f32x4*)(out + tok * 1024 + col) = x1; }
    }
}

#define XB_TMO      128
#define XB_XCNT(j)  (256  + 64 * (j))
#define XB_XSUB(j)  (1280 + 64 * (j))
#define XB_XGEN(j)  (2304 + 64 * (j))
#define XB_TOP      3328
#define XB_TOPGEN   3392
#define XCD_BAR_WORDS 3456
#define XB_SPIN_CAP (1u << 18)
__device__ __forceinline__ unsigned xb_ld(unsigned* p)              { return __hip_atomic_load(p, __ATOMIC_RELAXED, __HIP_MEMORY_SCOPE_AGENT); }
__device__ __forceinline__ unsigned xb_add(unsigned* p, unsigned v) { return __hip_atomic_fetch_add(p, v, __ATOMIC_RELAXED, __HIP_MEMORY_SCOPE_AGENT); }
__device__ __forceinline__ unsigned xb_xcc_id() { return (unsigned)__builtin_amdgcn_s_getreg((3 << 11) | 20) & 0xFu; }
#define XB_SPIN(cond, bar) do { unsigned _sp = 0; while (cond) { __builtin_amdgcn_s_sleep(1); \
    if ((++_sp & 255u) == 0u) { if (xb_ld(&(bar)[XB_TMO])) break; if (_sp > XB_SPIN_CAP) { atomicAdd(&(bar)[XB_TMO], 1u); break; } } } } while (0)
struct XcdBarrier { unsigned* bar; unsigned x; volatile LAS unsigned* st; };
__device__ __forceinline__ XcdBarrier xcd_barrier_post(unsigned* bar, volatile LAS unsigned* st) {
    XcdBarrier b; b.bar = bar; b.x = xb_xcc_id(); b.st = st;
    if (threadIdx.x == 0) (void)xb_add(&bar[XB_XCNT(b.x)], 1u);
    return b;
}
__device__ __forceinline__ void xcd_barrier_complete(unsigned* bar, unsigned x, unsigned& nloc, unsigned& nx) {
    const unsigned G = gridDim.x * gridDim.y * gridDim.z;
    unsigned sum, cnt, mine, sp = 0u;
    for (;;) {
        sum = 0u; cnt = 0u; mine = 0u;
#pragma unroll
        for (unsigned j = 0; j < 16; ++j) { const unsigned c = xb_ld(&bar[XB_XCNT(j)]); sum += c; cnt += (c > 0u) ? 1u : 0u; mine = (j == x) ? c : mine; }
        if (sum == G) break;
        __builtin_amdgcn_s_sleep(1);
        if ((++sp & 255u) == 0u) { if (xb_ld(&bar[XB_TMO])) break; if (sp > XB_SPIN_CAP) { atomicAdd(&bar[XB_TMO], 1u); break; } }
    }
    nloc = mine > 0u ? mine : 1u; nx = cnt > 0u ? cnt : 1u;
}
__device__ __forceinline__ void xcd_barrier(const XcdBarrier& b) {
    asm volatile("s_waitcnt vmcnt(0)" ::: "memory");
    __syncthreads();
    if (threadIdx.x == 0) {
        unsigned* bar = b.bar;
        __builtin_amdgcn_s_waitcnt(0);
        unsigned nloc = b.st[0], nx = b.st[1];
        if (nloc == 0u) { xcd_barrier_complete(bar, b.x, nloc, nx); b.st[0] = nloc; b.st[1] = nx; }
        const unsigned old = xb_add(&bar[XB_XSUB(b.x)], 1u);
        const unsigned gen = old / nloc;
        if (old + 1u == (gen + 1u) * nloc) {
            __builtin_amdgcn_fence(__ATOMIC_RELEASE, "agent");
            asm volatile("s_waitcnt vmcnt(0)" ::: "memory");
            const unsigned og = xb_add(&bar[XB_TOP], 1u);
            const unsigned tg = og / nx;
            if (og + 1u == (tg + 1u) * nx) xb_add(&bar[XB_TOPGEN], 1u);
            else XB_SPIN(xb_ld(&bar[XB_TOPGEN]) == tg, bar);
            __builtin_amdgcn_fence(__ATOMIC_ACQUIRE, "agent");
            xb_add(&bar[XB_XGEN(b.x)], 1u);
            asm volatile("s_waitcnt vmcnt(0)" ::: "memory");
        } else {
            XB_SPIN(xb_ld(&bar[XB_XGEN(b.x)]) == gen, bar);
            __builtin_amdgcn_fence(__ATOMIC_ACQUIRE, "agent");
            asm volatile("s_waitcnt vmcnt(0)" ::: "memory");
        }
    }
    __syncthreads();
}

__device__ __forceinline__ void moe_load_tab(int r, unsigned char* ws, LAS int* tab) {
    const int* RTAB = (const int*)(ws + WS_RTAB) + r * 256;
    __syncthreads();
    if (threadIdx.x < 65) tab[threadIdx.x] = RTAB[threadIdx.x];
    if (threadIdx.x < 64) tab[128 + threadIdx.x] = RTAB[128 + threadIdx.x];
    LDS_WAIT(); __syncthreads();
}
__device__ __forceinline__ void moe_gateup(int r, unsigned char* ws, LAS unsigned char* lds, int vcu, int G) {
    LAS int* tok = (LAS int*)(lds + TOK_OFF); LAS int* tab = (LAS int*)(lds + TOK_OFF + 8192);
    moe_load_tab(r, ws, tab);
    const int NT = tab[64], U = 2 * (NT + SH_TILES);
    MoeSched S; S.tab = tab; S.NT = NT; S.U = U; S.G = G; S.vcu = vcu; S.npn = 2; S.lg = 1; S.A = (const char*)(ws + R_H); S.B = (const char*)(ws + WS_WGU);
    S.atile = 0; S.btile_e = (size_t)512 * 1024 * 2; S.btile_n = (size_t)256 * 1024 * 2;
    const int* SLOTTOK = (const int*)(ws + WS_SLOTTOK) + (size_t)r * RT_MAX * 256;
    { pg8::Unit u;
      for (int i = 0; S.next(i, u) && i < 8; ++i) {
          if (threadIdx.x < 256) { const int row = threadIdx.x; int tk;
              if (u.aux) { const int valid = tab[128 + u.e] - (u.pm - tab[u.e]) * 256; tk = (row < valid) ? SLOTTOK[u.pm * 256 + row] : r * HALF_T; }
              else tk = r * HALF_T + (u.pm - RT_MAX) * 256 + row;
              tok[i * 256 + row] = tk; } } }
    LDS_WAIT(); __syncthreads();
    EpiGateUp E{(bf16_t*)(ws + R_ACT)};
    pg8::gemm_phase<EpiGateUp, MoeSched, true>(lds, 1024, 1024, 1024, S, E, tok);
}
__device__ __forceinline__ void moe_down(int r, unsigned char* ws, LAS unsigned char* lds, int vcu, int G) {
    LAS int* tab = (LAS int*)(lds + TOK_OFF + 8192);
    moe_load_tab(r, ws, tab);
    const int NT = tab[64], U = 4 * (NT + SH_TILES);
    MoeSched S; S.tab = tab; S.NT = NT; S.U = U; S.G = G; S.vcu = vcu; S.npn = 4; S.lg = 2; S.A = (const char*)(ws + R_ACT); S.B = (const char*)(ws + WS_WDN);
    S.atile = (size_t)256 * 256 * 2; S.btile_e = (size_t)1024 * 256 * 2; S.btile_n = (size_t)256 * 256 * 2;
    EpiDown E{(bf16_t*)(ws + R_Y)};
    int Kd = 256; asm volatile("" : "+s"(Kd));
    pg8::gemm_phase<EpiDown, MoeSched, false>(lds, Kd, 256, 256, S, E, nullptr);
}

enum { PH_PRO = 0, PH_NORM1, PH_INPROJ, PH_MIX, PH_BRANCH, PH_OUT, PH_TOK2, PH_PLACE, PH_GU0, PH_DN0, PH_CMB0_GU1, PH_DN1, PH_CMB1, NPHASE };
struct Args { const float* in[28]; float* out; unsigned char* ws; int ph_lo, ph_hi, li, pad; };

__global__ void __launch_bounds__(NWAVES * 64, 2) hybrid_fwd(Args args) {
    extern __shared__ __attribute__((aligned(16))) unsigned char lds_raw[];
    LAS unsigned char* lds = (LAS unsigned char*)lds_raw;
    volatile LAS unsigned* MISC = (volatile LAS unsigned*)(lds + MISC_OFF);
    const int tid = threadIdx.x; const int wave = __builtin_amdgcn_readfirstlane(tid >> 6);
    const int G = gridDim.x; const int bx = blockIdx.x; const int vcu = (G % 8 == 0) ? (bx % 8) * (G / 8) + bx / 8 : bx;
    unsigned char* ws = args.ws; float* out = args.out;
    In in;
    in.x = args.in[0]; in.c = args.in[1]; in.w_ada = args.in[2]; in.b_ada = args.in[3]; in.g_pre_mix = args.in[4]; in.g_post_mix = args.in[5]; in.g_pre_ffn = args.in[6]; in.g_post_ffn = args.in[7];
    in.w_in = args.in[8]; in.b_forget = args.in[9]; in.w_conv = args.in[10]; in.b_conv = args.in[11]; in.w_rg = args.in[12]; in.b_rg = args.in[13]; in.w_ig = args.in[14]; in.b_ig = args.in[15]; in.lam = args.in[16];
    in.w_ba = args.in[17]; in.w_br = args.in[18]; in.w_out = args.in[19]; in.w_router = args.in[20]; in.r_bias = args.in[21]; in.w_eg = args.in[22]; in.w_eu = args.in[23]; in.w_ed = args.in[24];
    in.w_sg = args.in[25]; in.w_su = args.in[26]; in.w_sd = args.in[27];
    for (int u = tid; u < 256; u += NWAVES * 64) ((LAS unsigned*)(lds + LDSCTL_OFF))[u] = 0u;
    __syncthreads();
    const int lo = args.ph_lo, hi = args.ph_hi;
    XcdBarrier bar; bar.bar = (unsigned*)(ws + WS_CTL) + CW_BAR; bar.x = 0; bar.st = nullptr;
    if (hi - lo > 1) bar = xcd_barrier_post((unsigned*)(ws + WS_CTL) + CW_BAR + args.li * XCD_BAR_WORDS, MISC + 8);
#ifndef PHASE_MASK
#define PHASE_MASK 0xFFFF
#endif
#define IN(k) (((PHASE_MASK >> (k)) & 1) && lo <= (k) && (k) < hi)
#define SEAM(k) do { if (IN(k) && IN((k) + 1)) xcd_barrier(bar); } while (0)

    if (IN(PH_PRO)) { p0_prologue(in, ws, lds, vcu, G); }
    SEAM(PH_PRO);
    if (IN(PH_NORM1)) { for (int tile = vcu; tile < 256; tile += G) p1_norm(tile, in, ws, lds); }
    SEAM(PH_NORM1);
    if (IN(PH_INPROJ)) {
        DenseSched S; S.init(T, NIN, G, bx, ws + R_H, 1024, ws + WS_WIN, 1024);
        EpiInProj E{(bf16_t*)(ws + R_QKV), (bf16_t*)(ws + R_XG), (bf16_t*)(ws + R_GT)};
        __syncthreads();
        pg8::gemm_phase<EpiInProj, DenseSched, false>(lds, 1024, 1024, 1024, S, E, nullptr);
    }
    SEAM(PH_INPROJ);
    if (IN(PH_MIX)) {
        for (int u = vcu; u < NBATCH * NHEAD; u += G) { __syncthreads(); att::attn_bh(u >> 3, u & 7, (bf16_t*)(ws + R_QKV), (const float*)(ws + WS_LCUM), (const float*)(ws + WS_TOT), lds); }
        for (int u = vcu; u < NBATCH * 16; u += G) rnn::rnn_unit(u >> 4, u & 15, (bf16_t*)(ws + R_XG), (const bf16_t*)(ws + WS_WRNN), in.w_conv, in.b_conv, in.b_rg, in.b_ig, in.lam, lds);
    }
    SEAM(PH_MIX);
    if (IN(PH_BRANCH)) {
        { DenseSched S; S.init(T, 1024, G, bx, ws + R_QKV, 1536, ws + WS_WBA, 512);
          EpiBranch<0> E{(const bf16_t*)(ws + R_GT), 2048, (bf16_t*)(ws + R_QKV) + 512, 1536};
          __syncthreads();
          pg8::gemm_phase<EpiBranch<0>, DenseSched, false>(lds, 512, 1536, 512, S, E, nullptr); }
        { DenseSched S; S.init(T, 1024, G, bx, (bf16_t*)(ws + R_XG) + 1024, 2048, ws + WS_WBR, 1024);
          EpiBranch<1> E{(const bf16_t*)(ws + R_GT) + 1024, 2048, (bf16_t*)(ws + R_QKV) + 512, 1536};
          __syncthreads();
          pg8::gemm_phase<EpiBranch<1>, DenseSched, false>(lds, 1024, 2048, 1024, S, E, nullptr); }
    }
    SEAM(PH_BRANCH);
    if (IN(PH_OUT)) {
        DenseSched S; S.init(T, 1024, G, bx, (bf16_t*)(ws + R_QKV) + 512, 1536, ws + WS_WOUT, 1024);
        EpiOut E{(bf16_t*)(ws + R_H), (float*)(ws + WS_SSQ)};
        __syncthreads();
        pg8::gemm_phase<EpiOut, DenseSched, false>(lds, 1024, 1536, 1024, S, E, nullptr);
    }
    SEAM(PH_OUT);
    if (IN(PH_TOK2)) { for (int tile = vcu; tile < 256; tile += G) p6::run(tile, in, out, ws, lds); }
    SEAM(PH_TOK2);
    if (IN(PH_PLACE)) { for (int tile = vcu; tile < 256; tile += G) p7_place(tile, ws, lds); }
    SEAM(PH_PLACE);
    if (IN(PH_GU0)) moe_gateup(0, ws, lds, vcu, G);
    SEAM(PH_GU0);
    if (IN(PH_DN0)) moe_down(0, ws, lds, vcu, G);
    SEAM(PH_DN0);
    if (IN(PH_CMB0_GU1)) { combine_round(0, in, out, ws, vcu * NWAVES + wave, G * NWAVES); moe_gateup(1, ws, lds, vcu, G); }
    SEAM(PH_CMB0_GU1);
    if (IN(PH_DN1)) moe_down(1, ws, lds, vcu, G);
    SEAM(PH_DN1);
    if (IN(PH_CMB1)) combine_round(1, in, out, ws, vcu * NWAVES + wave, G * NWAVES);
#undef IN
#undef SEAM
}

extern "C" void kernel_launch(void* const* d_in, const int* in_sizes, int n_in, void* d_out, int out_size, void* d_ws, size_t ws_size, hipStream_t stream) {
    static int grid = 0;
    if (grid == 0) {
        if (n_in != 28 || in_sizes[0] != T * D || out_size != T * D || ws_size < WS_END) { fprintf(stderr, "kernel_launch: unexpected shapes / workspace (n_in %d, ws %zu)\n", n_in, ws_size); grid = -1; return; }
        int dev = 0, cus = 0, per_cu = 0;
        if (hipGetDevice(&dev) != hipSuccess || hipDeviceGetAttribute(&cus, hipDeviceAttributeMultiprocessorCount, dev) != hipSuccess) { grid = -1; return; }
        if (hipFuncSetAttribute((const void*)hybrid_fwd, hipFuncAttributeMaxDynamicSharedMemorySize, LDS_BYTES) != hipSuccess) { fprintf(stderr, "kernel_launch: hipFuncSetAttribute failed\n"); grid = -1; return; }
        if (hipOccupancyMaxActiveBlocksPerMultiprocessor(&per_cu, (const void*)hybrid_fwd, NWAVES * 64, LDS_BYTES) != hipSuccess || per_cu < 1) { fprintf(stderr, "kernel_launch: occupancy query says %d\n", per_cu); per_cu = 1; }
        (void)hipGetLastError();
        grid = cus;
    }
    if (grid < 0) return;
    (void)hipMemsetAsync((char*)d_ws + WS_CTL, 0, CTL_ZERO_BYTES, stream);
    Args a{};
    for (int i = 0; i < 28; ++i) a.in[i] = (const float*)d_in[i];
    a.out = (float*)d_out; a.ws = (unsigned char*)d_ws;
#if MK_N_LAUNCHES == 1
    a.ph_lo = 0; a.ph_hi = NPHASE; a.li = 0;
    void* kargs[] = {&a};
    hipError_t e = hipLaunchCooperativeKernel((const void*)hybrid_fwd, dim3(grid), dim3(NWAVES * 64), kargs, LDS_BYTES, stream);
    if (e != hipSuccess) fprintf(stderr, "kernel_launch: cooperative launch failed: %s (grid %d)\n", hipGetErrorString(e), grid);
#else
    for (int li = 0; li < NPHASE; ++li) { a.ph_lo = li; a.ph_hi = li + 1; a.li = li;
        hipLaunchKernelGGL(hybrid_fwd, dim3(grid), dim3(NWAVES * 64), LDS_BYTES, stream, a); }
#endif
}
```

```cpp
#include <hip/hip_runtime.h>
#include <cstdio>
#include <cstdint>

#ifndef MK_N_LAUNCHES
#define MK_N_LAUNCHES 1
#endif

#define LAS __attribute__((address_space(3)))
#define GAS __attribute__((address_space(1)))
typedef unsigned short bf16_t;
typedef short bf16x8 __attribute__((ext_vector_type(8)));
typedef short s16x4 __attribute__((ext_vector_type(4)));
typedef float f32x4 __attribute__((ext_vector_type(4)));
typedef float f32x2 __attribute__((ext_vector_type(2)));
typedef float f32x16 __attribute__((ext_vector_type(16)));
typedef unsigned u32x4 __attribute__((ext_vector_type(4)));
typedef unsigned u32x2 __attribute__((ext_vector_type(2)));
typedef GAS unsigned gu32;

constexpr int T = 65536, D = 1024, NBATCH = 32, SEQ = 2048, NHEAD = 8, HD = 64;
constexpr int NIN = 5632;
constexpr int INCOLS = 5640;
constexpr int NEXP = 64, TOPK = 6, EFF = 256;
constexpr int RT_MAX = 832;
constexpr int SH_TILES = 128;
constexpr int RND_TILES = RT_MAX + SH_TILES;
constexpr int HALF_T = T / 2;
constexpr float NORM_EPS = 1e-6f;
constexpr float LOG2E = 1.4426950408889634f;
constexpr float QSCALE = 0.125f * LOG2E;

constexpr size_t MiB = 1u << 20, KiB = 1u << 10;
constexpr size_t WS_CTL = 0, CTL_ZERO_BYTES = 1 * MiB;
constexpr size_t WS_MOD = 1 * MiB;
constexpr size_t WS_TOT = 1 * MiB + 768 * KiB;
constexpr size_t WS_HIST = 2 * MiB;
constexpr size_t WS_RTAB = 2 * MiB + 64 * KiB;
constexpr size_t WS_LCUM = 3 * MiB;
constexpr size_t WS_SSQ = 5 * MiB;
constexpr size_t WS_EP = 9 * MiB;
constexpr size_t WS_EW = 11 * MiB;
constexpr size_t WS_POS = 13 * MiB;
constexpr size_t WS_SLOTTOK = 15 * MiB;
constexpr size_t WS_WF = 17 * MiB;
constexpr size_t WS_WRNN = 17 * MiB + 64 * KiB;
constexpr size_t WS_WROUT = 17 * MiB + 512 * KiB;
constexpr size_t WS_WIN = 18 * MiB;
constexpr size_t WS_WBA = 29 * MiB;
constexpr size_t WS_WBR = 30 * MiB;
constexpr size_t WS_WOUT = 32 * MiB;
constexpr size_t WS_WGU = 34 * MiB;
constexpr size_t WS_WDN = 99 * MiB;
constexpr size_t R_H = 144 * MiB;
constexpr size_t R_QKV = 272 * MiB;
constexpr size_t R_XG = 464 * MiB;
constexpr size_t R_GT = 720 * MiB;
constexpr size_t R_ACT = 272 * MiB;
constexpr size_t R_Y = 392 * MiB;
constexpr size_t WS_END = 976 * MiB;
static_assert(WS_WDN + (size_t)65 * 1024 * 256 * 2 <= R_H, "weights fit");
static_assert(R_Y + (size_t)RND_TILES * 256 * 1024 * 2 <= WS_END, "y fits");
static_assert(R_ACT + (size_t)RND_TILES * 256 * 256 * 2 <= R_Y, "act fits");

constexpr int CW_TMO = 0, CW_CODE = 1;
constexpr int CW_BAR = 4096;

constexpr int RING_BYTES = 131072;
constexpr int LDSCTL_OFF = RING_BYTES;
constexpr int MISC_OFF = LDSCTL_OFF + 320;
constexpr int TOK_OFF = RING_BYTES + 1024;
constexpr int LDS_BYTES = RING_BYTES + 1024 + 16384;
constexpr int NWAVES = 8;

#define RLX_AGENT __ATOMIC_RELAXED, __HIP_MEMORY_SCOPE_AGENT
#define LDS_WAIT() asm volatile("s_waitcnt lgkmcnt(0)" ::: "memory")
#define VM_WAIT() asm volatile("s_waitcnt vmcnt(0)" ::: "memory")

__device__ __forceinline__ unsigned f2bf(float f) { unsigned u = __builtin_bit_cast(unsigned, f); return (u + 0x7fffu + ((u >> 16) & 1u)) >> 16; }
__device__ __forceinline__ unsigned pk2(float lo, float hi) { return f2bf(lo) | (f2bf(hi) << 16); }
__device__ __forceinline__ float bf2f(unsigned short b) { return __builtin_bit_cast(float, (unsigned)b << 16); }
__device__ __forceinline__ float bflo(unsigned w) { return __builtin_bit_cast(float, w << 16); }
__device__ __forceinline__ float bfhi(unsigned w) { return __builtin_bit_cast(float, w & 0xffff0000u); }
__device__ __forceinline__ float fast_exp2(float x) { return __builtin_amdgcn_exp2f(x); }
__device__ __forceinline__ float fast_rcp(float x) { return __builtin_amdgcn_rcpf(x); }
__device__ __forceinline__ float sigmoidf_(float x) { return fast_rcp(1.0f + fast_exp2(-x * LOG2E)); }
__device__ __forceinline__ float wave_sum(float v) {
#pragma unroll
    for (int o = 1; o < 64; o <<= 1) v += __shfl_xor(v, o);
    return v;
}

namespace pg8 {
constexpr int BM = 256, BK = 64, HALF = 128, HTB = HALF * BK * 2, STAGE_BYTES = 8 * HTB;
__host__ __device__ __forceinline__ int lds_byte(int r, int c) { const int st = (r >> 4) * 2 + (c >> 5), rr = r & 15, cc = c & 31, ob = rr * 64 + cc * 2; return st * 1024 + (ob ^ (((ob >> 9) & 1) << 5)); }
__host__ __device__ __forceinline__ void stage_rc(int b, int& R, int& C) { const int st = b / 1024, sb = b % 1024, swz = sb ^ (((sb >> 9) & 1) << 5); R = (st >> 1) * 16 + swz / 64; C = (st & 1) * 32 + (swz % 64) / 2; }
__host__ __device__ __forceinline__ int perm32(int rho) { const int n = rho >> 4, i = rho & 15; return 8 * (i >> 2) + 4 * n + (i & 3); }

struct Unit { int pm, pn, e, aux; };

__device__ __forceinline__ unsigned cvt_pk_bf16(float lo, float hi) { unsigned r; asm volatile("v_cvt_pk_bf16_f32 %0, %1, %2" : "=v"(r) : "v"(lo), "v"(hi)); return r; }

template <class Epi, class Sched, bool GATHER>
__device__ __forceinline__ void gemm_phase(LAS unsigned char* lds, const int K, const int lda, const int ldb, const Sched& S, const Epi& E, const LAS int* tokLDS) {
    const int tid = threadIdx.x, wid = __builtin_amdgcn_readfirstlane(tid >> 6), lane = tid & 63, wr = wid >> 2, wc = wid & 3, fr = lane & 15, fq = lane >> 4;
    const int nt = K / BK;
    int Rr[2], Cc[2];
    unsigned voffB[2];
#pragma unroll
    for (int i = 0; i < 2; ++i) { int R, C; stage_rc(tid * 16 + i * 8192, R, C); Rr[i] = R; Cc[i] = C; const int Rb = (R & ~31) + perm32(R & 31); voffB[i] = (unsigned)(Rb * ldb + C) * 2u; }
    const size_t kstep = (size_t)(BK * 2);
    const size_t hstepB = (size_t)HALF * ldb * 2;
    const unsigned ldsw = (unsigned)wid * 1024u;
    const int aoff = lds_byte(wr * 64 + fr, fq * 8), boff = lds_byte(wc * 32 + fr, fq * 8);
#define PG8_SA(b, h) (((b) * 2 + (h)) * HTB)
#define PG8_SB(b, h) ((4 + (b) * 2 + (h)) * HTB)
#define PG8_STAGE2(bufoff, gbase, v0, v1) do { \
        __builtin_amdgcn_global_load_lds((const unsigned*)((const char*)(gbase) + (v0)), (LAS unsigned*)(lds + (bufoff) + ldsw), 16, 0, 0); \
        __builtin_amdgcn_global_load_lds((const unsigned*)((const char*)(gbase) + (v1)), (LAS unsigned*)(lds + (bufoff) + ldsw + 8192), 16, 0, 0); } while (0)
#define PG8_STAGEB(bufoff, gbase) PG8_STAGE2(bufoff, gbase, voffB[0], voffB[1])
#define PG8_LDA(dst, b, h) do { _Pragma("unroll") for (int m = 0; m < 4; ++m) _Pragma("unroll") for (int k = 0; k < 2; ++k) dst[m][k] = *(const LAS bf16x8*)(lds + PG8_SA(b, h) + aoff + m * 2048 + k * 1024); } while (0)
#define PG8_LDB(dst, b, h) do { _Pragma("unroll") for (int n = 0; n < 2; ++n) _Pragma("unroll") for (int k = 0; k < 2; ++k) dst[n][k] = *(const LAS bf16x8*)(lds + PG8_SB(b, h) + boff + n * 2048 + k * 1024); } while (0)
#define PG8_MMA(ai, bj, At, Bt) do { __builtin_amdgcn_s_setprio(1); _Pragma("unroll") for (int m = 0; m < 4; ++m) _Pragma("unroll") for (int n = 0; n < 2; ++n) _Pragma("unroll") for (int k = 0; k < 2; ++k) \
        acc[ai][bj][m][n] = __builtin_amdgcn_mfma_f32_16x16x32_bf16(Bt[n][k], At[m][k], acc[ai][bj][m][n], 0, 0, 0); __builtin_amdgcn_s_setprio(0); } while (0)
#define PG8_WAIT_V(n) asm volatile("s_waitcnt vmcnt(" #n ")" ::: "memory")
#define PG8_WAIT_L(n) asm volatile("s_waitcnt lgkmcnt(" #n ")" ::: "memory")
#define PG8_BAR __builtin_amdgcn_s_barrier()
#define PG8_SCHED __builtin_amdgcn_sched_barrier(0)
    Unit cur, nxt; int ui = 0;
    if (!S.next(0, cur)) return;
    unsigned vA0[2], vA1[2], nA0[2], nA1[2];
#pragma unroll
    for (int i = 0; i < 2; ++i) {
        if constexpr (GATHER) { vA0[i] = (unsigned)(tokLDS[Rr[i]] * lda + Cc[i]) * 2u; vA1[i] = (unsigned)(tokLDS[HALF + Rr[i]] * lda + Cc[i]) * 2u; }
        else { vA0[i] = (unsigned)(Rr[i] * lda + Cc[i]) * 2u; vA1[i] = (unsigned)((HALF + Rr[i]) * lda + Cc[i]) * 2u; }
        nA0[i] = vA0[i]; nA1[i] = vA1[i];
    }
    f32x4 acc[2][2][4][2];
#pragma unroll
    for (int a = 0; a < 2; ++a)
#pragma unroll
        for (int b = 0; b < 2; ++b)
#pragma unroll
            for (int m = 0; m < 4; ++m)
#pragma unroll
                for (int n = 0; n < 2; ++n) acc[a][b][m][n] = (f32x4){0.f, 0.f, 0.f, 0.f};
    bf16x8 At[4][2], B0[2][2], B1[2][2];
    const char* cA = S.aptr(cur); const char* cB = S.bptr(cur);
    PG8_STAGEB(PG8_SB(0, 0), cB); PG8_STAGEB(PG8_SB(0, 1), cB + hstepB); PG8_STAGE2(PG8_SA(0, 0), cA, vA0[0], vA0[1]); PG8_STAGE2(PG8_SA(0, 1), cA, vA1[0], vA1[1]);
    if (wr == 1) PG8_BAR;
    PG8_WAIT_V(2); PG8_BAR;
    PG8_STAGEB(PG8_SB(1, 0), cB + kstep); PG8_STAGE2(PG8_SA(1, 0), cA + kstep, vA0[0], vA0[1]); PG8_STAGEB(PG8_SB(1, 1), cB + hstepB + kstep);
    PG8_WAIT_V(6); PG8_BAR;
    for (;;) {
        const bool has_next = S.next(ui + 1, nxt);
        const char* nAp = has_next ? S.aptr(nxt) : cA; const char* nBp = has_next ? S.bptr(nxt) : cB;
        if constexpr (GATHER) {
            if (has_next) {
#pragma unroll
                for (int i = 0; i < 2; ++i) { nA0[i] = (unsigned)(tokLDS[(ui + 1) * 256 + Rr[i]] * lda + Cc[i]) * 2u; nA1[i] = (unsigned)(tokLDS[(ui + 1) * 256 + HALF + Rr[i]] * lda + Cc[i]) * 2u; }
            } else {
#pragma unroll
                for (int i = 0; i < 2; ++i) { nA0[i] = vA0[i]; nA1[i] = vA1[i]; }
            }
        }
        for (int t = 0; t < nt; t += 2) {
            const bool last = (t == nt - 2);
            const char* a1 = cA + (size_t)(t + 1) * kstep;
            const char* a2 = last ? nAp : cA + (size_t)(t + 2) * kstep; const char* b2 = last ? nBp : cB + (size_t)(t + 2) * kstep;
            const char* a3 = a2 + kstep; const char* b3 = b2 + kstep;
            unsigned w0[2], w1[2];
#pragma unroll
            for (int i = 0; i < 2; ++i) { w0[i] = (GATHER && last) ? nA0[i] : vA0[i]; w1[i] = (GATHER && last) ? nA1[i] : vA1[i]; }
            PG8_LDB(B0, 0, 0); PG8_LDB(B1, 0, 1); PG8_SCHED; PG8_LDA(At, 0, 0); PG8_STAGE2(PG8_SA(1, 1), a1, vA1[0], vA1[1]);
            PG8_WAIT_V(8); PG8_WAIT_L(0); PG8_BAR; PG8_MMA(0, 0, At, B0); PG8_MMA(0, 1, At, B1); PG8_BAR; PG8_SCHED;
            PG8_LDA(At, 0, 1); PG8_STAGEB(PG8_SB(0, 0), b2); PG8_STAGEB(PG8_SB(0, 1), b2 + hstepB); PG8_STAGE2(PG8_SA(0, 0), a2, w0[0], w0[1]);
            PG8_WAIT_V(8); PG8_WAIT_L(0); PG8_BAR; PG8_MMA(1, 0, At, B0); PG8_MMA(1, 1, At, B1); PG8_BAR; PG8_SCHED;
            PG8_LDB(B0, 1, 0); PG8_LDB(B1, 1, 1); PG8_SCHED; PG8_LDA(At, 1, 0); PG8_STAGE2(PG8_SA(0, 1), a2, w1[0], w1[1]);
            PG8_WAIT_V(8); PG8_WAIT_L(0); PG8_BAR; PG8_MMA(0, 0, At, B0); PG8_MMA(0, 1, At, B1); PG8_BAR; PG8_SCHED;
            PG8_LDA(At, 1, 1); PG8_STAGEB(PG8_SB(1, 0), b3); PG8_STAGEB(PG8_SB(1, 1), b3 + hstepB); PG8_STAGE2(PG8_SA(1, 0), a3, w0[0], w0[1]);
            PG8_WAIT_V(8); PG8_WAIT_L(0); PG8_BAR; PG8_MMA(1, 0, At, B0); PG8_MMA(1, 1, At, B1); PG8_BAR; PG8_SCHED;
        }
        if (wr == 0) PG8_BAR;
        E(acc, cur, wr, wc, fr, fq);
        if (!has_next) break;
#pragma unroll
        for (int a = 0; a < 2; ++a)
#pragma unroll
            for (int b = 0; b < 2; ++b)
#pragma unroll
                for (int m = 0; m < 4; ++m)
#pragma unroll
                    for (int n = 0; n < 2; ++n) acc[a][b][m][n] = (f32x4){0.f, 0.f, 0.f, 0.f};
        cur = nxt; cA = nAp; cB = nBp; ++ui;
        if constexpr (GATHER) {
#pragma unroll
            for (int i = 0; i < 2; ++i) { vA0[i] = nA0[i]; vA1[i] = nA1[i]; }
        }
        if (wr == 1) PG8_BAR;
    }
    PG8_WAIT_V(0);
    PG8_BAR;
#undef PG8_SA
#undef PG8_SB
#undef PG8_STAGE2
#undef PG8_STAGEB
#undef PG8_LDA
#undef PG8_LDB
#undef PG8_MMA
#undef PG8_WAIT_V
#undef PG8_WAIT_L
#undef PG8_BAR
#undef PG8_SCHED
}
}

struct DenseSched {
    int nM, nN, nwg, G, c; const char* A; const char* B; size_t atile, btile;
    __device__ __forceinline__ void init(int M, int N, int G_, int c_, const void* A_, int lda, const void* B_, int ldb) {
        nM = M / 256; nN = N / 256; nwg = nM * nN; G = G_; c = c_; A = (const char*)A_; B = (const char*)B_; atile = (size_t)256 * lda * 2; btile = (size_t)256 * ldb * 2; }
    __device__ __forceinline__ bool next(int i, pg8::Unit& u) const {
        const long L = (long)i * G + c; if (L >= nwg) return false;
        int wgid = (int)L; { const int q = nwg / 8, r = nwg % 8, xcd = wgid % 8, off = wgid / 8; wgid = (xcd < r ? xcd * (q + 1) : r * (q + 1) + (xcd - r) * q) + off; }
        const int nig = 8 * nN, gid = wgid / nig, fm = gid * 8, gsz = (nM - fm) < 8 ? (nM - fm) : 8;
        u.pm = fm + ((wgid % nig) % gsz); u.pn = (wgid % nig) / gsz; u.e = 0; u.aux = 0; return true;
    }
    __device__ __forceinline__ const char* aptr(const pg8::Unit& u) const { return A + (size_t)u.pm * atile; }
    __device__ __forceinline__ const char* bptr(const pg8::Unit& u) const { return B + (size_t)u.pn * btile; }
};

struct MoeSched {
    const LAS int* tab;
    int NT, U, G, vcu, npn, lg; const char* A; const char* B; size_t atile, btile_e, btile_n;
    __device__ __forceinline__ bool next(int i, pg8::Unit& u) const {
        const int id = i * G + vcu; if (id >= U) return false;
        const int ri = id >> lg; u.pn = id & (npn - 1);
        if (ri < NT) { int e = 0;
#pragma unroll 8
            for (int j = 1; j <= 64; ++j) e += (tab[j] <= ri) ? 1 : 0;
            u.e = e; u.pm = ri; u.aux = 1; }
        else { u.e = 64; u.pm = RT_MAX + (ri - NT); u.aux = 0; }
        return true;
    }
    __device__ __forceinline__ const char* aptr(const pg8::Unit& u) const { return A + (size_t)u.pm * atile; }
    __device__ __forceinline__ const char* bptr(const pg8::Unit& u) const { return B + (size_t)u.e * btile_e + (size_t)u.pn * btile_n; }
};

#define EPI_ARGS const f32x4 (&acc)[2][2][4][2], const pg8::Unit& u, int wr, int wc, int fr, int fq
struct EpiInProj {
    bf16_t* qkv; bf16_t* xg; bf16_t* gt;
    __device__ __forceinline__ void operator()(EPI_ARGS) const {
        bf16_t* base; int ld, colt; float sc = 1.f;
        if (u.pn < 6) { base = qkv; ld = 1536; colt = u.pn * 256; if (u.pn < 2) sc = QSCALE; }
        else if (u.pn < 14) { base = xg; ld = 2048; colt = (u.pn - 6) * 256; }
        else { base = gt; ld = 2048; colt = (u.pn - 14) * 256; }
        const int row0 = u.pm * 256 + wr * 64 + fr, col0 = colt + wc * 32 + 8 * fq;
#pragma unroll
        for (int ai = 0; ai < 2; ++ai)
#pragma unroll
            for (int m = 0; m < 4; ++m) { bf16_t* rowp = base + (size_t)(row0 + ai * 128 + m * 16) * ld + col0;
#pragma unroll
                for (int bj = 0; bj < 2; ++bj) { const f32x4 v0 = acc[ai][bj][m][0] * sc, v1 = acc[ai][bj][m][1] * sc;
                    u32x4 w; w.x = pg8::cvt_pk_bf16(v0[0], v0[1]); w.y = pg8::cvt_pk_bf16(v0[2], v0[3]); w.z = pg8::cvt_pk_bf16(v1[0], v1[1]); w.w = pg8::cvt_pk_bf16(v1[2], v1[3]);
                    *(u32x4*)(rowp + bj * 128) = w; } }
    }
};
template <int MODE> struct EpiBranch {
    const bf16_t* gate; int ldg; bf16_t* mg; int ldm;
    __device__ __forceinline__ void operator()(EPI_ARGS) const {
        const int row0 = u.pm * 256 + wr * 64 + fr, col0 = u.pn * 256 + wc * 32 + 8 * fq;
#pragma unroll
        for (int ai = 0; ai < 2; ++ai)
#pragma unroll
            for (int m = 0; m < 4; ++m) { const size_t r = (size_t)(row0 + ai * 128 + m * 16);
#pragma unroll
                for (int bj = 0; bj < 2; ++bj) {
                    const u32x4 g = *(const u32x4*)(gate + r * ldg + col0 + bj * 128);
                    bf16_t* mp = mg + r * ldm + col0 + bj * 128;
                    f32x4 v0 = acc[ai][bj][m][0], v1 = acc[ai][bj][m][1];
                    v0[0] *= sigmoidf_(bflo(g.x)); v0[1] *= sigmoidf_(bfhi(g.x)); v0[2] *= sigmoidf_(bflo(g.y)); v0[3] *= sigmoidf_(bfhi(g.y));
                    v1[0] *= sigmoidf_(bflo(g.z)); v1[1] *= sigmoidf_(bfhi(g.z)); v1[2] *= sigmoidf_(bflo(g.w)); v1[3] *= sigmoidf_(bfhi(g.w));
                    if (MODE == 1) { const u32x4 o = *(const u32x4*)mp;
                        v0[0] += bflo(o.x); v0[1] += bfhi(o.x); v0[2] += bflo(o.y); v0[3] += bfhi(o.y); v1[0] += bflo(o.z); v1[1] += bfhi(o.z); v1[2] += bflo(o.w); v1[3] += bfhi(o.w); }
                    u32x4 w; w.x = pg8::cvt_pk_bf16(v0[0], v0[1]); w.y = pg8::cvt_pk_bf16(v0[2], v0[3]); w.z = pg8::cvt_pk_bf16(v1[0], v1[1]); w.w = pg8::cvt_pk_bf16(v1[2], v1[3]);
                    *(u32x4*)mp = w; } }
    }
};
struct EpiOut {
    bf16_t* mo; float* ssq;
    __device__ __forceinline__ void operator()(EPI_ARGS) const {
        const int row0 = u.pm * 256 + wr * 64 + fr, col0 = u.pn * 256 + wc * 32 + 8 * fq;
#pragma unroll
        for (int ai = 0; ai < 2; ++ai)
#pragma unroll
            for (int m = 0; m < 4; ++m) { const size_t r = (size_t)(row0 + ai * 128 + m * 16); float s = 0.f;
#pragma unroll
                for (int bj = 0; bj < 2; ++bj) { const f32x4 v0 = acc[ai][bj][m][0], v1 = acc[ai][bj][m][1];
                    s += (v0[0] * v0[0] + v0[1] * v0[1]) + (v0[2] * v0[2] + v0[3] * v0[3]) + (v1[0] * v1[0] + v1[1] * v1[1]) + (v1[2] * v1[2] + v1[3] * v1[3]);
                    u32x4 w; w.x = pg8::cvt_pk_bf16(v0[0], v0[1]); w.y = pg8::cvt_pk_bf16(v0[2], v0[3]); w.z = pg8::cvt_pk_bf16(v1[0], v1[1]); w.w = pg8::cvt_pk_bf16(v1[2], v1[3]);
                    *(u32x4*)(mo + r * 1024 + col0 + bj * 128) = w; }
                s += __shfl_xor(s, 16); s += __shfl_xor(s, 32);
                if (fq == 0) ssq[r * 16 + u.pn * 4 + wc] = s; }
    }
};
struct EpiGateUp {
    bf16_t* act;
    __device__ __forceinline__ void operator()(EPI_ARGS) const {
        const int row0 = u.pm * 256 + wr * 64 + fr, col0 = u.pn * 128 + wc * 32 + 8 * fq;
#pragma unroll
        for (int ai = 0; ai < 2; ++ai)
#pragma unroll
            for (int m = 0; m < 4; ++m) { const size_t r = (size_t)(row0 + ai * 128 + m * 16);
                float v[8];
#pragma unroll
                for (int n = 0; n < 2; ++n)
#pragma unroll
                    for (int e = 0; e < 4; ++e) { const float g = acc[ai][0][m][n][e], up = acc[ai][1][m][n][e]; v[n * 4 + e] = g * sigmoidf_(g) * up; }
                u32x4 w; w.x = pg8::cvt_pk_bf16(v[0], v[1]); w.y = pg8::cvt_pk_bf16(v[2], v[3]); w.z = pg8::cvt_pk_bf16(v[4], v[5]); w.w = pg8::cvt_pk_bf16(v[6], v[7]);
                *(u32x4*)(act + r * 256 + col0) = w; }
    }
};
struct EpiDown {
    bf16_t* y;
    __device__ __forceinline__ void operator()(EPI_ARGS) const {
        const int row0 = u.pm * 256 + wr * 64 + fr, col0 = u.pn * 256 + wc * 32 + 8 * fq;
#pragma unroll
        for (int ai = 0; ai < 2; ++ai)
#pragma unroll
            for (int m = 0; m < 4; ++m) { bf16_t* rowp = y + (size_t)(row0 + ai * 128 + m * 16) * 1024 + col0;
#pragma unroll
                for (int bj = 0; bj < 2; ++bj) { const f32x4 v0 = acc[ai][bj][m][0], v1 = acc[ai][bj][m][1];
                    u32x4 w; w.x = pg8::cvt_pk_bf16(v0[0], v0[1]); w.y = pg8::cvt_pk_bf16(v0[2], v0[3]); w.z = pg8::cvt_pk_bf16(v1[0], v1[1]); w.w = pg8::cvt_pk_bf16(v1[2], v1[3]);
                    *(u32x4*)(rowp + bj * 128) = w; } }
    }
};

namespace att {
constexpr int PITCH = 1536, QB = 256, KVBLK = 64, SLOTB = 8192;
constexpr int L_K = 0, L_V = 2 * SLOTB, L_WS = 4 * SLOTB, L_CUM = L_WS + 8 * 64 * 4, L_OST = L_CUM + SEQ * 4, L_END = L_OST + 8 * 4096;
static_assert(L_END <= RING_BYTES, "attention LDS");
__device__ __forceinline__ int crow(int r, int hi) { return (r & 3) + 8 * (r >> 2) + 4 * hi; }
__device__ __forceinline__ void glds16(const void* gsrc, unsigned lds_dst) { unsigned keep;
    asm volatile("s_mov_b32 %0, m0\n\ts_mov_b32 m0, %2\n\ts_nop 0\n\tglobal_load_lds_dwordx4 %1, off\n\ts_mov_b32 m0, %0" : "=&s"(keep) : "v"(gsrc), "s"(lds_dst) : "memory"); }
__device__ __forceinline__ unsigned cvtpk(float lo, float hi) { unsigned r; asm volatile("v_cvt_pk_bf16_f32 %0, %1, %2" : "=v"(r) : "v"(lo), "v"(hi)); return r; }

__device__ __forceinline__ void pv(f32x16* o, int vb, bf16x8 pa0, bf16x8 pa1, bf16x8 pa2, bf16x8 pa3) {
#pragma unroll
    for (int d0 = 0; d0 < 2; ++d0) { s16x4 lo[4], hi[4];
#pragma unroll
        for (int ks = 0; ks < 4; ++ks) {
            asm volatile("ds_read_b64_tr_b16 %0,%1 offset:%c2" : "=&v"(lo[ks]) : "v"(vb), "i"(d0 * 4096 + ks * 1024) : "memory");
            asm volatile("ds_read_b64_tr_b16 %0,%1 offset:%c2" : "=&v"(hi[ks]) : "v"(vb), "i"(d0 * 4096 + ks * 1024 + 512) : "memory"); }
        asm volatile("s_waitcnt lgkmcnt(0)" ::: "memory"); __builtin_amdgcn_sched_barrier(0);
#define PK(k) (bf16x8){lo[k][0], lo[k][1], lo[k][2], lo[k][3], hi[k][0], hi[k][1], hi[k][2], hi[k][3]}
        o[d0] = __builtin_amdgcn_mfma_f32_32x32x16_bf16(pa0, PK(0), o[d0], 0, 0, 0);
        o[d0] = __builtin_amdgcn_mfma_f32_32x32x16_bf16(pa1, PK(1), o[d0], 0, 0, 0);
        o[d0] = __builtin_amdgcn_mfma_f32_32x32x16_bf16(pa2, PK(2), o[d0], 0, 0, 0);
        o[d0] = __builtin_amdgcn_mfma_f32_32x32x16_bf16(pa3, PK(3), o[d0], 0, 0, 0);
#undef PK
    }
}

__device__ __forceinline__ void attn_bh(int b, int h, bf16_t* qkv, const float* lcum, const float* tot, LAS unsigned char* lds) {
    const int tid = threadIdx.x, lane = tid & 63, r32 = lane & 31, hi = lane >> 5; const int wid = __builtin_amdgcn_readfirstlane(tid >> 6);
    LAS float* cumT = (LAS float*)(lds + L_CUM);
    LAS float* wsf = (LAS float*)(lds + L_WS) + wid * 64;
    const long rowbase = (long)b * SEQ;
    for (int i = tid; i < SEQ; i += 512) { float off = 0.f; const int ti = i >> 8;
        for (int j = 0; j < ti; ++j) off += tot[(b * 8 + j) * 8 + h];
        cumT[i] = lcum[(rowbase + i) * 8 + h] + off; }
    LDS_WAIT(); __syncthreads();
    const unsigned lds0 = (unsigned)(uintptr_t)lds;
    const bf16_t* Kh = qkv + rowbase * PITCH + 512 + h * 64; const bf16_t* Vh = qkv + rowbase * PITCH + 1024 + h * 64;
    const bf16_t* ksrc = Kh + (long)lane * PITCH + wid * 8;
    const bf16_t* vsrc = Vh + (long)(16 * (wid & 3) + (lane >> 2)) * PITCH + (wid >> 2) * 32 + (lane & 3) * 8;
    const unsigned kdst = lds0 + L_K + wid * 1024, vdst = lds0 + L_V + wid * 1024;
    const int vb0 = (int)(lds0 + L_V) + ((lane >> 4) & 1) * 32 + (lane & 3) * 8 + (4 * hi + ((lane & 15) >> 2)) * 64;
    for (int qb = 7; qb >= 0; --qb) {
        const int q0 = qb * QB;
        bf16_t* Qw = qkv + (rowbase + q0 + wid * 32) * PITCH + h * 64;
        bf16x8 qr[4];
#pragma unroll
        for (int d0 = 0; d0 < 4; ++d0) qr[d0] = *(const bf16x8*)(Qw + (long)r32 * PITCH + d0 * 16 + hi * 8);
        const int qrel = wid * 32 + r32;
        const float cq = cumT[q0 + qrel];
        float mrun = -1e30f, lrun = 0.f; f32x16 o[2]; o[0] = f32x16{}; o[1] = f32x16{};
        const int NT = (q0 + QB) / KVBLK;
        glds16(ksrc, (unsigned)__builtin_amdgcn_readfirstlane(kdst)); glds16(vsrc, (unsigned)__builtin_amdgcn_readfirstlane(vdst));
        for (int t = 0; t < NT; ++t) {
            const int slot = (t & 1) * SLOTB;
            asm volatile("s_waitcnt vmcnt(0) lgkmcnt(0)\n\ts_barrier" ::: "memory");
            if (t + 1 < NT) { const int ns = ((t + 1) & 1) * SLOTB;
                glds16(ksrc + (long)(t + 1) * KVBLK * PITCH, (unsigned)__builtin_amdgcn_readfirstlane(kdst + ns));
                glds16(vsrc + (long)(t + 1) * KVBLK * PITCH, (unsigned)__builtin_amdgcn_readfirstlane(vdst + ns)); }
            f32x16 p0, p1;
            const LAS float* ck = cumT + t * KVBLK + 4 * hi;
#pragma unroll
            for (int g = 0; g < 4; ++g) { const f32x4 c0 = *(const LAS f32x4*)(ck + 8 * g), c1 = *(const LAS f32x4*)(ck + 32 + 8 * g);
#pragma unroll
                for (int e = 0; e < 4; ++e) { p0[4 * g + e] = cq - c0[e]; p1[4 * g + e] = cq - c1[e]; } }
            const LAS unsigned char* kb = lds + L_K + slot + hi * 1024 + r32 * 16;
#pragma unroll
            for (int d0 = 0; d0 < 4; ++d0) { const bf16x8 b0 = *(const LAS bf16x8*)(kb + d0 * 2048), b1 = *(const LAS bf16x8*)(kb + d0 * 2048 + 512);
                p0 = __builtin_amdgcn_mfma_f32_32x32x16_bf16(b0, qr[d0], p0, 0, 0, 0); p1 = __builtin_amdgcn_mfma_f32_32x32x16_bf16(b1, qr[d0], p1, 0, 0, 0); }
            const int jb = t - (NT - 4);
            if (jb >= 0) { const int kb0 = 64 * jb + 4 * hi;
#pragma unroll
                for (int r = 0; r < 16; ++r) { const int kv = kb0 + (r & 3) + 8 * (r >> 2); if (kv > qrel) p0[r] = -INFINITY; if (kv + 32 > qrel) p1[r] = -INFINITY; } }
            float rm = p0[0];
#pragma unroll
            for (int r = 1; r < 16; ++r) rm = fmaxf(rm, p0[r]);
#pragma unroll
            for (int r = 0; r < 16; ++r) rm = fmaxf(rm, p1[r]);
            rm = fmaxf(rm, __shfl_xor(rm, 32));
            const float mn = fmaxf(mrun, rm), alpha = fast_exp2(mrun - mn); mrun = mn;
            float ls = 0.f;
#pragma unroll
            for (int r = 0; r < 16; ++r) { p0[r] = fast_exp2(p0[r] - mn); p1[r] = fast_exp2(p1[r] - mn); ls += p0[r] + p1[r]; }
            lrun = lrun * alpha + ls;
            if (hi == 0) wsf[r32] = alpha;
            asm volatile("s_waitcnt lgkmcnt(0)" ::: "memory");
#pragma unroll
            for (int r = 0; r < 16; ++r) { const float a = wsf[crow(r, hi)]; o[0][r] *= a; o[1][r] *= a; }
            u32x4 pw0, pw1, pw2, pw3;
            pw0 = (u32x4){cvtpk(p0[0], p0[1]), cvtpk(p0[2], p0[3]), cvtpk(p0[4], p0[5]), cvtpk(p0[6], p0[7])};
            pw1 = (u32x4){cvtpk(p0[8], p0[9]), cvtpk(p0[10], p0[11]), cvtpk(p0[12], p0[13]), cvtpk(p0[14], p0[15])};
            pw2 = (u32x4){cvtpk(p1[0], p1[1]), cvtpk(p1[2], p1[3]), cvtpk(p1[4], p1[5]), cvtpk(p1[6], p1[7])};
            pw3 = (u32x4){cvtpk(p1[8], p1[9]), cvtpk(p1[10], p1[11]), cvtpk(p1[12], p1[13]), cvtpk(p1[14], p1[15])};
            asm volatile("s_waitcnt lgkmcnt(0)" ::: "memory"); __builtin_amdgcn_sched_barrier(0);
            pv(o, vb0 + slot, __builtin_bit_cast(bf16x8, pw0), __builtin_bit_cast(bf16x8, pw1), __builtin_bit_cast(bf16x8, pw2), __builtin_bit_cast(bf16x8, pw3));
        }
        lrun += __shfl_xor(lrun, 32);
        if (hi == 0) wsf[32 + r32] = lrun;
        asm volatile("s_waitcnt lgkmcnt(0)" ::: "memory");
        float rli[16];
#pragma unroll
        for (int r = 0; r < 16; ++r) rli[r] = fast_rcp(wsf[32 + crow(r, hi)]);
        { LAS bf16_t* stg = (LAS bf16_t*)(lds + L_OST) + wid * 2048;
#pragma unroll
            for (int r = 0; r < 16; ++r) { const int orow = crow(r, hi);
#pragma unroll
                for (int d0 = 0; d0 < 2; ++d0) stg[orow * 64 + d0 * 32 + r32] = (bf16_t)f2bf(o[d0][r] * rli[r]); }
            asm volatile("s_waitcnt lgkmcnt(0)" ::: "memory");
#pragma unroll
            for (int i = 0; i < 4; ++i) { const int row = i * 8 + (lane >> 3), ch = lane & 7; const u32x4 v = *(const LAS u32x4*)(stg + row * 64 + ch * 8); *(u32x4*)(Qw + (long)row * PITCH + ch * 8) = v; } }
        asm volatile("s_waitcnt vmcnt(0) lgkmcnt(0)\n\ts_barrier" ::: "memory");
    }
}
}

namespace rnn {
constexpr int L_W = 0, L_CW = 24576, L_GB = 26112, L_SUM = 28672, L_PARK = 36864, L_CARRY = 40960;
__device__ __forceinline__ void rnn_unit(int b, int blk, bf16_t* xg, const bf16_t* wfrag, const float* w_conv, const float* b_conv,
                                         const float* b_rg, const float* b_ig, const float* lam, LAS unsigned char* lds) {
    const int tid = threadIdx.x, lane = tid & 63, n31 = lane & 31, hh = lane >> 5; const int wid = __builtin_amdgcn_readfirstlane(tid >> 6);
    LAS float* cw = (LAS float*)(lds + L_CW);
    LAS float* gb = (LAS float*)(lds + L_GB);
    LAS float* sum = (LAS float*)(lds + L_SUM);
    LAS float* carry = (LAS float*)(lds + L_CARRY);
    LAS float* park = (LAS float*)(lds + L_PARK);
    __syncthreads();
    for (int i = tid; i < 1536; i += 512) *(LAS u32x4*)(lds + L_W + i * 16) = *(const u32x4*)((const char*)wfrag + (size_t)blk * 24576 + i * 16);
    if (tid < 256) cw[tid] = w_conv[(tid >> 6) * 1024 + blk * 64 + (tid & 63)];
    else if (tid < 320) cw[tid] = b_conv[blk * 64 + (tid - 256)];
    if (tid < 64) { gb[tid] = b_rg[blk * 64 + tid]; gb[64 + tid] = b_ig[blk * 64 + tid];
        const float l = lam[blk * 64 + tid]; const float sp = log1pf(expf(-l)); gb[128 + tid] = -8.0f * sp * LOG2E; carry[tid] = 0.f; }
    LDS_WAIT(); __syncthreads();
    const size_t colx = (size_t)blk * 64;
    for (int seg = 0; seg < 8; ++seg) {
        const int tl = seg * 256 + wid * 32;
        bf16x8 ua[4];
        { const int tok = tl + n31;
#pragma unroll
          for (int ks = 0; ks < 4; ++ks) { const int ch0 = 16 * ks + 8 * hh; float a8[8];
#pragma unroll
              for (int j = 0; j < 8; ++j) a8[j] = cw[256 + ch0 + j];
#pragma unroll
              for (int tap = 0; tap < 4; ++tap) { const int tt = tok - 3 + tap;
                  if (tt >= 0) { const u32x4 xv = *(const u32x4*)(xg + ((size_t)b * SEQ + tt) * 2048 + colx + ch0);
                      const LAS float* cwt = cw + tap * 64 + ch0;
                      a8[0] += cwt[0] * bflo(xv.x); a8[1] += cwt[1] * bfhi(xv.x); a8[2] += cwt[2] * bflo(xv.y); a8[3] += cwt[3] * bfhi(xv.y);
                      a8[4] += cwt[4] * bflo(xv.z); a8[5] += cwt[5] * bfhi(xv.z); a8[6] += cwt[6] * bflo(xv.w); a8[7] += cwt[7] * bfhi(xv.w); } }
              u32x4 w; w.x = pk2(a8[0], a8[1]); w.y = pk2(a8[2], a8[3]); w.z = pk2(a8[4], a8[5]); w.w = pk2(a8[6], a8[7]);
              ua[ks] = __builtin_bit_cast(bf16x8, w); } }
        f32x16 C[6];
#pragma unroll
        for (int nb = 0; nb < 6; ++nb) { C[nb] = f32x16{};
#pragma unroll
            for (int ks = 0; ks < 4; ++ks) { const bf16x8 wf = *(const LAS bf16x8*)(lds + L_W + ((nb * 4 + ks) * 64 + lane) * 16);
                C[nb] = __builtin_amdgcn_mfma_f32_32x32x16_bf16(ua[ks], wf, C[nb], 0, 0, 0); } }
        float hl[2][16], Pl[2][16];
#pragma unroll
        for (int cb = 0; cb < 2; ++cb) { const int n = 32 * cb + n31; const float brg = gb[n], big = gb[64 + n], cA = gb[128 + n];
#pragma unroll
            for (int r = 0; r < 16; ++r) { const float rg = sigmoidf_(C[cb][r] + brg), ig = sigmoidf_(C[2 + cb][r] + big);
                const float a = fast_exp2(cA * rg); const float mult = sqrtf(fmaxf(1.0f - a * a, 0.f));
                Pl[cb][r] = a; hl[cb][r] = mult * ig * C[4 + cb][r]; }
#pragma unroll
            for (int j = 0; j < 4; ++j) {
#pragma unroll
                for (int k = 1; k < 4; ++k) { hl[cb][4 * j + k] = Pl[cb][4 * j + k] * hl[cb][4 * j + k - 1] + hl[cb][4 * j + k]; Pl[cb][4 * j + k] *= Pl[cb][4 * j + k - 1]; } }
            float cin = 0.f, pin = 1.f, cinj[4], pinj[4];
#pragma unroll
            for (int g = 0; g < 8; ++g) { const int j = g >> 1; const bool own = (hh == (g & 1));
                if (own) { cinj[j] = cin; pinj[j] = pin; }
                const float co = Pl[cb][4 * j + 3] * cin + hl[cb][4 * j + 3], po = pin * Pl[cb][4 * j + 3];
                const float co_o = __shfl_xor(co, 32), po_o = __shfl_xor(po, 32);
                cin = own ? co : co_o; pin = own ? po : po_o; }
#pragma unroll
            for (int j = 0; j < 4; ++j)
#pragma unroll
                for (int k = 0; k < 4; ++k) { hl[cb][4 * j + k] += Pl[cb][4 * j + k] * cinj[j]; Pl[cb][4 * j + k] *= pinj[j]; }
            if (hh == 0) { sum[(wid * 64 + n) * 2] = pin; sum[(wid * 64 + n) * 2 + 1] = cin; }
        }
        LDS_WAIT(); __syncthreads();
#pragma unroll
        for (int cb = 0; cb < 2; ++cb) { const int n = 32 * cb + n31; float hin = carry[n];
            for (int w = 0; w < wid; ++w) hin = sum[(w * 64 + n) * 2] * hin + sum[(w * 64 + n) * 2 + 1];
            float hend = 0.f;
#pragma unroll
            for (int r = 0; r < 16; ++r) { const float hv = hl[cb][r] + Pl[cb][r] * hin; if (r == 15) hend = hv;
                const int tok = tl + att::crow(r, hh);
                bf16_t* gp = xg + ((size_t)b * SEQ + tok) * 2048 + 1024 + colx + n;
                const float g = bf2f(*gp); const float ge = g * sigmoidf_(1.5957691216057308f * (g + 0.044715f * g * g * g));
                *gp = (bf16_t)f2bf(hv * ge); }
            if (wid == 7 && hh == 1) park[n] = hend;
        }
        LDS_WAIT(); __syncthreads();
        if (tid < 64) carry[tid] = park[tid];
        LDS_WAIT(); __syncthreads();
    }
}
}

__device__ __forceinline__ void transpose_block(const float* W, int ldw, bf16_t* dst, int ldd, LAS float* scr, int lane) {
#pragma unroll 8
    for (int i = 0; i < 32; ++i) { const int kk = 2 * i + (lane >> 5); scr[kk * 33 + (lane & 31)] = W[(size_t)kk * ldw + (lane & 31)]; }
    LDS_WAIT(); asm volatile("" ::: "memory");
    const int c = lane & 7;
#pragma unroll
    for (int j = 0; j < 4; ++j) { const int n = (lane >> 3) + 8 * j; const LAS float* s = scr + (8 * c) * 33 + n;
        u32x4 o; o.x = pk2(s[0 * 33], s[1 * 33]); o.y = pk2(s[2 * 33], s[3 * 33]); o.z = pk2(s[4 * 33], s[5 * 33]); o.w = pk2(s[6 * 33], s[7 * 33]);
        *(u32x4*)(dst + (size_t)n * ldd + 8 * c) = o; }
    LDS_WAIT(); asm volatile("" ::: "memory");
}

struct In {
    const float *x, *c, *w_ada, *b_ada, *g_pre_mix, *g_post_mix, *g_pre_ffn, *g_post_ffn, *w_in, *b_forget, *w_conv, *b_conv, *w_rg, *b_rg, *w_ig, *b_ig, *lam,
        *w_ba, *w_br, *w_out, *w_router, *r_bias, *w_eg, *w_eu, *w_ed, *w_sg, *w_su, *w_sd;
};

__device__ __forceinline__ bool conv_mat(int& r, const float* W, int K, int N, int ldw, bf16_t* dst, int ldd, LAS float* scr, int lane) {
    const int nblk = N / 32, items = (K / 64) * nblk;
    if (r >= items) { r -= items; return false; }
    const int kb = r / nblk, nb = r % nblk;
    transpose_block(W + (size_t)(64 * kb) * ldw + 32 * nb, ldw, dst + (size_t)(32 * nb) * ldd + 64 * kb, ldd, scr, lane);
    return true;
}

__device__ __forceinline__ void p0_prologue(const In& in, unsigned char* ws, LAS unsigned char* lds, int vcu, int G) {
    const int tid = threadIdx.x, lane = tid & 63; const int wave = __builtin_amdgcn_readfirstlane(tid >> 6);
    bf16_t* WIN = (bf16_t*)(ws + WS_WIN); bf16_t* WBA = (bf16_t*)(ws + WS_WBA); bf16_t* WBR = (bf16_t*)(ws + WS_WBR); bf16_t* WOUT = (bf16_t*)(ws + WS_WOUT);
    bf16_t* WROUT = (bf16_t*)(ws + WS_WROUT); bf16_t* WGU = (bf16_t*)(ws + WS_WGU); bf16_t* WDN = (bf16_t*)(ws + WS_WDN);
    if (vcu < 192) {
        LAS float* s = (LAS float*)lds;
        for (int i = tid; i < 32 * 1024; i += 512) { const float v = in.c[i]; s[i] = v * sigmoidf_(v); }
        LDS_WAIT(); __syncthreads();
        const int kq = tid >> 5, col = tid & 31, col0 = vcu * 32;
        float acc[32];
#pragma unroll
        for (int bb = 0; bb < 32; ++bb) acc[bb] = 0.f;
        for (int k4 = 0; k4 < 16; ++k4) { const int k = 64 * kq + 4 * k4; float w[4];
#pragma unroll
            for (int e = 0; e < 4; ++e) w[e] = in.w_ada[(size_t)(k + e) * 6144 + col0 + col];
#pragma unroll
            for (int bb = 0; bb < 32; ++bb) { const f32x4 sv = *(const LAS f32x4*)(s + bb * 1024 + k); acc[bb] += (sv[0] * w[0] + sv[1] * w[1]) + (sv[2] * w[2] + sv[3] * w[3]); } }
        __syncthreads();
        LAS float* red = (LAS float*)lds;
#pragma unroll
        for (int bb = 0; bb < 32; ++bb) red[(kq * 32 + bb) * 32 + col] = acc[bb];
        LDS_WAIT(); __syncthreads();
        float* mod = (float*)(ws + WS_MOD);
        for (int o = tid; o < 1024; o += 512) { const int bb = o >> 5, cc = o & 31; float v = in.b_ada[col0 + cc];
#pragma unroll
            for (int q = 0; q < 16; ++q) v += red[(q * 32 + bb) * 32 + cc];
            mod[(size_t)bb * 6144 + col0 + cc] = v; }
        __syncthreads();
    }
    { const int gt = vcu * 512 + tid, GT = G * 512;
      float* WF = (float*)(ws + WS_WF);
      for (int i = gt; i < 8 * 1024; i += GT) { const int hd = i >> 10, k = i & 1023; WF[i] = in.w_in[(size_t)k * INCOLS + 1536 + hd]; }
      bf16_t* WR = (bf16_t*)(ws + WS_WRNN);
      for (int i = gt; i < 16 * 6 * 4 * 64 * 8; i += GT) { const int jj = i & 7, ln = (i >> 3) & 63, ks = (i >> 9) & 3, nbk = (i >> 11); const int nb = nbk % 6, blk = nbk / 6;
          const int c = 16 * ks + 8 * (ln >> 5) + jj, n = 32 * nb + (ln & 31); float v;
          if (n < 64) v = in.w_rg[((size_t)blk * 64 + c) * 64 + n]; else if (n < 128) v = in.w_ig[((size_t)blk * 64 + c) * 64 + (n - 64)]; else v = (c == n - 128) ? 1.f : 0.f;
          WR[i] = (bf16_t)f2bf(v); } }
    LAS float* scr = (LAS float*)(lds + wave * 16384);
    const int gw = vcu * NWAVES + wave, NGW = G * NWAVES;
    constexpr int I_EXP = (1024 / 64) * (256 / 32);
    constexpr int NITEMS = 768 + 2048 + 256 + 512 + 512 + 32 + 3 * 65 * I_EXP;
    for (int it = gw; it < NITEMS; it += NGW) {
        int r = it;
        if (conv_mat(r, in.w_in, 1024, 1536, INCOLS, WIN, 1024, scr, lane)) continue;
        if (conv_mat(r, in.w_in + 1544, 1024, 4096, INCOLS, WIN + (size_t)1536 * 1024, 1024, scr, lane)) continue;
        if (conv_mat(r, in.w_ba, 512, 1024, 1024, WBA, 512, scr, lane)) continue;
        if (conv_mat(r, in.w_br, 1024, 1024, 1024, WBR, 1024, scr, lane)) continue;
        if (conv_mat(r, in.w_out, 1024, 1024, 1024, WOUT, 1024, scr, lane)) continue;
        if (conv_mat(r, in.w_router, 1024, 64, 64, WROUT, 1024, scr, lane)) continue;
        const int kind = r / (65 * I_EXP), rr = r % (65 * I_EXP), e = rr / I_EXP, ii = rr % I_EXP;
        if (kind < 2) {
            const float* W = (e < 64) ? ((kind == 0 ? in.w_eg : in.w_eu) + (size_t)e * 1024 * 256) : (kind == 0 ? in.w_sg : in.w_su);
            const int kb = ii / 8, nb = ii % 8, n0 = 32 * nb;
            transpose_block(W + (size_t)(64 * kb) * 256 + n0, 256, WGU + ((size_t)e * 512 + (n0 >> 7) * 256 + kind * 128 + (n0 & 127)) * 1024 + 64 * kb, 1024, scr, lane);
        } else {
            const float* W = (e < 64) ? (in.w_ed + (size_t)e * 256 * 1024) : in.w_sd;
            const int kb = ii / 32, nb = ii % 32;
            transpose_block(W + (size_t)(64 * kb) * 1024 + 32 * nb, 1024, WDN + ((size_t)e * 1024 + 32 * nb) * 256 + 64 * kb, 256, scr, lane);
        }
    }
}

__device__ __forceinline__ void p1_norm(int tile, const In& in, unsigned char* ws, LAS unsigned char* lds) {
    const int tid = threadIdx.x, lane = tid & 63; const int wave = __builtin_amdgcn_readfirstlane(tid >> 6);
    const int b = tile >> 3;
    LAS float* wf = (LAS float*)lds;
    LAS float* lc = (LAS float*)(lds + 32768);
    LAS float* wtot = (LAS float*)(lds + 40960);
    const float* WF = (const float*)(ws + WS_WF); const float* mod = (const float*)(ws + WS_MOD) + (size_t)b * 6144;
    __syncthreads();
    for (int i = tid; i < 2048; i += 512) *(LAS f32x4*)(wf + 4 * i) = *(const f32x4*)(WF + 4 * i);
    f32x4 A[4], B[4];
#pragma unroll
    for (int j = 0; j < 4; ++j) { const int col = 4 * lane + 256 * j; const f32x4 g = *(const f32x4*)(in.g_pre_mix + col), sc = *(const f32x4*)(mod + 1024 + col); A[j] = g * (sc + 1.0f); B[j] = *(const f32x4*)(mod + col); }
    const float bfg = in.b_forget[lane & 7];
    LDS_WAIT(); __syncthreads();
    bf16_t* H = (bf16_t*)(ws + R_H);
    float run = 0.f;
    for (int i = 0; i < 32; ++i) { const size_t tok = (size_t)tile * 256 + wave * 32 + i;
        f32x4 v[4]; float ss = 0.f;
#pragma unroll
        for (int j = 0; j < 4; ++j) { v[j] = *(const f32x4*)(in.x + tok * 1024 + 4 * lane + 256 * j); ss += (v[j][0] * v[j][0] + v[j][1] * v[j][1]) + (v[j][2] * v[j][2] + v[j][3] * v[j][3]); }
        const float rstd = 1.0f / sqrtf(wave_sum(ss) * (1.0f / 1024.0f) + NORM_EPS);
#pragma unroll
        for (int j = 0; j < 4; ++j) { v[j] = v[j] * rstd * A[j] + B[j];
            u32x2 w; w.x = pk2(v[j][0], v[j][1]); w.y = pk2(v[j][2], v[j][3]); *(u32x2*)(H + tok * 1024 + 4 * lane + 256 * j) = w; }
        float p[8];
#pragma unroll
        for (int hd = 0; hd < 8; ++hd) { float a = 0.f;
#pragma unroll
            for (int j = 0; j < 4; ++j) { const f32x4 w4 = *(const LAS f32x4*)(wf + hd * 1024 + 4 * lane + 256 * j); a += (v[j][0] * w4[0] + v[j][1] * w4[1]) + (v[j][2] * w4[2] + v[j][3] * w4[3]); }
            p[hd] = wave_sum(a); }
        const int l7 = lane & 7;
        float f = p[0]; f = (l7 == 1) ? p[1] : f; f = (l7 == 2) ? p[2] : f; f = (l7 == 3) ? p[3] : f; f = (l7 == 4) ? p[4] : f; f = (l7 == 5) ? p[5] : f; f = (l7 == 6) ? p[6] : f; f = (l7 == 7) ? p[7] : f;
        f += bfg;
        const float ls = -log1pf(expf(-f)) * LOG2E;
        run += ls;
        if (lane < 8) lc[(wave * 32 + i) * 8 + lane] = run;
    }
    if (lane < 8) wtot[wave * 8 + lane] = run;
    LDS_WAIT(); __syncthreads();
    float* LC = (float*)(ws + WS_LCUM); float* TOT = (float*)(ws + WS_TOT);
    for (int i = tid; i < 2048; i += 512) { const int tk = i >> 3, hd = i & 7; float off = 0.f; const int w = tk >> 5;
        for (int q = 0; q < w; ++q) off += wtot[q * 8 + hd];
        LC[((size_t)tile * 256 + tk) * 8 + hd] = lc[i] + off; }
    if (tid < 8) { float t = 0.f;
#pragma unroll
        for (int q = 0; q < 8; ++q) t += wtot[q * 8 + tid];
        TOT[tile * 8 + tid] = t; }
}

namespace p6 {
constexpr int HP = 2064;
constexpr int L_H2 = 0, L_PART = 66560, L_HIST = 99328;
__device__ __forceinline__ void run(int tile, const In& in, float* out, unsigned char* ws, LAS unsigned char* lds) {
    const int tid = threadIdx.x, lane = tid & 63, n31 = lane & 31, hh = lane >> 5; const int wave = __builtin_amdgcn_readfirstlane(tid >> 6);
    const int b = tile >> 3;
    const float* mod = (const float*)(ws + WS_MOD) + (size_t)b * 6144;
    bf16_t* H = (bf16_t*)(ws + R_H); const float* SSQ = (const float*)(ws + WS_SSQ); const bf16_t* WROUT = (const bf16_t*)(ws + WS_WROUT);
    int* EP = (int*)(ws + WS_EP); float* EW = (float*)(ws + WS_EW); int* HIST = (int*)(ws + WS_HIST);
    LAS float* part = (LAS float*)(lds + L_PART); LAS int* histl = (LAS int*)(lds + L_HIST);
    f32x4 G1[4], A2[4], B2[4];
#pragma unroll
    for (int j = 0; j < 4; ++j) { const int col = 4 * lane + 256 * j;
        G1[j] = *(const f32x4*)(mod + 2048 + col) * *(const f32x4*)(in.g_post_mix + col);
        A2[j] = *(const f32x4*)(in.g_pre_ffn + col) * (*(const f32x4*)(mod + 4096 + col) + 1.0f);
        B2[j] = *(const f32x4*)(mod + 3072 + col); }
    const int kq = wave >> 1, nb = wave & 1;
    bf16x8 wr[16];
#pragma unroll
    for (int ks = 0; ks < 16; ++ks) wr[ks] = *(const bf16x8*)(WROUT + (size_t)(32 * nb + n31) * 1024 + 256 * kq + 16 * ks + 8 * hh);
    const float rbias = in.r_bias[lane];
    __syncthreads();
    if (tid < 64) histl[tid] = 0;
    LDS_WAIT(); __syncthreads();
    for (int sub = 0; sub < 8; ++sub) {
        for (int i = 0; i < 4; ++i) { const int tl = wave * 4 + i; const size_t tok = (size_t)tile * 256 + sub * 32 + tl;
            u32x2 mv[4]; f32x4 xv[4];
#pragma unroll
            for (int j = 0; j < 4; ++j) { mv[j] = *(const u32x2*)(H + tok * 1024 + 4 * lane + 256 * j); xv[j] = *(const f32x4*)(in.x + tok * 1024 + 4 * lane + 256 * j); }
            const float s1 = wave_sum(lane < 16 ? SSQ[tok * 16 + lane] : 0.f);
            const float rstd1 = 1.0f / sqrtf(s1 * (1.0f / 1024.0f) + NORM_EPS);
            float ss = 0.f;
#pragma unroll
            for (int j = 0; j < 4; ++j) { f32x4 m; m[0] = bflo(mv[j].x); m[1] = bfhi(mv[j].x); m[2] = bflo(mv[j].y); m[3] = bfhi(mv[j].y);
                xv[j] = xv[j] + G1[j] * (m * rstd1);
                *(f32x4*)(out + tok * 1024 + 4 * lane + 256 * j) = xv[j];
                ss += (xv[j][0] * xv[j][0] + xv[j][1] * xv[j][1]) + (xv[j][2] * xv[j][2] + xv[j][3] * xv[j][3]); }
            const float rstd2 = 1.0f / sqrtf(wave_sum(ss) * (1.0f / 1024.0f) + NORM_EPS);
#pragma unroll
            for (int j = 0; j < 4; ++j) { const f32x4 hv = xv[j] * rstd2 * A2[j] + B2[j];
                u32x2 w; w.x = pk2(hv[0], hv[1]); w.y = pk2(hv[2], hv[3]);
                *(u32x2*)(H + tok * 1024 + 4 * lane + 256 * j) = w;
                *(LAS u32x2*)(lds + L_H2 + tl * HP + (4 * lane + 256 * j) * 2) = w; }
        }
        LDS_WAIT(); __syncthreads();
        { f32x16 acc = f32x16{};
#pragma unroll
          for (int ks = 0; ks < 16; ++ks) { const bf16x8 a = *(const LAS bf16x8*)(lds + L_H2 + n31 * HP + (256 * kq + 16 * ks + 8 * hh) * 2);
              acc = __builtin_amdgcn_mfma_f32_32x32x16_bf16(a, wr[ks], acc, 0, 0, 0); }
#pragma unroll
          for (int r = 0; r < 16; ++r) part[(kq * 32 + att::crow(r, hh)) * 64 + 32 * nb + n31] = acc[r]; }
        LDS_WAIT(); __syncthreads();
        for (int i = 0; i < 4; ++i) { const int tl = wave * 4 + i; const size_t tok = (size_t)tile * 256 + sub * 32 + tl;
            const float logit = (part[(0 * 32 + tl) * 64 + lane] + part[(1 * 32 + tl) * 64 + lane]) + (part[(2 * 32 + tl) * 64 + lane] + part[(3 * 32 + tl) * 64 + lane]);
            const float score = 1.0f / (1.0f + expf(-logit)); const float sel = score + rbias;
            int rin = 0;
#pragma unroll
            for (int j = 0; j < 8; ++j) { const float o = __shfl(sel, (lane & ~7) + j); rin += (o > sel || (o == sel && j < (lane & 7))) ? 1 : 0; }
            float gs = rin < 2 ? sel : 0.f; gs += __shfl_xor(gs, 1); gs += __shfl_xor(gs, 2); gs += __shfl_xor(gs, 4);
            int gr = 0; const int g = lane >> 3;
#pragma unroll
            for (int j = 0; j < 8; ++j) { const float o = __shfl(gs, j * 8); gr += (o > gs || (o == gs && j < g)) ? 1 : 0; }
            const bool gsel = gr < 4; const float msel = gsel ? sel : -INFINITY;
            int rk = 0;
            for (int j = 0; j < 64; ++j) { const float o = __shfl(msel, j); rk += (o > msel || (o == msel && j < lane)) ? 1 : 0; }
            const bool chosen = gsel && rk < 6;
            const float wsum = wave_sum(chosen ? score : 0.f);
            if (chosen) { const int li = __hip_atomic_fetch_add(histl + lane, 1, __ATOMIC_RELAXED, __HIP_MEMORY_SCOPE_WORKGROUP);
                EP[tok * 6 + rk] = lane | (li << 8); EW[tok * 6 + rk] = score / wsum * 2.5f; }
        }
    }
    LDS_WAIT(); __syncthreads();
    if (tid < 64) HIST[tile * 64 + tid] = histl[tid];
}
}

__device__ __forceinline__ void p7_place(int tile, unsigned char* ws, LAS unsigned char* lds) {
    const int tid = threadIdx.x; const int r = tile >> 7;
    LAS int* cntb = (LAS int*)lds; LAS int* tot = cntb + 64; LAS int* base = cntb + 128; LAS int* tst = cntb + 192;
    const int* HIST = (const int*)(ws + WS_HIST); const int* EP = (const int*)(ws + WS_EP); int* POS = (int*)(ws + WS_POS);
    int* SLOTTOK = (int*)(ws + WS_SLOTTOK) + (size_t)r * RT_MAX * 256; int* RTAB = (int*)(ws + WS_RTAB) + r * 256;
    __syncthreads();
    if (tid < 64) { int cb = 0, tt = 0;
        for (int i = 0; i < 128; ++i) { const int v = HIST[(r * 128 + i) * 64 + tid]; tt += v; if (r * 128 + i < tile) cb += v; }
        cntb[tid] = cb; tot[tid] = tt; }
    LDS_WAIT(); __syncthreads();
    if (tid == 0) { int ts = 0; for (int e = 0; e < 64; ++e) { tst[e] = ts; ts += (tot[e] + 255) >> 8; } tst[64] = ts; }
    LDS_WAIT(); __syncthreads();
    if (tid < 64) base[tid] = tst[tid] * 256 + cntb[tid];
    if ((tile & 127) == 0) { if (tid < 65) RTAB[tid] = tst[tid]; if (tid < 64) RTAB[128 + tid] = tot[tid]; }
    LDS_WAIT(); __syncthreads();
    for (int p = tid; p < 1536; p += 512) { const int token = tile * 256 + p / 6; const int ep = EP[(size_t)tile * 1536 + p]; const int e = ep & 255, li = ep >> 8;
        const int slot = base[e] + li; POS[(size_t)tile * 1536 + p] = slot; SLOTTOK[slot] = token; }
}

__device__ __forceinline__ void combine_round(int r, const In& in, float* out, unsigned char* ws, int gw, int NGW) {
    const int lane = threadIdx.x & 63;
    const bf16_t* Y = (const bf16_t*)(ws + R_Y); const int* POS = (const int*)(ws + WS_POS); const float* EW = (const float*)(ws + WS_EW);
    for (int idx = gw; idx < HALF_T; idx += NGW) { const size_t tok = (size_t)r * HALF_T + idx; const int b = (int)(tok >> 11);
        const float* mod = (const float*)(ws + WS_MOD) + (size_t)b * 6144;
        int slot = 0; float w = 1.0f;
        if (lane < 6) { slot = POS[tok * 6 + lane]; w = EW[tok * 6 + lane]; }
        if (lane == 6) slot = (RT_MAX + (idx >> 8)) * 256 + (idx & 255);
        f32x4 a[4];
#pragma unroll
        for (int j = 0; j < 4; ++j) a[j] = (f32x4){0.f, 0.f, 0.f, 0.f};
#pragma unroll
        for (int k = 0; k < 7; ++k) { const int sl = __shfl(slot, k); const float wk = __shfl(w, k);
#pragma unroll
            for (int j = 0; j < 4; ++j) { const u32x2 v = *(const u32x2*)(Y + (size_t)sl * 1024 + 4 * lane + 256 * j);
                a[j][0] += wk * bflo(v.x); a[j][1] += wk * bfhi(v.x); a[j][2] += wk * bflo(v.y); a[j][3] += wk * bfhi(v.y); } }
        float ss = 0.f;
#pragma unroll
        for (int j = 0; j < 4; ++j) ss += (a[j][0] * a[j][0] + a[j][1] * a[j][1]) + (a[j][2] * a[j][2] + a[j][3] * a[j][3]);
        const float rstd = 1.0f / sqrtf(wave_sum(ss) * (1.0f / 1024.0f) + NORM_EPS);
#pragma unroll
        for (int j = 0; j < 4; ++j) { const int col = 4 * lane + 256 * j;
            const f32x4 gf = *(const f32x4*)(mod + 5120 + col) * *(const f32x4*)(in.g_post_ffn + col);
            f32x4 x1 = *(const f32x4*)(out + tok * 1024 + col);
            x1 = x1 + gf * (a[j] * rstd);
            *(f32x4*)(out + tok * 1024 + col) = x1; }
    }
}

#define XB_TMO      128
#define XB_XCNT(j)  (256  + 64 * (j))
#define XB_XSUB(j)  (1280 + 64 * (j))
#define XB_XGEN(j)  (2304 + 64 * (j))
#define XB_TOP      3328
#define XB_TOPGEN   3392
#define XCD_BAR_WORDS 3456
#define XB_SPIN_CAP (1u << 18)
__device__ __forceinline__ unsigned xb_ld(unsigned* p)              { return __hip_atomic_load(p, __ATOMIC_RELAXED, __HIP_MEMORY_SCOPE_AGENT); }
__device__ __forceinline__ unsigned xb_add(unsigned* p, unsigned v) { return __hip_atomic_fetch_add(p, v, __ATOMIC_RELAXED, __HIP_MEMORY_SCOPE_AGENT); }
__device__ __forceinline__ unsigned xb_xcc_id() { return (unsigned)__builtin_amdgcn_s_getreg((3 << 11) | 20) & 0xFu; }
#define XB_SPIN(cond, bar) do { unsigned _sp = 0; while (cond) { __builtin_amdgcn_s_sleep(1); \
    if ((++_sp & 255u) == 0u) { if (xb_ld(&(bar)[XB_TMO])) break; if (_sp > XB_SPIN_CAP) { atomicAdd(&(bar)[XB_TMO], 1u); break; } } } } while (0)
struct XcdBarrier { unsigned* bar; unsigned x; volatile LAS unsigned* st; };
__device__ __forceinline__ XcdBarrier xcd_barrier_post(unsigned* bar, volatile LAS unsigned* st) {
    XcdBarrier b; b.bar = bar; b.x = xb_xcc_id(); b.st = st;
    if (threadIdx.x == 0) (void)xb_add(&bar[XB_XCNT(b.x)], 1u);
    return b;
}
__device__ __forceinline__ void xcd_barrier_complete(unsigned* bar, unsigned x, unsigned& nloc, unsigned& nx) {
    const unsigned G = gridDim.x * gridDim.y * gridDim.z;
    unsigned sum, cnt, mine, sp = 0u;
    for (;;) {
        sum = 0u; cnt = 0u; mine = 0u;
#pragma unroll
        for (unsigned j = 0; j < 16; ++j) { const unsigned c = xb_ld(&bar[XB_XCNT(j)]); sum += c; cnt += (c > 0u) ? 1u : 0u; mine = (j == x) ? c : mine; }
        if (sum == G) break;
        __builtin_amdgcn_s_sleep(1);
        if ((++sp & 255u) == 0u) { if (xb_ld(&bar[XB_TMO])) break; if (sp > XB_SPIN_CAP) { atomicAdd(&bar[XB_TMO], 1u); break; } }
    }
    nloc = mine > 0u ? mine : 1u; nx = cnt > 0u ? cnt : 1u;
}
__device__ __forceinline__ void xcd_barrier(const XcdBarrier& b) {
    asm volatile("s_waitcnt vmcnt(0)" ::: "memory");
    __syncthreads();
    if (threadIdx.x == 0) {
        unsigned* bar = b.bar;
        __builtin_amdgcn_s_waitcnt(0);
        unsigned nloc = b.st[0], nx = b.st[1];
        if (nloc == 0u) { xcd_barrier_complete(bar, b.x, nloc, nx); b.st[0] = nloc; b.st[1] = nx; }
        const unsigned old = xb_add(&bar[XB_XSUB(b.x)], 1u);
        const unsigned gen = old / nloc;
        if (old + 1u == (gen + 1u) * nloc) {
            __builtin_amdgcn_fence(__ATOMIC_RELEASE, "agent");
            asm volatile("s_waitcnt vmcnt(0)" ::: "memory");
            const unsigned og = xb_add(&bar[XB_TOP], 1u);
            const unsigned tg = og / nx;
            if (og + 1u == (tg + 1u) * nx) xb_add(&bar[XB_TOPGEN], 1u);
            else XB_SPIN(xb_ld(&bar[XB_TOPGEN]) == tg, bar);
            __builtin_amdgcn_fence(__ATOMIC_ACQUIRE, "agent");
            xb_add(&bar[XB_XGEN(b.x)], 1u);
            asm volatile("s_waitcnt vmcnt(0)" ::: "memory");
        } else {
            XB_SPIN(xb_ld(&bar[XB_XGEN(b.x)]) == gen, bar);
            __builtin_amdgcn_fence(__ATOMIC_ACQUIRE, "agent");
            asm volatile("s_waitcnt vmcnt(0)" ::: "memory");
        }
    }
    __syncthreads();
}

__device__ __forceinline__ void moe_load_tab(int r, unsigned char* ws, LAS int* tab) {
    const int* RTAB = (const int*)(ws + WS_RTAB) + r * 256;
    __syncthreads();
    if (threadIdx.x < 65) tab[threadIdx.x] = RTAB[threadIdx.x];
    if (threadIdx.x < 64) tab[128 + threadIdx.x] = RTAB[128 + threadIdx.x];
    LDS_WAIT(); __syncthreads();
}
__device__ __forceinline__ void moe_gateup(int r, unsigned char* ws, LAS unsigned char* lds, int vcu, int G) {
    LAS int* tok = (LAS int*)(lds + TOK_OFF); LAS int* tab = (LAS int*)(lds + TOK_OFF + 8192);
    moe_load_tab(r, ws, tab);
    const int NT = tab[64], U = 2 * (NT + SH_TILES);
    MoeSched S; S.tab = tab; S.NT = NT; S.U = U; S.G = G; S.vcu = vcu; S.npn = 2; S.lg = 1; S.A = (const char*)(ws + R_H); S.B = (const char*)(ws + WS_WGU);
    S.atile = 0; S.btile_e = (size_t)512 * 1024 * 2; S.btile_n = (size_t)256 * 1024 * 2;
    const int* SLOTTOK = (const int*)(ws + WS_SLOTTOK) + (size_t)r * RT_MAX * 256;
    { pg8::Unit u;
      for (int i = 0; S.next(i, u) && i < 8; ++i) {
          if (threadIdx.x < 256) { const int row = threadIdx.x; int tk;
              if (u.aux) { const int valid = tab[128 + u.e] - (u.pm - tab[u.e]) * 256; tk = (row < valid) ? SLOTTOK[u.pm * 256 + row] : r * HALF_T; }
              else tk = r * HALF_T + (u.pm - RT_MAX) * 256 + row;
              tok[i * 256 + row] = tk; } } }
    LDS_WAIT(); __syncthreads();
    EpiGateUp E{(bf16_t*)(ws + R_ACT)};
    pg8::gemm_phase<EpiGateUp, MoeSched, true>(lds, 1024, 1024, 1024, S, E, tok);
}
__device__ __forceinline__ void moe_down(int r, unsigned char* ws, LAS unsigned char* lds, int vcu, int G) {
    LAS int* tab = (LAS int*)(lds + TOK_OFF + 8192);
    moe_load_tab(r, ws, tab);
    const int NT = tab[64], U = 4 * (NT + SH_TILES);
    MoeSched S; S.tab = tab; S.NT = NT; S.U = U; S.G = G; S.vcu = vcu; S.npn = 4; S.lg = 2; S.A = (const char*)(ws + R_ACT); S.B = (const char*)(ws + WS_WDN);
    S.atile = (size_t)256 * 256 * 2; S.btile_e = (size_t)1024 * 256 * 2; S.btile_n = (size_t)256 * 256 * 2;
    EpiDown E{(bf16_t*)(ws + R_Y)};
    int Kd = 256; asm volatile("" : "+s"(Kd));
    pg8::gemm_phase<EpiDown, MoeSched, false>(lds, Kd, 256, 256, S, E, nullptr);
}

enum { PH_PRO = 0, PH_NORM1, PH_INPROJ, PH_MIX, PH_BRANCH, PH_OUT, PH_TOK2, PH_PLACE, PH_GU0, PH_DN0, PH_CMB0_GU1, PH_DN1, PH_CMB1, NPHASE };
struct Args { const float* in[28]; float* out; unsigned char* ws; int ph_lo, ph_hi, li, pad; };

__global__ void __launch_bounds__(NWAVES * 64, 2) hybrid_fwd(Args args) {
    extern __shared__ __attribute__((aligned(16))) unsigned char lds_raw[];
    LAS unsigned char* lds = (LAS unsigned char*)lds_raw;
    volatile LAS unsigned* MISC = (volatile LAS unsigned*)(lds + MISC_OFF);
    const int tid = threadIdx.x; const int wave = __builtin_amdgcn_readfirstlane(tid >> 6);
    const int G = gridDim.x; const int bx = blockIdx.x; const int vcu = (G % 8 == 0) ? (bx % 8) * (G / 8) + bx / 8 : bx;
    unsigned char* ws = args.ws; float* out = args.out;
    In in;
    in.x = args.in[0]; in.c = args.in[1]; in.w_ada = args.in[2]; in.b_ada = args.in[3]; in.g_pre_mix = args.in[4]; in.g_post_mix = args.in[5]; in.g_pre_ffn = args.in[6]; in.g_post_ffn = args.in[7];
    in.w_in = args.in[8]; in.b_forget = args.in[9]; in.w_conv = args.in[10]; in.b_conv = args.in[11]; in.w_rg = args.in[12]; in.b_rg = args.in[13]; in.w_ig = args.in[14]; in.b_ig = args.in[15]; in.lam = args.in[16];
    in.w_ba = args.in[17]; in.w_br = args.in[18]; in.w_out = args.in[19]; in.w_router = args.in[20]; in.r_bias = args.in[21]; in.w_eg = args.in[22]; in.w_eu = args.in[23]; in.w_ed = args.in[24];
    in.w_sg = args.in[25]; in.w_su = args.in[26]; in.w_sd = args.in[27];
    for (int u = tid; u < 256; u += NWAVES * 64) ((LAS unsigned*)(lds + LDSCTL_OFF))[u] = 0u;
    __syncthreads();
    const int lo = args.ph_lo, hi = args.ph_hi;
    XcdBarrier bar; bar.bar = (unsigned*)(ws + WS_CTL) + CW_BAR; bar.x = 0; bar.st = nullptr;
    if (hi - lo > 1) bar = xcd_barrier_post((unsigned*)(ws + WS_CTL) + CW_BAR + args.li * XCD_BAR_WORDS, MISC + 8);
#ifndef PHASE_MASK
#define PHASE_MASK 0xFFFF
#endif
#define IN(k) (((PHASE_MASK >> (k)) & 1) && lo <= (k) && (k) < hi)
#define SEAM(k) do { if (IN(k) && IN((k) + 1)) xcd_barrier(bar); } while (0)

    if (IN(PH_PRO)) { p0_prologue(in, ws, lds, vcu, G); }
    SEAM(PH_PRO);
    if (IN(PH_NORM1)) { for (int tile = vcu; tile < 256; tile += G) p1_norm(tile, in, ws, lds); }
    SEAM(PH_NORM1);
    if (IN(PH_INPROJ)) {
        DenseSched S; S.init(T, NIN, G, bx, ws + R_H, 1024, ws + WS_WIN, 1024);
        EpiInProj E{(bf16_t*)(ws + R_QKV), (bf16_t*)(ws + R_XG), (bf16_t*)(ws + R_GT)};
        __syncthreads();
        pg8::gemm_phase<EpiInProj, DenseSched, false>(lds, 1024, 1024, 1024, S, E, nullptr);
    }
    SEAM(PH_INPROJ);
    if (IN(PH_MIX)) {
        for (int u = vcu; u < NBATCH * NHEAD; u += G) { __syncthreads(); att::attn_bh(u >> 3, u & 7, (bf16_t*)(ws + R_QKV), (const float*)(ws + WS_LCUM), (const float*)(ws + WS_TOT), lds); }
        for (int u = vcu; u < NBATCH * 16; u += G) rnn::rnn_unit(u >> 4, u & 15, (bf16_t*)(ws + R_XG), (const bf16_t*)(ws + WS_WRNN), in.w_conv, in.b_conv, in.b_rg, in.b_ig, in.lam, lds);
    }
    SEAM(PH_MIX);
    if (IN(PH_BRANCH)) {
        { DenseSched S; S.init(T, 1024, G, bx, ws + R_QKV, 1536, ws + WS_WBA, 512);
          EpiBranch<0> E{(const bf16_t*)(ws + R_GT), 2048, (bf16_t*)(ws + R_QKV) + 512, 1536};
          __syncthreads();
          pg8::gemm_phase<EpiBranch<0>, DenseSched, false>(lds, 512, 1536, 512, S, E, nullptr); }
        { DenseSched S; S.init(T, 1024, G, bx, (bf16_t*)(ws + R_XG) + 1024, 2048, ws + WS_WBR, 1024);
          EpiBranch<1> E{(const bf16_t*)(ws + R_GT) + 1024, 2048, (bf16_t*)(ws + R_QKV) + 512, 1536};
          __syncthreads();
          pg8::gemm_phase<EpiBranch<1>, DenseSched, false>(lds, 1024, 2048, 1024, S, E, nullptr); }
    }
    SEAM(PH_BRANCH);
    if (IN(PH_OUT)) {
        DenseSched S; S.init(T, 1024, G, bx, (bf16_t*)(ws + R_QKV) + 512, 1536, ws + WS_WOUT, 1024);
        EpiOut E{(bf16_t*)(ws + R_H), (float*)(ws + WS_SSQ)};
        __syncthreads();
        pg8::gemm_phase<EpiOut, DenseSched, false>(lds, 1024, 1536, 1024, S, E, nullptr);
    }
    SEAM(PH_OUT);
    if (IN(PH_TOK2)) { for (int tile = vcu; tile < 256; tile += G) p6::run(tile, in, out, ws, lds); }
    SEAM(PH_TOK2);
    if (IN(PH_PLACE)) { for (int tile = vcu; tile < 256; tile += G) p7_place(tile, ws, lds); }
    SEAM(PH_PLACE);
    if (IN(PH_GU0)) moe_gateup(0, ws, lds, vcu, G);
    SEAM(PH_GU0);
    if (IN(PH_DN0)) moe_down(0, ws, lds, vcu, G);
    SEAM(PH_DN0);
    if (IN(PH_CMB0_GU1)) { combine_round(0, in, out, ws, vcu * NWAVES + wave, G * NWAVES); moe_gateup(1, ws, lds, vcu, G); }
    SEAM(PH_CMB0_GU1);
    if (IN(PH_DN1)) moe_down(1, ws, lds, vcu, G);
    SEAM(PH_DN1);
    if (IN(PH_CMB1)) combine_round(1, in, out, ws, vcu * NWAVES + wave, G * NWAVES);
#undef IN
#undef SEAM
}

extern "C" void kernel_launch(void* const* d_in, const int* in_sizes, int n_in, void* d_out, int out_size, void* d_ws, size_t ws_size, hipStream_t stream) {
    static int grid = 0;
    if (grid == 0) {
        if (n_in != 28 || in_sizes[0] != T * D || out_size != T * D || ws_size < WS_END) { fprintf(stderr, "kernel_launch: unexpected shapes / workspace (n_in %d, ws %zu)\n", n_in, ws_size); grid = -1; return; }
        int dev = 0, cus = 0, per_cu = 0;
        if (hipGetDevice(&dev) != hipSuccess || hipDeviceGetAttribute(&cus, hipDeviceAttributeMultiprocessorCount, dev) != hipSuccess) { grid = -1; return; }
        if (hipFuncSetAttribute((const void*)hybrid_fwd, hipFuncAttributeMaxDynamicSharedMemorySize, LDS_BYTES) != hipSuccess) { fprintf(stderr, "kernel_launch: hipFuncSetAttribute failed\n"); grid = -1; return; }
        if (hipOccupancyMaxActiveBlocksPerMultiprocessor(&per_cu, (const void*)hybrid_fwd, NWAVES * 64, LDS_BYTES) != hipSuccess || per_cu < 1) { fprintf(stderr, "kernel_launch: occupancy query says %d\n", per_cu); per_cu = 1; }
        (void)hipGetLastError();
        grid = cus;
    }
    if (grid < 0) return;
    (void)hipMemsetAsync((char*)d_ws + WS_CTL, 0, CTL_ZERO_BYTES, stream);
    Args a{};
    for (int i = 0; i < 28; ++i) a.in[i] = (const float*)d_in[i];
    a.out = (float*)d_out; a.ws = (unsigned char*)d_ws;
#if MK_N_LAUNCHES == 1
    a.ph_lo = 0; a.ph_hi = NPHASE; a.li = 0;
    void* kargs[] = {&a};
    hipError_t e = hipLaunchCooperativeKernel((const void*)hybrid_fwd, dim3(grid), dim3(NWAVES * 64), kargs, LDS_BYTES, stream);
    if (e != hipSuccess) fprintf(stderr, "kernel_launch: cooperative launch failed: %s (grid %d)\n", hipGetErrorString(e), grid);
#else
    for (int li = 0; li < NPHASE; ++li) { a.ph_lo = li; a.ph_hi = li + 1; a.li = li;
        hipLaunchKernelGGL(hybrid_fwd, dim3(grid), dim3(NWAVES * 64), LDS_BYTES, stream, a); }
#endif
}
```

```cpp
#include <hip/hip_runtime.h>
#include <cstdio>
#include <cstdint>

#ifndef MK_N_LAUNCHES
#define MK_N_LAUNCHES 1
#endif

#define LAS __attribute__((address_space(3)))
#define GAS __attribute__((address_space(1)))
typedef unsigned short bf16_t;
typedef short bf16x8 __attribute__((ext_vector_type(8)));
typedef short s16x4 __attribute__((ext_vector_type(4)));
typedef float f32x4 __attribute__((ext_vector_type(4)));
typedef float f32x2 __attribute__((ext_vector_type(2)));
typedef float f32x16 __attribute__((ext_vector_type(16)));
typedef unsigned u32x4 __attribute__((ext_vector_type(4)));
typedef unsigned u32x2 __attribute__((ext_vector_type(2)));
typedef GAS unsigned gu32;

constexpr int T = 65536, D = 1024, NBATCH = 32, SEQ = 2048, NHEAD = 8, HD = 64;
constexpr int NIN = 5632;
constexpr int INCOLS = 5640;
constexpr int NEXP = 64, TOPK = 6, EFF = 256;
constexpr int RT_MAX = 1600;
constexpr int SH_TILES = 256;
constexpr int RND_TILES = RT_MAX + SH_TILES;
constexpr float NORM_EPS = 1e-6f;
constexpr float LOG2E = 1.4426950408889634f;
constexpr float QSCALE = 0.125f * LOG2E;

constexpr size_t MiB = 1u << 20, KiB = 1u << 10;
constexpr size_t WS_CTL = 0, CTL_ZERO_BYTES = 1 * MiB;
constexpr size_t WS_MOD = 1 * MiB;
constexpr size_t WS_TOT = 1 * MiB + 768 * KiB;
constexpr size_t WS_HIST = 2 * MiB;
constexpr size_t WS_RTAB = 2 * MiB + 64 * KiB;
constexpr size_t WS_LCUM = 3 * MiB;
constexpr size_t WS_SSQ = 5 * MiB;
constexpr size_t WS_EP = 9 * MiB;
constexpr size_t WS_EW = 11 * MiB;
constexpr size_t WS_POS = 13 * MiB;
constexpr size_t WS_SLOTTOK = 15 * MiB;
constexpr size_t WS_WF = 17 * MiB;
constexpr size_t WS_WRNN = 17 * MiB + 64 * KiB;
constexpr size_t WS_WROUT = 17 * MiB + 512 * KiB;
constexpr size_t WS_WIN = 18 * MiB;
constexpr size_t WS_WBA = 29 * MiB;
constexpr size_t WS_WOUT = 32 * MiB;
constexpr size_t WS_WGU = 34 * MiB;
constexpr size_t WS_WDN = 68 * MiB;
constexpr size_t R_H = 144 * MiB;
constexpr size_t R_QKV = 272 * MiB;
constexpr int QXP = 3584;
constexpr size_t R_GT = 720 * MiB;
constexpr size_t R_ACT = 272 * MiB;
constexpr size_t R_Y = 392 * MiB;
constexpr size_t R_H8 = 856 * MiB;
constexpr size_t WS_END = 976 * MiB;
static_assert(WS_WDN + (size_t)65 * 1024 * 256 <= R_H && WS_WGU + (size_t)65 * 512 * 1024 <= WS_WDN, "weights fit");
static_assert(R_Y + (size_t)RND_TILES * 256 * 1024 <= WS_END, "y fits");
static_assert(R_ACT + (size_t)RND_TILES * 256 * 256 <= R_Y && R_Y + (size_t)RND_TILES * 256 * 1024 <= R_H8 && R_H8 + (size_t)T * 1024 <= WS_END, "act / y / h8 fit");

constexpr int CW_TMO = 0, CW_CODE = 1;
constexpr int CW_BAR = 4096;

constexpr int RING_BYTES = 131072;
constexpr int LDSCTL_OFF = RING_BYTES;
constexpr int MISC_OFF = LDSCTL_OFF + 320;
constexpr int TOK_OFF = RING_BYTES + 1024;
constexpr int EST_OFF = TOK_OFF;
constexpr int TAB_OFF = TOK_OFF + 16384;
constexpr int LDS_BYTES = TAB_OFF + 1024;
constexpr int NWAVES = 8;

#define RLX_AGENT __ATOMIC_RELAXED, __HIP_MEMORY_SCOPE_AGENT
#define LDS_WAIT() asm volatile("s_waitcnt lgkmcnt(0)" ::: "memory")
#define VM_WAIT() asm volatile("s_waitcnt vmcnt(0)" ::: "memory")

__device__ __forceinline__ unsigned f2bf(float f) { unsigned u = __builtin_bit_cast(unsigned, f); return (u + 0x7fffu + ((u >> 16) & 1u)) >> 16; }
__device__ __forceinline__ unsigned pk2(float lo, float hi) { return f2bf(lo) | (f2bf(hi) << 16); }
__device__ __forceinline__ float bf2f(unsigned short b) { return __builtin_bit_cast(float, (unsigned)b << 16); }
__device__ __forceinline__ float bflo(unsigned w) { return __builtin_bit_cast(float, w << 16); }
__device__ __forceinline__ float bfhi(unsigned w) { return __builtin_bit_cast(float, w & 0xffff0000u); }
__device__ __forceinline__ float fast_exp2(float x) { return __builtin_amdgcn_exp2f(x); }
__device__ __forceinline__ float fast_rcp(float x) { return __builtin_amdgcn_rcpf(x); }
__device__ __forceinline__ float fast_rsq(float x) { return __builtin_amdgcn_rsqf(x); }
__device__ __forceinline__ float fast_log2(float x) { return __builtin_amdgcn_logf(x); }
__device__ __forceinline__ unsigned cvt_pk(float lo, float hi) { unsigned r; asm volatile("v_cvt_pk_bf16_f32 %0, %1, %2" : "=v"(r) : "v"(lo), "v"(hi)); return r; }
__device__ __forceinline__ float sigmoidf_(float x) { return fast_rcp(1.0f + fast_exp2(-x * LOG2E)); }
template <int CTRL, int RMASK> __device__ __forceinline__ float dpp_f(float v) { return __builtin_bit_cast(float, __builtin_amdgcn_update_dpp(0, __builtin_bit_cast(int, v), CTRL, RMASK, 0xF, false)); }
__device__ __forceinline__ float wave_sum(float v) {
    v += dpp_f<0xB1, 0xF>(v);
    v += dpp_f<0x4E, 0xF>(v);
    v += dpp_f<0x141, 0xF>(v);
    v += dpp_f<0x140, 0xF>(v);
    v += dpp_f<0x142, 0xA>(v);
    v += dpp_f<0x143, 0xC>(v);
    return __builtin_bit_cast(float, __builtin_amdgcn_readlane(__builtin_bit_cast(int, v), 63));
}
__device__ __forceinline__ void swap32(float& a, float& b) { asm("s_nop 1\n\tv_permlane32_swap_b32 %0, %1" : "+v"(a), "+v"(b)); }
__device__ __forceinline__ void swap16(float& a, float& b) { asm("s_nop 1\n\tv_permlane16_swap_b32 %0, %1" : "+v"(a), "+v"(b)); }
__device__ __forceinline__ float xor32_sum(float v) { float a = v, b = v; swap32(a, b); return a + b; }
__device__ __forceinline__ float xor32_max(float v) { float a = v, b = v; swap32(a, b); return fmaxf(a, b); }
__device__ __forceinline__ float xor16_sum(float v) { float a = v, b = v; swap16(a, b); return a + b; }
__device__ __forceinline__ float wave_max(float v) {
    v = fmaxf(v, dpp_f<0xB1, 0xF>(v)); v = fmaxf(v, dpp_f<0x4E, 0xF>(v)); v = fmaxf(v, dpp_f<0x141, 0xF>(v)); v = fmaxf(v, dpp_f<0x140, 0xF>(v));
    v = fmaxf(v, __builtin_bit_cast(float, __builtin_amdgcn_update_dpp(__builtin_bit_cast(int, v), __builtin_bit_cast(int, v), 0x142, 0xA, 0xF, false)));
    v = fmaxf(v, __builtin_bit_cast(float, __builtin_amdgcn_update_dpp(__builtin_bit_cast(int, v), __builtin_bit_cast(int, v), 0x143, 0xC, 0xF, false)));
    return __builtin_bit_cast(float, __builtin_amdgcn_readlane(__builtin_bit_cast(int, v), 63));
}
__device__ __forceinline__ float max8(float v) { v = fmaxf(v, dpp_f<0xB1, 0xF>(v)); v = fmaxf(v, dpp_f<0x4E, 0xF>(v)); v = fmaxf(v, dpp_f<0x141, 0xF>(v)); return v; }
__device__ __forceinline__ float sum8(float v) { v += dpp_f<0xB1, 0xF>(v); v += dpp_f<0x4E, 0xF>(v); v += dpp_f<0x141, 0xF>(v); return v; }

#ifndef STAMP_INPROJ
#define STAMP_INPROJ -1
#endif
#ifndef STAMP_DOWN
#define STAMP_DOWN -1
#endif
#ifndef GEMM_STAMP_BLOCK
#define GEMM_STAMP_BLOCK 0
#endif
#ifndef GEMM_STAMP_THREAD
#define GEMM_STAMP_THREAD 0
#endif
#ifdef GEMM_STAMP
__device__ unsigned long long g_dbg[16];
#endif
namespace pg8 {
constexpr int BM = 256, BK = 64, HALF = 128, HTB = HALF * BK * 2, STAGE_BYTES = 8 * HTB;
__host__ __device__ __forceinline__ int lds_byte(int r, int c) { const int st = (r >> 4) * 2 + (c >> 5), rr = r & 15, cc = c & 31, ob = rr * 64 + cc * 2; return st * 1024 + (ob ^ (((ob >> 9) & 1) << 5)); }
__host__ __device__ __forceinline__ void stage_rc(int b, int& R, int& C) { const int st = b / 1024, sb = b % 1024, swz = sb ^ (((sb >> 9) & 1) << 5); R = (st >> 1) * 16 + swz / 64; C = (st & 1) * 32 + (swz % 64) / 2; }
__host__ __device__ __forceinline__ int perm32(int rho) { const int n = rho >> 4, i = rho & 15; return 8 * (i >> 2) + 4 * n + (i & 3); }

struct Unit { int pm, pn, e, aux; };
typedef long l2v __attribute__((ext_vector_type(2)));
typedef int v8i __attribute__((ext_vector_type(8)));

__device__ __forceinline__ unsigned cvt_pk_bf16(float lo, float hi) { unsigned r; asm volatile("v_cvt_pk_bf16_f32 %0, %1, %2" : "=v"(r) : "v"(lo), "v"(hi)); return r; }
#ifndef EPI_SC1
#define EPI_SC1 0
#endif
__device__ __forceinline__ void st16(void* p, u32x4 v) {
#if EPI_SC1
    asm volatile("global_store_dwordx4 %0, %1, off sc1\n\ts_nop 1" :: "v"(p), "v"(v) : "memory");
#else
    *(u32x4*)p = v;
#endif
}

template <class Epi, class Sched, bool GATHER>
__device__ __forceinline__ void gemm_phase(LAS unsigned char* lds, const int K, const int lda, const int ldb, const Sched& S, const Epi& E, const LAS int* tokLDS) {
    const int tid = threadIdx.x, wid = __builtin_amdgcn_readfirstlane(tid >> 6), lane = tid & 63, wr = wid >> 2, wc = wid & 3, fr = lane & 15, fq = lane >> 4;
    int nt = K / BK;
    int Rr[2], Cc[2];
    unsigned voffB0[2], voffB1[2];
#pragma unroll
    for (int i = 0; i < 2; ++i) { int R, C; stage_rc(tid * 16 + i * 8192, R, C); Rr[i] = R; Cc[i] = C;
        if constexpr (Epi::WIDE) { const int n0 = 64 * (R >> 5) + perm32(R & 31); voffB0[i] = (unsigned)(n0 * ldb + C) * 2u; voffB1[i] = (unsigned)((n0 + 32) * ldb + C) * 2u; }
        else { const int Rb = (R & ~31) + perm32(R & 31); voffB0[i] = (unsigned)(Rb * ldb + C) * 2u; voffB1[i] = (unsigned)((Rb + HALF) * ldb + C) * 2u; } }
    const size_t kstep = (size_t)(BK * 2);
    const unsigned ldsw = (unsigned)wid * 1024u;
    const int aoff = lds_byte(wr * 64 + fr, fq * 8), boff = lds_byte(wc * 32 + fr, fq * 8);
#define PG8_SA(b, h) (((b) * 2 + (h)) * HTB)
#define PG8_SB(b, h) ((4 + (b) * 2 + (h)) * HTB)
#define PG8_STAGE2(bufoff, gbase, v0, v1) do { \
        __builtin_amdgcn_global_load_lds((const unsigned*)((const char*)(gbase) + (v0)), (LAS unsigned*)(lds + (bufoff) + ldsw), 16, 0, 0); \
        __builtin_amdgcn_global_load_lds((const unsigned*)((const char*)(gbase) + (v1)), (LAS unsigned*)(lds + (bufoff) + ldsw + 8192), 16, 0, 0); } while (0)
#define PG8_STAGEB0(bufoff, gbase) PG8_STAGE2(bufoff, gbase, voffB0[0], voffB0[1])
#define PG8_STAGEB1(bufoff, gbase) PG8_STAGE2(bufoff, gbase, voffB1[0], voffB1[1])
#define MX_LD(var, LO, HI, ALL, addr, off) asm volatile("ds_read_b128 " LO ", %1 offset:%2\n\tds_read_b128 " HI ", %1 offset:%3" : "={" ALL "}"(var) : "v"(addr), "i"(off), "i"((off) + 1024) : "memory")
#define MX_LDA(b, h) do { MX_LD(At_8[0], "v[192:195]", "v[196:199]", "v[192:199]", aaddr, PG8_SA(b, h)); MX_LD(At_8[1], "v[200:203]", "v[204:207]", "v[200:207]", aaddr, PG8_SA(b, h) + 2048); \
        MX_LD(At_8[2], "v[208:211]", "v[212:215]", "v[208:215]", aaddr, PG8_SA(b, h) + 4096); MX_LD(At_8[3], "v[216:219]", "v[220:223]", "v[216:223]", aaddr, PG8_SA(b, h) + 6144); } while (0)
#define MX_LDB_B0(b, h) do { MX_LD(B0_8[0], "v[224:227]", "v[228:231]", "v[224:231]", baddr, PG8_SA(b, h)); MX_LD(B0_8[1], "v[232:235]", "v[236:239]", "v[232:239]", baddr, PG8_SA(b, h) + 2048); } while (0)
#define MX_LDB_B1(b, h) do { MX_LD(B1_8[0], "v[240:243]", "v[244:247]", "v[240:247]", baddr, PG8_SA(b, h)); MX_LD(B1_8[1], "v[248:251]", "v[252:255]", "v[248:255]", baddr, PG8_SA(b, h) + 2048); } while (0)
#define PG8_LDA(dst, b, h) do { if constexpr (Epi::FP8) { MX_LDA(b, h); } else { _Pragma("unroll") for (int m = 0; m < 4; ++m) _Pragma("unroll") for (int k = 0; k < 2; ++k) dst[m][k] = *(const LAS bf16x8*)(lds + PG8_SA(b, h) + aoff + m * 2048 + k * 1024); } } while (0)
#define PG8_LDB(dst, b, h) do { if constexpr (Epi::FP8) { MX_LDB_##dst(b, h); } else { _Pragma("unroll") for (int n = 0; n < 2; ++n) _Pragma("unroll") for (int k = 0; k < 2; ++k) dst[n][k] = *(const LAS bf16x8*)(lds + PG8_SB(b, h) + boff + n * 2048 + k * 1024); } } while (0)
#define PG8_MMA(ai, bj, At, Bt) do { __builtin_amdgcn_s_setprio(1); _Pragma("unroll") for (int m = 0; m < 4; ++m) _Pragma("unroll") for (int n = 0; n < 2; ++n) _Pragma("unroll") for (int k = 0; k < 2; ++k) { \
        if constexpr (Epi::FP8) { if (k == 0) acc[ai][bj][m][n] = __builtin_amdgcn_mfma_scale_f32_16x16x128_f8f6f4(Bt##_8[n], At##_8[m], acc[ai][bj][m][n], 0, 0, 0, 0x7f7f7f7f, 0, 0x7f7f7f7f); } \
        else acc[ai][bj][m][n] = __builtin_amdgcn_mfma_f32_16x16x32_bf16(Bt[n][k], At[m][k], acc[ai][bj][m][n], 0, 0, 0); } __builtin_amdgcn_s_setprio(0); } while (0)
#define PG8_WAIT_V(n) asm volatile("s_waitcnt vmcnt(" #n ")" ::: "memory")
#define PG8_WAIT_L(n) asm volatile("s_waitcnt lgkmcnt(" #n ")" ::: "memory")
#define PG8_BAR __builtin_amdgcn_s_barrier()
#define PG8_SCHED __builtin_amdgcn_sched_barrier(0)
    Unit cur, nxt; int ui = 0;
    if (!S.next(0, cur)) return;
    if constexpr (Sched::PARTS) nt = S.nt(cur);
    unsigned ts1 = 0, tsa = 0, ts2 = 0, d12 = 0, d2a = 0, dab = 0; bool stamped = false;
    unsigned vA0[2], vA1[2], nA0[2], nA1[2];
#pragma unroll
    for (int i = 0; i < 2; ++i) {
        if constexpr (GATHER) { vA0[i] = (unsigned)(tokLDS[Rr[i]] * lda + Cc[i]) * 2u; vA1[i] = (unsigned)(tokLDS[HALF + Rr[i]] * lda + Cc[i]) * 2u; }
        else { vA0[i] = (unsigned)(Rr[i] * lda + Cc[i]) * 2u; vA1[i] = (unsigned)((HALF + Rr[i]) * lda + Cc[i]) * 2u; }
        nA0[i] = vA0[i]; nA1[i] = vA1[i];
    }
    f32x4 acc[2][2][4][2];
#pragma unroll
    for (int a = 0; a < 2; ++a)
#pragma unroll
        for (int b = 0; b < 2; ++b)
#pragma unroll
            for (int m = 0; m < 4; ++m)
#pragma unroll
                for (int n = 0; n < 2; ++n) acc[a][b][m][n] = (f32x4){0.f, 0.f, 0.f, 0.f};
    bf16x8 At[4][2], B0[2][2], B1[2][2];
    v8i At_8[4], B0_8[2], B1_8[2];
    const unsigned aaddr = (unsigned)(uintptr_t)lds + (unsigned)aoff, baddr = (unsigned)(uintptr_t)lds + 4u * HTB + (unsigned)boff;
    const char* cA = S.aptr(cur); const char* cB = S.bptr(cur);
    PG8_STAGEB0(PG8_SB(0, 0), cB); PG8_STAGEB1(PG8_SB(0, 1), cB); PG8_STAGE2(PG8_SA(0, 0), cA, vA0[0], vA0[1]); PG8_STAGE2(PG8_SA(0, 1), cA, vA1[0], vA1[1]);
    if (wr == 1) PG8_BAR;
    PG8_WAIT_V(2); PG8_BAR;
    PG8_STAGEB0(PG8_SB(1, 0), cB + kstep); PG8_STAGE2(PG8_SA(1, 0), cA + kstep, vA0[0], vA0[1]); PG8_STAGEB1(PG8_SB(1, 1), cB + kstep);
    PG8_WAIT_V(6); PG8_BAR;
    for (;;) {
        const bool has_next = S.next(ui + 1, nxt);
        const char* nAp = has_next ? S.aptr(nxt) : cA; const char* nBp = has_next ? S.bptr(nxt) : cB;
        if constexpr (GATHER) {
            if (has_next) {
#pragma unroll
                for (int i = 0; i < 2; ++i) { nA0[i] = (unsigned)(tokLDS[(ui + 1) * 256 + Rr[i]] * lda + Cc[i]) * 2u; nA1[i] = (unsigned)(tokLDS[(ui + 1) * 256 + HALF + Rr[i]] * lda + Cc[i]) * 2u; }
            } else {
#pragma unroll
                for (int i = 0; i < 2; ++i) { nA0[i] = vA0[i]; nA1[i] = vA1[i]; }
            }
        }
        for (int t = 0; t < nt; t += 2) {
            const bool last = (t == nt - 2);
            const char* a1 = cA + (size_t)(t + 1) * kstep;
            const char* a2 = last ? nAp : cA + (size_t)(t + 2) * kstep; const char* b2 = last ? nBp : cB + (size_t)(t + 2) * kstep;
            const char* a3 = a2 + kstep; const char* b3 = b2 + kstep;
            unsigned w0[2], w1[2];
#pragma unroll
            for (int i = 0; i < 2; ++i) { w0[i] = (GATHER && last) ? nA0[i] : vA0[i]; w1[i] = (GATHER && last) ? nA1[i] : vA1[i]; }
            PG8_LDB(B0, 0, 0); PG8_LDB(B1, 0, 1); PG8_SCHED; PG8_LDA(At, 0, 0); PG8_STAGE2(PG8_SA(1, 1), a1, vA1[0], vA1[1]);
            if constexpr (Epi::STAMP) { if (stamped) tsa = (unsigned)__builtin_amdgcn_s_memtime(); }
            PG8_WAIT_V(8); PG8_WAIT_L(0); PG8_BAR;
            if constexpr (Epi::STAMP) { if (stamped) { const unsigned tsb = (unsigned)__builtin_amdgcn_s_memtime(); d2a += tsa - ts2; dab += tsb - tsa; stamped = false; } }
            PG8_MMA(0, 0, At, B0); PG8_MMA(0, 1, At, B1); PG8_BAR; PG8_SCHED;
            PG8_LDA(At, 0, 1); PG8_STAGEB0(PG8_SB(0, 0), b2); PG8_STAGEB1(PG8_SB(0, 1), b2); PG8_STAGE2(PG8_SA(0, 0), a2, w0[0], w0[1]);
            PG8_WAIT_V(8); PG8_WAIT_L(0); PG8_BAR; PG8_MMA(1, 0, At, B0); PG8_MMA(1, 1, At, B1); PG8_BAR; PG8_SCHED;
            PG8_LDB(B0, 1, 0); PG8_LDB(B1, 1, 1); PG8_SCHED; PG8_LDA(At, 1, 0); PG8_STAGE2(PG8_SA(0, 1), a2, w1[0], w1[1]);
            PG8_WAIT_V(8); PG8_WAIT_L(0); PG8_BAR; PG8_MMA(0, 0, At, B0); PG8_MMA(0, 1, At, B1); PG8_BAR; PG8_SCHED;
            PG8_LDA(At, 1, 1); PG8_STAGEB0(PG8_SB(1, 0), b3); PG8_STAGEB1(PG8_SB(1, 1), b3); PG8_STAGE2(PG8_SA(1, 0), a3, w0[0], w0[1]);
            PG8_WAIT_V(8); PG8_WAIT_L(0); PG8_BAR; PG8_MMA(1, 0, At, B0); PG8_MMA(1, 1, At, B1); PG8_BAR; PG8_SCHED;
        }
        if (wr == 0) PG8_BAR;
        if constexpr (Epi::STAMP) ts1 = (unsigned)__builtin_amdgcn_s_memtime();
        if constexpr (Sched::PARTS) { if (cur.aux == 0) E.mid(acc, cur, wr, wc, fr, fq, lds, wid, lane); else E(acc, cur, wr, wc, fr, fq, lds, wid, lane); }
        else E(acc, cur, wr, wc, fr, fq, lds, wid, lane);
        if constexpr (Epi::STAMP) { ts2 = (unsigned)__builtin_amdgcn_s_memtime(); d12 += ts2 - ts1; stamped = true; }
        if (!has_next) break;
        if (!Sched::PARTS || nxt.aux == 0) {
#pragma unroll
        for (int a = 0; a < 2; ++a)
#pragma unroll
            for (int b = 0; b < 2; ++b)
#pragma unroll
                for (int m = 0; m < 4; ++m)
#pragma unroll
                    for (int n = 0; n < 2; ++n) acc[a][b][m][n] = (f32x4){0.f, 0.f, 0.f, 0.f};
        }
        cur = nxt; cA = nAp; cB = nBp; ++ui;
        if constexpr (Sched::PARTS) nt = S.nt(cur);
        if constexpr (GATHER) {
#pragma unroll
            for (int i = 0; i < 2; ++i) { vA0[i] = nA0[i]; vA1[i] = nA1[i]; }
        }
        if (wr == 1) PG8_BAR;
    }
    PG8_WAIT_V(0);
    PG8_BAR;
#ifdef GEMM_STAMP
    if constexpr (Epi::STAMP) if (blockIdx.x == GEMM_STAMP_BLOCK && threadIdx.x == GEMM_STAMP_THREAD) { g_dbg[0] = 0; g_dbg[1] = d12; g_dbg[2] = d2a; g_dbg[3] = dab; g_dbg[4] = ui + 1; g_dbg[5] = 0; }
#endif
#undef PG8_SA
#undef PG8_SB
#undef PG8_STAGE2
#undef PG8_STAGEB0
#undef PG8_STAGEB1
#undef PG8_LDA
#undef MX_LD
#undef MX_LDA
#undef MX_LDB_B0
#undef MX_LDB_B1
#undef PG8_LDB
#undef PG8_MMA
#undef PG8_WAIT_V
#undef PG8_WAIT_L
#undef PG8_BAR
#undef PG8_SCHED
}
}

template <int NM, int NN> struct DenseSchedT {
    static constexpr bool PARTS = false;
    static_assert(NM % 8 == 0 && (NM * NN) % 8 == 0, "8-row groups, equal XCD chunks");
    int G, c; const char* A; const char* B; size_t atile, btile;
    __device__ __forceinline__ void init(int M, int N, int G_, int c_, const void* A_, int lda, const void* B_, int ldb) {
        (void)M; (void)N; G = G_; c = c_; A = (const char*)A_; B = (const char*)B_; atile = (size_t)256 * lda * 2; btile = (size_t)256 * ldb * 2; }
    __device__ __forceinline__ bool next(int i, pg8::Unit& u) const {
        constexpr int nwg = NM * NN, q = nwg / 8, nig = 8 * NN;
        const long L = (long)i * G + c; if (L >= nwg) return false;
        int wgid = (int)L; { const int xcd = wgid % 8, off = wgid / 8; wgid = xcd * q + off; }
        const int gid = wgid / nig, fm = gid * 8, w = wgid % nig;
        u.pm = fm + (w % 8); u.pn = w / 8; u.e = 0; u.aux = 0; return true;
    }
    __device__ __forceinline__ const char* aptr(const pg8::Unit& u) const { return A + (size_t)u.pm * atile; }
    __device__ __forceinline__ const char* bptr(const pg8::Unit& u) const { return B + (size_t)u.pn * btile; }
};

struct BranchSched {
    static constexpr bool PARTS = true;
    DenseSchedT<256, 4> d;
    __device__ __forceinline__ bool next(int i, pg8::Unit& u) const { if (!d.next(i >> 1, u)) return false; u.aux = i & 1; return true; }
    __device__ __forceinline__ int nt(const pg8::Unit& u) const { return u.aux ? 16 : 8; }
    __device__ __forceinline__ const char* aptr(const pg8::Unit& u) const { return d.A + (size_t)u.pm * d.atile + (u.aux ? 2560 * 2 : 0); }
    __device__ __forceinline__ const char* bptr(const pg8::Unit& u) const { return d.B + (size_t)u.pn * d.btile + (u.aux ? 512 * 2 : 0); }
};

struct MoeSched {
    static constexpr bool PARTS = false;
    const LAS int* tab;
    int NT, U, G, vcu, npn, lg; const char* A; const char* B; size_t atile, btile_e, btile_n;
    __device__ __forceinline__ bool next(int i, pg8::Unit& u) const {
        const int id = i * G + vcu; if (id >= U) return false;
        const int ri = id >> lg; u.pn = id & (npn - 1);
        if (ri < NT) { u.e = tab[192 + i]; u.pm = ri; u.aux = 1; }
        else { u.e = 64; u.pm = RT_MAX + (ri - NT); u.aux = 0; }
        return true;
    }
    __device__ __forceinline__ const char* aptr(const pg8::Unit& u) const { return A + (size_t)u.pm * atile; }
    __device__ __forceinline__ const char* bptr(const pg8::Unit& u) const { return B + (size_t)u.e * btile_e + (size_t)u.pn * btile_n; }
};


__device__ __forceinline__ void wide_store16(LAS unsigned char* stg, int fr, int fq, int lane, u32x4 w0, u32x4 w1, bf16_t* rowbase, size_t ld, bool st) {
    *(LAS u32x4*)(stg + fr * 128 + ((fq ^ (fr & 7)) * 16)) = w0;
    *(LAS u32x4*)(stg + fr * 128 + (((4 + fq) ^ (fr & 7)) * 16)) = w1;
#pragma unroll
    for (int s2 = 0; s2 < 2; ++s2) { const int rr = (lane >> 3) + 8 * s2, p = lane & 7;
        const u32x4 v = *(const LAS u32x4*)(stg + rr * 128 + ((p ^ (rr & 7)) * 16));
        if (st) *(u32x4*)(rowbase + (size_t)rr * ld + p * 8) = v; }
}
#define EPI_ARGS const f32x4 (&acc)[2][2][4][2], const pg8::Unit& u, int wr, int wc, int fr, int fq, LAS unsigned char* lds, int wid, int lane
struct EpiInProj {
    bf16_t* qkv; bf16_t* gt; bool st; static constexpr bool STAMP = (STAMP_INPROJ >= 0); static constexpr bool WIDE = true; static constexpr bool FP8 = true;
    __device__ __forceinline__ void operator()(EPI_ARGS) const {
        bf16_t* base; int ld, colt; float sc = 1.f / 32.f;
        if (u.pn < 14) { base = qkv; ld = QXP; colt = u.pn * 256; if (u.pn < 2) sc = QSCALE / 32.f; }
        else { base = gt; ld = 2048; colt = (u.pn - 14) * 256; }
        LAS unsigned char* stg = lds + EST_OFF + wid * 2048;
#pragma unroll
        for (int ai = 0; ai < 2; ++ai)
#pragma unroll
            for (int m = 0; m < 4; ++m) { bf16_t* rowbase = base + (size_t)(u.pm * 256 + wr * 64 + ai * 128 + m * 16) * ld + colt + 64 * wc;
                u32x4 w[2];
#pragma unroll
                for (int bj = 0; bj < 2; ++bj) { const f32x4 v0 = acc[ai][bj][m][0] * sc, v1 = acc[ai][bj][m][1] * sc;
                    w[bj].x = pg8::cvt_pk_bf16(v0[0], v0[1]); w[bj].y = pg8::cvt_pk_bf16(v0[2], v0[3]); w[bj].z = pg8::cvt_pk_bf16(v1[0], v1[1]); w[bj].w = pg8::cvt_pk_bf16(v1[2], v1[3]); }
                wide_store16(stg, fr, fq, lane, w[0], w[1], rowbase, (size_t)ld, st); }
    }
};
template <int MODE> struct EpiBranch {
    const bf16_t* gate; int ldg; bf16_t* mg; int ldm; static constexpr bool STAMP = false; static constexpr bool WIDE = true; static constexpr bool FP8 = false;
    __device__ __forceinline__ void operator()(EPI_ARGS) const {
        const int row0 = u.pm * 256 + wr * 64 + fr, colw = u.pn * 256 + 64 * wc;
        LAS unsigned char* stg = lds + EST_OFF + wid * 2048;
#pragma unroll
        for (int ai = 0; ai < 2; ++ai)
#pragma unroll
            for (int m = 0; m < 4; ++m) { const size_t r = (size_t)(row0 + ai * 128 + m * 16);
                u32x4 w[2];
#pragma unroll
                for (int bj = 0; bj < 2; ++bj) { const int col0 = colw + 32 * bj + 8 * fq;
                    const u32x4 g = *(const u32x4*)(gate + r * ldg + col0);
                    f32x4 v0 = acc[ai][bj][m][0], v1 = acc[ai][bj][m][1];
                    v0[0] *= sigmoidf_(bflo(g.x)); v0[1] *= sigmoidf_(bfhi(g.x)); v0[2] *= sigmoidf_(bflo(g.y)); v0[3] *= sigmoidf_(bfhi(g.y));
                    v1[0] *= sigmoidf_(bflo(g.z)); v1[1] *= sigmoidf_(bfhi(g.z)); v1[2] *= sigmoidf_(bflo(g.w)); v1[3] *= sigmoidf_(bfhi(g.w));
                    if (MODE == 1) { const u32x4 o = *(const u32x4*)(mg + r * ldm + col0);
                        v0[0] += bflo(o.x); v0[1] += bfhi(o.x); v0[2] += bflo(o.y); v0[3] += bfhi(o.y); v1[0] += bflo(o.z); v1[1] += bfhi(o.z); v1[2] += bflo(o.w); v1[3] += bfhi(o.w); }
                    w[bj].x = pg8::cvt_pk_bf16(v0[0], v0[1]); w[bj].y = pg8::cvt_pk_bf16(v0[2], v0[3]); w[bj].z = pg8::cvt_pk_bf16(v1[0], v1[1]); w[bj].w = pg8::cvt_pk_bf16(v1[2], v1[3]); }
                wide_store16(stg, fr, fq, lane, w[0], w[1], mg + (size_t)(u.pm * 256 + wr * 64 + ai * 128 + m * 16) * ldm + colw, (size_t)ldm, true); }
    }
};
struct EpiBranchF {
    const bf16_t* ga; const bf16_t* gr; int ldg; bf16_t* mg; int ldm; static constexpr bool STAMP = false; static constexpr bool WIDE = true; static constexpr bool FP8 = false;
    static __device__ __forceinline__ float ratio(float a, float r) { return (1.0f + fast_exp2(-r * LOG2E)) * fast_rcp(1.0f + fast_exp2(-a * LOG2E)); }
    __device__ __forceinline__ void mid(f32x4 (&acc)[2][2][4][2], const pg8::Unit& u, int wr, int wc, int fr, int fq, LAS unsigned char* lds, int wid, int lane) const {
        const int row0 = u.pm * 256 + wr * 64 + fr, colw = u.pn * 256 + 64 * wc;
#pragma unroll
        for (int ai = 0; ai < 2; ++ai)
#pragma unroll
            for (int m = 0; m < 4; ++m) { const size_t r = (size_t)(row0 + ai * 128 + m * 16);
#pragma unroll
                for (int bj = 0; bj < 2; ++bj) { const int col0 = colw + 32 * bj + 8 * fq;
                    const u32x4 a = *(const u32x4*)(ga + r * ldg + col0), g = *(const u32x4*)(gr + r * ldg + col0);
                    f32x4& v0 = acc[ai][bj][m][0]; f32x4& v1 = acc[ai][bj][m][1];
                    v0[0] *= ratio(bflo(a.x), bflo(g.x)); v0[1] *= ratio(bfhi(a.x), bfhi(g.x)); v0[2] *= ratio(bflo(a.y), bflo(g.y)); v0[3] *= ratio(bfhi(a.y), bfhi(g.y));
                    v1[0] *= ratio(bflo(a.z), bflo(g.z)); v1[1] *= ratio(bfhi(a.z), bfhi(g.z)); v1[2] *= ratio(bflo(a.w), bflo(g.w)); v1[3] *= ratio(bfhi(a.w), bfhi(g.w)); } }
    }
    __device__ __forceinline__ void operator()(EPI_ARGS) const {
        const int row0 = u.pm * 256 + wr * 64 + fr, colw = u.pn * 256 + 64 * wc;
        LAS unsigned char* stg = lds + EST_OFF + wid * 2048;
#pragma unroll
        for (int ai = 0; ai < 2; ++ai)
#pragma unroll
            for (int m = 0; m < 4; ++m) { const size_t r = (size_t)(row0 + ai * 128 + m * 16);
                u32x4 w[2];
#pragma unroll
                for (int bj = 0; bj < 2; ++bj) { const int col0 = colw + 32 * bj + 8 * fq;
                    const u32x4 g = *(const u32x4*)(gr + r * ldg + col0);
                    f32x4 v0 = acc[ai][bj][m][0], v1 = acc[ai][bj][m][1];
                    v0[0] *= sigmoidf_(bflo(g.x)); v0[1] *= sigmoidf_(bfhi(g.x)); v0[2] *= sigmoidf_(bflo(g.y)); v0[3] *= sigmoidf_(bfhi(g.y));
                    v1[0] *= sigmoidf_(bflo(g.z)); v1[1] *= sigmoidf_(bfhi(g.z)); v1[2] *= sigmoidf_(bflo(g.w)); v1[3] *= sigmoidf_(bfhi(g.w));
                    w[bj].x = pg8::cvt_pk_bf16(v0[0], v0[1]); w[bj].y = pg8::cvt_pk_bf16(v0[2], v0[3]); w[bj].z = pg8::cvt_pk_bf16(v1[0], v1[1]); w[bj].w = pg8::cvt_pk_bf16(v1[2], v1[3]); }
                wide_store16(stg, fr, fq, lane, w[0], w[1], mg + (size_t)(u.pm * 256 + wr * 64 + ai * 128 + m * 16) * ldm + colw, (size_t)ldm, true); }
    }
};
struct EpiOut {
    bf16_t* mo; float* ssq; static constexpr bool STAMP = false; static constexpr bool WIDE = true; static constexpr bool FP8 = false;
    __device__ __forceinline__ void operator()(EPI_ARGS) const {
        const int row0 = u.pm * 256 + wr * 64 + fr, colw = u.pn * 256 + 64 * wc;
        LAS unsigned char* stg = lds + EST_OFF + wid * 2048;
#pragma unroll
        for (int ai = 0; ai < 2; ++ai)
#pragma unroll
            for (int m = 0; m < 4; ++m) { const size_t r = (size_t)(row0 + ai * 128 + m * 16); float sq = 0.f;
                u32x4 w[2];
#pragma unroll
                for (int bj = 0; bj < 2; ++bj) { const f32x4 v0 = acc[ai][bj][m][0], v1 = acc[ai][bj][m][1];
                    sq += (v0[0] * v0[0] + v0[1] * v0[1]) + (v0[2] * v0[2] + v0[3] * v0[3]) + (v1[0] * v1[0] + v1[1] * v1[1]) + (v1[2] * v1[2] + v1[3] * v1[3]);
                    w[bj].x = pg8::cvt_pk_bf16(v0[0], v0[1]); w[bj].y = pg8::cvt_pk_bf16(v0[2], v0[3]); w[bj].z = pg8::cvt_pk_bf16(v1[0], v1[1]); w[bj].w = pg8::cvt_pk_bf16(v1[2], v1[3]); }
                wide_store16(stg, fr, fq, lane, w[0], w[1], mo + (size_t)(u.pm * 256 + wr * 64 + ai * 128 + m * 16) * 1024 + colw, (size_t)1024, true);
                sq = xor16_sum(sq); sq = xor32_sum(sq);
                if (fq == 0) ssq[r * 16 + u.pn * 4 + wc] = sq; }
    }
};
struct EpiGateUp {
    unsigned char* act; static constexpr bool STAMP = false; static constexpr bool WIDE = false; static constexpr bool FP8 = true;
    __device__ __forceinline__ void operator()(EPI_ARGS) const {
        const int row0 = u.pm * 256 + wr * 64 + fr, col0 = u.pn * 128 + wc * 32 + 8 * fq;
#pragma unroll
        for (int ai = 0; ai < 2; ++ai)
#pragma unroll
            for (int m = 0; m < 4; ++m) { const size_t r = (size_t)(row0 + ai * 128 + m * 16);
                float v[8];
#pragma unroll
                for (int n = 0; n < 2; ++n)
#pragma unroll
                    for (int e = 0; e < 4; ++e) { const float g = acc[ai][0][m][n][e] * (1.0f / 32.0f), up = acc[ai][1][m][n][e] * (4.0f / 32.0f); v[n * 4 + e] = g * sigmoidf_(g) * up; }
                int d0 = 0, d1 = 0;
                d0 = __builtin_amdgcn_cvt_pk_fp8_f32(v[0], v[1], d0, false); d0 = __builtin_amdgcn_cvt_pk_fp8_f32(v[2], v[3], d0, true);
                d1 = __builtin_amdgcn_cvt_pk_fp8_f32(v[4], v[5], d1, false); d1 = __builtin_amdgcn_cvt_pk_fp8_f32(v[6], v[7], d1, true);
                *(u32x2*)(act + r * 256 + col0) = (u32x2){(unsigned)d0, (unsigned)d1}; }
    }
};
struct EpiDown {
    unsigned char* y; bool st; static constexpr bool STAMP = (STAMP_DOWN >= 0); static constexpr bool WIDE = true; static constexpr bool FP8 = true;
    __device__ __forceinline__ void operator()(EPI_ARGS) const {
        LAS unsigned char* stg = lds + EST_OFF + wid * 2048;
        const int sw = ((fr >> 1) & 3) << 1;
#pragma unroll
        for (int ai = 0; ai < 2; ++ai)
#pragma unroll
            for (int m = 0; m < 4; ++m) {
#pragma unroll
                for (int bj = 0; bj < 2; ++bj) { const f32x4 v0 = acc[ai][bj][m][0] * (1.0f / 64.0f), v1 = acc[ai][bj][m][1] * (1.0f / 64.0f); int d0 = 0, d1 = 0;
                    d0 = __builtin_amdgcn_cvt_pk_fp8_f32(v0[0], v0[1], d0, false); d0 = __builtin_amdgcn_cvt_pk_fp8_f32(v0[2], v0[3], d0, true);
                    d1 = __builtin_amdgcn_cvt_pk_fp8_f32(v1[0], v1[1], d1, false); d1 = __builtin_amdgcn_cvt_pk_fp8_f32(v1[2], v1[3], d1, true);
                    *(LAS u32x2*)(stg + fr * 64 + (((bj * 4 + fq) ^ sw) * 8)) = (u32x2){(unsigned)d0, (unsigned)d1}; }
                const int rr = lane >> 2, q = lane & 3;
                const u32x4 v = *(const LAS u32x4*)(stg + rr * 64 + (((2 * q) ^ (((rr >> 1) & 3) << 1)) * 8));
                if (st) *(u32x4*)(y + (size_t)(u.pm * 256 + wr * 64 + ai * 128 + m * 16 + rr) * 1024 + u.pn * 256 + 64 * wc + 16 * q) = v; }
    }
};

namespace att {
constexpr int PITCH = QXP, QB = 256, KVBLK = 64, SLOTB = 8192;
constexpr int L_K = 0, L_V = 2 * SLOTB, L_WS = 4 * SLOTB, L_CUM = L_WS + 8 * 64 * 4, L_OST = L_CUM + SEQ * 4, L_END = L_OST + 8 * 4096;
static_assert(L_END <= RING_BYTES, "attention LDS");
__device__ __forceinline__ int crow(int r, int hi) { return (r & 3) + 8 * (r >> 2) + 4 * hi; }
__device__ __forceinline__ void glds16(const void* gsrc, unsigned lds_dst) { unsigned keep;
    asm volatile("s_mov_b32 %0, m0\n\ts_mov_b32 m0, %2\n\ts_nop 0\n\tglobal_load_lds_dwordx4 %1, off\n\ts_mov_b32 m0, %0" : "=&s"(keep) : "v"(gsrc), "s"(lds_dst) : "memory"); }
__device__ __forceinline__ unsigned cvtpk(float lo, float hi) { unsigned r; asm volatile("v_cvt_pk_bf16_f32 %0, %1, %2" : "=v"(r) : "v"(lo), "v"(hi)); return r; }
__device__ __forceinline__ float max3f(float a, float b, float c) { return __builtin_fmaxf(__builtin_fmaxf(a, b), c); }

__device__ __forceinline__ void pv(f32x16* o, int vb, bf16x8 pa0, bf16x8 pa1, bf16x8 pa2, bf16x8 pa3) {
#pragma unroll
    for (int d0 = 0; d0 < 2; ++d0) { s16x4 lo[4], hi[4];
#pragma unroll
        for (int ks = 0; ks < 4; ++ks) {
            asm volatile("ds_read_b64_tr_b16 %0,%1 offset:%c2" : "=&v"(lo[ks]) : "v"(vb), "i"(d0 * 4096 + ks * 1024) : "memory");
            asm volatile("ds_read_b64_tr_b16 %0,%1 offset:%c2" : "=&v"(hi[ks]) : "v"(vb), "i"(d0 * 4096 + ks * 1024 + 512) : "memory"); }
        asm volatile("s_waitcnt lgkmcnt(0)" ::: "memory"); __builtin_amdgcn_sched_barrier(0);
#define PK(k) (bf16x8){lo[k][0], lo[k][1], lo[k][2], lo[k][3], hi[k][0], hi[k][1], hi[k][2], hi[k][3]}
        o[d0] = __builtin_amdgcn_mfma_f32_32x32x16_bf16(pa0, PK(0), o[d0], 0, 0, 0);
        o[d0] = __builtin_amdgcn_mfma_f32_32x32x16_bf16(pa1, PK(1), o[d0], 0, 0, 0);
        o[d0] = __builtin_amdgcn_mfma_f32_32x32x16_bf16(pa2, PK(2), o[d0], 0, 0, 0);
        o[d0] = __builtin_amdgcn_mfma_f32_32x32x16_bf16(pa3, PK(3), o[d0], 0, 0, 0);
#undef PK
    }
}

constexpr float SKIP_T = 24.0f;
constexpr int L_KN = L_OST + 8 * 4096;
static_assert(L_KN + 512 <= RING_BYTES, "attention LDS");
__device__ __forceinline__ void attn_bh(int b, int h, bf16_t* qkv, const float* lcum, const float* tot, LAS unsigned char* lds, bool do_store = true) {
    const int tid = threadIdx.x, lane = tid & 63, r32 = lane & 31, hi = lane >> 5; const int wid = __builtin_amdgcn_readfirstlane(tid >> 6);
    LAS float* cumT = (LAS float*)(lds + L_CUM);
    LAS float* wsf = (LAS float*)(lds + L_WS) + wid * 64;
    LAS float* knw = (LAS float*)(lds + L_KN); LAS float* knb = knw + 32; LAS float* rbw = knb + 8;
    const long rowbase = (long)b * SEQ;
    const bf16_t* Kh = qkv + rowbase * PITCH + 512 + h * 64; const bf16_t* Vh = qkv + rowbase * PITCH + 1024 + h * 64;
    { float tt[8], lc4[4];
#pragma unroll
      for (int j = 0; j < 8; ++j) tt[j] = tot[(b * 8 + j) * 8 + h];
#pragma unroll
      for (int q = 0; q < 4; ++q) lc4[q] = lcum[(rowbase + tid + 512 * q) * 8 + h];
#pragma unroll
      for (int q = 0; q < 4; ++q) { const int i = tid + 512 * q, ti = i >> 8; float off = 0.f;
#pragma unroll
          for (int j = 0; j < 7; ++j) off += (j < ti) ? tt[j] : 0.f;
          cumT[i] = lc4[q] + off; } }
    { float kn[4];
#pragma unroll
      for (int i = 0; i < 4; ++i) { const bf16_t* kp = Kh + (long)(tid + 512 * i) * PITCH; float ss = 0.f;
#pragma unroll
          for (int c = 0; c < 8; ++c) { const u32x4 v = *(const u32x4*)(kp + 8 * c);
              ss += bflo(v.x) * bflo(v.x) + bfhi(v.x) * bfhi(v.x) + bflo(v.y) * bflo(v.y) + bfhi(v.y) * bfhi(v.y) + bflo(v.z) * bflo(v.z) + bfhi(v.z) * bfhi(v.z) + bflo(v.w) * bflo(v.w) + bfhi(v.w) * bfhi(v.w); }
          float m = sqrtf(ss);
          kn[i] = wave_max(m); }
      if (lane == 0) { knw[wid * 4 + 0] = kn[0]; knw[wid * 4 + 1] = kn[1]; knw[wid * 4 + 2] = kn[2]; knw[wid * 4 + 3] = kn[3]; } }
    LDS_WAIT(); __syncthreads();
    if (tid < 8) { const int half = tid & 1, i = tid >> 1; float m = 0.f;
#pragma unroll
        for (int w = 0; w < 4; ++w) m = fmaxf(m, knw[(4 * half + w) * 4 + i]);
        knb[tid] = m; }
    LDS_WAIT(); __syncthreads();
    const unsigned lds0 = (unsigned)(uintptr_t)lds;
    const bf16_t* ksrc = Kh + (long)lane * PITCH + wid * 8;
    const bf16_t* vsrc = Vh + (long)(16 * (wid & 3) + (lane >> 2)) * PITCH + (wid >> 2) * 32 + (lane & 3) * 8;
    const unsigned kdst = lds0 + L_K + wid * 1024, vdst = lds0 + L_V + wid * 1024;
    const int vb0 = (int)(lds0 + L_V) + ((lane >> 4) & 1) * 32 + (lane & 3) * 8 + (4 * hi + ((lane & 15) >> 2)) * 64;
    int it = 0;
    for (int qb = 7; qb >= 0; --qb) {
        const int q0 = qb * QB;
        bf16_t* Qw = qkv + (rowbase + q0 + wid * 32) * PITCH + h * 64;
        bf16x8 qr[4];
#pragma unroll
        for (int d0 = 0; d0 < 4; ++d0) qr[d0] = *(const bf16x8*)(Qw + (long)r32 * PITCH + d0 * 16 + hi * 8);
        float qn = 0.f;
#pragma unroll
        for (int d0 = 0; d0 < 4; ++d0)
#pragma unroll
            for (int j = 0; j < 8; ++j) { const float qv = bf2f((unsigned short)qr[d0][j]); qn += qv * qv; }
        qn = xor32_sum(qn); qn = sqrtf(qn);
        float kpmax = 0.f;
#pragma unroll
        for (int j = 0; j < 8; ++j) { const float kj = knb[j]; kpmax = (j <= qb) ? fmaxf(kpmax, kj) : kpmax; }
        const int qrel = wid * 32 + r32;
        const float cq = cumT[q0 + qrel];
        float mrun = -1e30f, lrun = 0.f; f32x16 o[2]; o[0] = f32x16{}; o[1] = f32x16{};
        const int NT = (q0 + QB) / KVBLK;
        if (qb == 7) { glds16(ksrc + (long)(NT - 1) * KVBLK * PITCH, (unsigned)__builtin_amdgcn_readfirstlane(kdst)); glds16(vsrc + (long)(NT - 1) * KVBLK * PITCH, (unsigned)__builtin_amdgcn_readfirstlane(vdst)); }
        float Rb = 1e30f, Rw = 1e30f;
        for (int t = NT - 1; t >= 0; --t, ++it) {
            const int slot = (it & 1) * SLOTB;
            asm volatile("s_waitcnt vmcnt(0) lgkmcnt(0)\n\ts_barrier" ::: "memory");
            const bool more = (t >= 1) && (Rb - cumT[64 * (t - 1) + 63] >= -SKIP_T);
            if (more) { const int ns = ((it + 1) & 1) * SLOTB;
                glds16(ksrc + (long)(t - 1) * KVBLK * PITCH, (unsigned)__builtin_amdgcn_readfirstlane(kdst + ns));
                glds16(vsrc + (long)(t - 1) * KVBLK * PITCH, (unsigned)__builtin_amdgcn_readfirstlane(vdst + ns)); }
            else if (qb > 0) { const int ns = ((it + 1) & 1) * SLOTB;
                glds16(ksrc + (long)(q0 - KVBLK) * PITCH, (unsigned)__builtin_amdgcn_readfirstlane(kdst + ns));
                glds16(vsrc + (long)(q0 - KVBLK) * PITCH, (unsigned)__builtin_amdgcn_readfirstlane(vdst + ns)); }
            const int jb = t - (NT - 4);
            const bool wskip = (jb >= 0) ? (64 * jb > wid * 32 + 31) : (Rw - cumT[64 * t + 63] < -SKIP_T);
            if (!wskip) {
            f32x16 p0, p1;
            const LAS float* ck = cumT + t * KVBLK + 4 * hi;
            const float cqm = (jb >= 0) ? cq : cq - mrun;
#pragma unroll
            for (int g = 0; g < 4; ++g) { const f32x4 c0 = *(const LAS f32x4*)(ck + 8 * g), c1 = *(const LAS f32x4*)(ck + 32 + 8 * g);
#pragma unroll
                for (int e = 0; e < 4; ++e) { p0[4 * g + e] = cqm - c0[e]; p1[4 * g + e] = cqm - c1[e]; } }
            const LAS unsigned char* kb = lds + L_K + slot + hi * 1024 + r32 * 16;
#pragma unroll
            for (int d0 = 0; d0 < 4; ++d0) { const bf16x8 b0 = *(const LAS bf16x8*)(kb + d0 * 2048), b1 = *(const LAS bf16x8*)(kb + d0 * 2048 + 512);
                p0 = __builtin_amdgcn_mfma_f32_32x32x16_bf16(b0, qr[d0], p0, 0, 0, 0); p1 = __builtin_amdgcn_mfma_f32_32x32x16_bf16(b1, qr[d0], p1, 0, 0, 0); }
            if (jb >= 0) { const int kb0 = 64 * jb + 4 * hi;
#pragma unroll
                for (int r = 0; r < 16; ++r) { const int kv = kb0 + (r & 3) + 8 * (r >> 2); if (kv > qrel) p0[r] = -INFINITY; if (kv + 32 > qrel) p1[r] = -INFINITY; } }
            float rm;
            { float a = max3f(p0[0], p0[1], p1[0]), b2 = max3f(p0[2], p0[3], p1[1]); a = max3f(a, p1[2], p1[3]);
#pragma unroll
              for (int r = 4; r < 16; r += 4) { a = max3f(a, p0[r], p0[r + 1]); b2 = max3f(b2, p0[r + 2], p0[r + 3]); a = max3f(a, p1[r], p1[r + 1]); b2 = max3f(b2, p1[r + 2], p1[r + 3]); }
              rm = fmaxf(a, b2); }
            rm = xor32_max(rm);
            float alpha; bool grew;
            if (jb >= 0) {
                const float mn = fmaxf(mrun, rm); alpha = fast_exp2(mrun - mn); grew = __any(mn > mrun); mrun = mn;
#pragma unroll
                for (int r = 0; r < 16; ++r) { p0[r] -= mn; p1[r] -= mn; }
            } else {
                grew = __any(rm > 0.f); alpha = 1.0f;
                if (grew) { const float dl = fmaxf(rm, 0.f); mrun += dl; alpha = fast_exp2(-dl);
#pragma unroll
                    for (int r = 0; r < 16; ++r) { p0[r] -= dl; p1[r] -= dl; } }
            }
            float ls = 0.f;
#pragma unroll
            for (int r = 0; r < 16; ++r) { p0[r] = fast_exp2(p0[r]); p1[r] = fast_exp2(p1[r]); ls += p0[r] + p1[r]; }
            lrun = lrun * alpha + ls;
            if (grew) {
                if (hi == 0) wsf[r32] = alpha;
                asm volatile("s_waitcnt lgkmcnt(0)" ::: "memory");
#pragma unroll
                for (int r = 0; r < 16; ++r) { const float a = wsf[crow(r, hi)]; o[0][r] *= a; o[1][r] *= a; }
            }
            u32x4 pw0, pw1, pw2, pw3;
            pw0 = (u32x4){cvtpk(p0[0], p0[1]), cvtpk(p0[2], p0[3]), cvtpk(p0[4], p0[5]), cvtpk(p0[6], p0[7])};
            pw1 = (u32x4){cvtpk(p0[8], p0[9]), cvtpk(p0[10], p0[11]), cvtpk(p0[12], p0[13]), cvtpk(p0[14], p0[15])};
            pw2 = (u32x4){cvtpk(p1[0], p1[1]), cvtpk(p1[2], p1[3]), cvtpk(p1[4], p1[5]), cvtpk(p1[6], p1[7])};
            pw3 = (u32x4){cvtpk(p1[8], p1[9]), cvtpk(p1[10], p1[11]), cvtpk(p1[12], p1[13]), cvtpk(p1[14], p1[15])};
            asm volatile("s_waitcnt lgkmcnt(0)" ::: "memory"); __builtin_amdgcn_sched_barrier(0);
            pv(o, vb0 + slot, __builtin_bit_cast(bf16x8, pw0), __builtin_bit_cast(bf16x8, pw1), __builtin_bit_cast(bf16x8, pw2), __builtin_bit_cast(bf16x8, pw3));
            }
            if (jb == 0) {
                float rb = qn * kpmax + cq - mrun;
                rb = wave_max(rb);
                Rw = rb;
                if (lane == 0) rbw[wid] = rb;
                asm volatile("s_waitcnt lgkmcnt(0)\n\ts_barrier" ::: "memory");
                float R = rbw[0];
#pragma unroll
                for (int w = 1; w < 8; ++w) R = fmaxf(R, rbw[w]);
                Rb = R;
            }
            if (!more) { ++it; break; }
        }
        lrun = xor32_sum(lrun);
        if (hi == 0) wsf[32 + r32] = lrun;
        asm volatile("s_waitcnt lgkmcnt(0)" ::: "memory");
        float rli[16];
#pragma unroll
        for (int r = 0; r < 16; ++r) rli[r] = fast_rcp(wsf[32 + crow(r, hi)]);
        { LAS bf16_t* stg = (LAS bf16_t*)(lds + L_OST) + wid * 2048;
#pragma unroll
            for (int r = 0; r < 16; ++r) { const int orow = crow(r, hi);
#pragma unroll
                for (int d0 = 0; d0 < 2; ++d0) stg[orow * 64 + d0 * 32 + r32] = (bf16_t)f2bf(o[d0][r] * rli[r]); }
            asm volatile("s_waitcnt lgkmcnt(0)" ::: "memory");
#pragma unroll
            for (int i = 0; i < 4; ++i) { const int row = i * 8 + (lane >> 3), ch = lane & 7; const u32x4 v = *(const LAS u32x4*)(stg + row * 64 + ch * 8); if (do_store) *(u32x4*)(Qw + (long)row * PITCH + ch * 8) = v; } }
        asm volatile("s_waitcnt vmcnt(0) lgkmcnt(0)\n\ts_barrier" ::: "memory");
    }
}
}

namespace rnn {
constexpr int L_W = 0, L_CW = 24576, L_GB = 26112, L_SUM = 28672, L_PARK = 36864, L_CARRY = 40960, L_STG = 49152, L_XS = 81920, XSP = 144;
__device__ __forceinline__ void rnn_unit(int b, int blk, bf16_t* xg, const bf16_t* wfrag, const float* w_conv, const float* b_conv,
                                         const float* b_rg, const float* b_ig, const float* lam, LAS unsigned char* lds, bool do_store = true) {
    const int tid = threadIdx.x, lane = tid & 63, n31 = lane & 31, hh = lane >> 5; const int wid = __builtin_amdgcn_readfirstlane(tid >> 6);
    LAS float* cw = (LAS float*)(lds + L_CW);
    LAS float* gb = (LAS float*)(lds + L_GB);
    LAS float* sum = (LAS float*)(lds + L_SUM);
    LAS float* carry = (LAS float*)(lds + L_CARRY);
    LAS float* park = (LAS float*)(lds + L_PARK);
    __syncthreads();
    const size_t colx = (size_t)blk * 64;
    u32x4 xr[5], gr[4];
#define RNN_LOAD(sg) do { const int tl_ = (sg) * 256 + wid * 32; \
        _Pragma("unroll") for (int i = 0; i < 5; ++i) { const int p = lane + 64 * i, row = p >> 3, tok = tl_ - 3 + row; \
            xr[i] = (p < 280 && tok >= 0) ? *(const u32x4*)(xg + ((size_t)b * SEQ + tok) * QXP + colx + (p & 7) * 8) : (u32x4){0u, 0u, 0u, 0u}; } \
        _Pragma("unroll") for (int i = 0; i < 4; ++i) gr[i] = *(const u32x4*)(xg + ((size_t)b * SEQ + tl_ + i * 8 + (lane >> 3)) * QXP + 1024 + colx + (lane & 7) * 8); } while (0)
    RNN_LOAD(0);
    for (int i = tid; i < 1536; i += 512) *(LAS u32x4*)(lds + L_W + i * 16) = *(const u32x4*)((const char*)wfrag + (size_t)blk * 24576 + i * 16);
    if (tid < 256) cw[tid] = w_conv[(tid >> 6) * 1024 + blk * 64 + (tid & 63)];
    else if (tid < 320) cw[tid] = b_conv[blk * 64 + (tid - 256)];
    if (tid < 64) { gb[tid] = b_rg[blk * 64 + tid]; gb[64 + tid] = b_ig[blk * 64 + tid];
        const float l = lam[blk * 64 + tid]; const float sp = log1pf(expf(-l)); gb[128 + tid] = -8.0f * sp * LOG2E; carry[tid] = 0.f; }
    LDS_WAIT(); __syncthreads();
    LAS unsigned char* stg = lds + L_STG + wid * 4096;
    LAS unsigned char* xs = lds + L_XS + wid * 5120;
    for (int seg = 0; seg < 8; ++seg) {
        const int tl = seg * 256 + wid * 32;
#pragma unroll
        for (int i = 0; i < 5; ++i) { const int p = lane + 64 * i; if (p < 280) *(LAS u32x4*)(xs + (p >> 3) * XSP + (p & 7) * 16) = xr[i]; }
#pragma unroll
        for (int i = 0; i < 4; ++i) *(LAS u32x4*)(stg + (i * 8 + (lane >> 3)) * 128 + (lane & 7) * 16) = gr[i];
        if (seg < 7) RNN_LOAD(seg + 1);
        bf16x8 ua[4];
        {
#pragma unroll
          for (int ks = 0; ks < 4; ++ks) { const int ch0 = 16 * ks + 8 * hh; float a8[8];
#pragma unroll
              for (int j = 0; j < 8; ++j) a8[j] = cw[256 + ch0 + j];
#pragma unroll
              for (int tap = 0; tap < 4; ++tap) { const u32x4 xv = *(const LAS u32x4*)(xs + (n31 + tap) * XSP + ch0 * 2);
                  const LAS float* cwt = cw + tap * 64 + ch0;
                  a8[0] += cwt[0] * bflo(xv.x); a8[1] += cwt[1] * bfhi(xv.x); a8[2] += cwt[2] * bflo(xv.y); a8[3] += cwt[3] * bfhi(xv.y);
                  a8[4] += cwt[4] * bflo(xv.z); a8[5] += cwt[5] * bfhi(xv.z); a8[6] += cwt[6] * bflo(xv.w); a8[7] += cwt[7] * bfhi(xv.w); }
              u32x4 w; w.x = cvt_pk(a8[0], a8[1]); w.y = cvt_pk(a8[2], a8[3]); w.z = cvt_pk(a8[4], a8[5]); w.w = cvt_pk(a8[6], a8[7]);
              ua[ks] = __builtin_bit_cast(bf16x8, w); } }
        f32x16 C[6];
#pragma unroll
        for (int nb = 0; nb < 6; ++nb) { C[nb] = f32x16{};
#pragma unroll
            for (int ks = 0; ks < 4; ++ks) { const bf16x8 wf = *(const LAS bf16x8*)(lds + L_W + ((nb * 4 + ks) * 64 + lane) * 16);
                C[nb] = __builtin_amdgcn_mfma_f32_32x32x16_bf16(ua[ks], wf, C[nb], 0, 0, 0); } }
        float hl[2][16], Pl[2][16];
#pragma unroll
        for (int cb = 0; cb < 2; ++cb) { const int n = 32 * cb + n31; const float brg = gb[n], big = gb[64 + n], cA = gb[128 + n];
#pragma unroll
            for (int r = 0; r < 16; ++r) { const float rg = sigmoidf_(C[cb][r] + brg), ig = sigmoidf_(C[2 + cb][r] + big);
                const float a = fast_exp2(cA * rg); const float mult = __builtin_amdgcn_sqrtf(fmaxf(1.0f - a * a, 0.f));
                Pl[cb][r] = a; hl[cb][r] = mult * ig * C[4 + cb][r]; }
#pragma unroll
            for (int j = 0; j < 4; ++j) {
#pragma unroll
                for (int k = 1; k < 4; ++k) { hl[cb][4 * j + k] = Pl[cb][4 * j + k] * hl[cb][4 * j + k - 1] + hl[cb][4 * j + k]; Pl[cb][4 * j + k] *= Pl[cb][4 * j + k - 1]; } }
            float cin = 0.f, pin = 1.f, cinj[4], pinj[4];
#pragma unroll
            for (int g = 0; g < 8; ++g) { const int j = g >> 1; const bool own = (hh == (g & 1));
                if (own) { cinj[j] = cin; pinj[j] = pin; }
                const float co = Pl[cb][4 * j + 3] * cin + hl[cb][4 * j + 3], po = pin * Pl[cb][4 * j + 3];
                float ca = co, cb2 = co, pa = po, pb = po; swap32(ca, cb2); swap32(pa, pb);
                cin = (g & 1) ? cb2 : ca; pin = (g & 1) ? pb : pa; }
#pragma unroll
            for (int j = 0; j < 4; ++j)
#pragma unroll
                for (int k = 0; k < 4; ++k) { hl[cb][4 * j + k] += Pl[cb][4 * j + k] * cinj[j]; Pl[cb][4 * j + k] *= pinj[j]; }
            if (hh == 0) { sum[(wid * 64 + n) * 2] = pin; sum[(wid * 64 + n) * 2 + 1] = cin; }
        }
        LDS_WAIT(); __syncthreads();
#pragma unroll
        for (int cb = 0; cb < 2; ++cb) { const int n = 32 * cb + n31; float hin = carry[n];
            { float sa[7], sb[7];
#pragma unroll
              for (int w = 0; w < 7; ++w) { const f32x2 t2 = *(const LAS f32x2*)(sum + (w * 64 + n) * 2); sa[w] = t2[0]; sb[w] = t2[1]; }
#pragma unroll
              for (int w = 0; w < 7; ++w) if (w < wid) hin = sa[w] * hin + sb[w]; }
            float hend = 0.f;
#pragma unroll
            for (int r = 0; r < 16; ++r) { const float hv = hl[cb][r] + Pl[cb][r] * hin; if (r == 15) hend = hv;
                LAS bf16_t* gp = (LAS bf16_t*)(stg + att::crow(r, hh) * 128 + n * 2);
                const float g = bf2f(*gp); const float ge = g * sigmoidf_(1.5957691216057308f * (g + 0.044715f * g * g * g));
                *gp = (bf16_t)cvt_pk(hv * ge, 0.f); }
            if (wid == 7 && hh == 1) park[n] = hend;
        }
        LDS_WAIT();
#pragma unroll
        for (int i = 0; i < 4; ++i) { const u32x4 v = *(const LAS u32x4*)(stg + (i * 8 + (lane >> 3)) * 128 + (lane & 7) * 16);
            if (do_store) *(u32x4*)(xg + ((size_t)b * SEQ + tl + i * 8 + (lane >> 3)) * QXP + 1024 + colx + (lane & 7) * 8) = v; }
        LDS_WAIT(); __syncthreads();
        if (tid < 64) carry[tid] = park[tid];
        LDS_WAIT(); __syncthreads();
    }
#undef RNN_LOAD
}
}

__device__ __forceinline__ void transpose_block(const float* W, int ldw, bf16_t* dst, int ldd, LAS float* scr, int lane) {
#pragma unroll 8
    for (int i = 0; i < 32; ++i) { const int kk = 2 * i + (lane >> 5); scr[kk * 33 + (lane & 31)] = W[(size_t)kk * ldw + (lane & 31)]; }
    LDS_WAIT(); asm volatile("" ::: "memory");
    const int c = lane & 7;
#pragma unroll
    for (int j = 0; j < 4; ++j) { const int n = (lane >> 3) + 8 * j; const LAS float* s = scr + (8 * c) * 33 + n;
        u32x4 o; o.x = pk2(s[0 * 33], s[1 * 33]); o.y = pk2(s[2 * 33], s[3 * 33]); o.z = pk2(s[4 * 33], s[5 * 33]); o.w = pk2(s[6 * 33], s[7 * 33]);
        *(u32x4*)(dst + (size_t)n * ldd + 8 * c) = o; }
    LDS_WAIT(); asm volatile("" ::: "memory");
}

struct In {
    const float *x, *c, *w_ada, *b_ada, *g_pre_mix, *g_post_mix, *g_pre_ffn, *g_post_ffn, *w_in, *b_forget, *w_conv, *b_conv, *w_rg, *b_rg, *w_ig, *b_ig, *lam,
        *w_ba, *w_br, *w_out, *w_router, *r_bias, *w_eg, *w_eu, *w_ed, *w_sg, *w_su, *w_sd;
};

struct TItem { const float* W; bf16_t* dst; int ldw, ldd; float sc; };
__device__ __forceinline__ bool dec_mat(int& r, const float* W, int K, int N, int ldw, bf16_t* dst, int ldd, TItem& t, float sc8 = 0.f) {
    const int nblk = N / 32, items = (K / 64) * nblk;
    if (r >= items) { r -= items; return false; }
    const int kb = r / nblk, nb = r % nblk;
    t.W = W + (size_t)(64 * kb) * ldw + 32 * nb; t.ldw = ldw; t.ldd = ldd; t.sc = sc8;
    t.dst = (sc8 > 0.f) ? (bf16_t*)((unsigned char*)dst + (size_t)(32 * nb) * ldd + 64 * kb) : dst + (size_t)(32 * nb) * ldd + 64 * kb; return true;
}
__device__ __forceinline__ void tb_load(const TItem& t, float (&v)[32], int lane) {
#pragma unroll
    for (int i = 0; i < 32; ++i) v[i] = t.W[(size_t)(2 * i + (lane >> 5)) * t.ldw + (lane & 31)];
}
__device__ __forceinline__ void tb_store(const TItem& t, const float (&v)[32], LAS float* scr, int lane) {
#pragma unroll
    for (int i = 0; i < 32; ++i) scr[(2 * i + (lane >> 5)) * 33 + (lane & 31)] = v[i];
    LDS_WAIT(); asm volatile("" ::: "memory");
    if (t.sc > 0.f) {
        const int c = lane & 3; unsigned char* d8 = (unsigned char*)t.dst; const float sc = t.sc;
#pragma unroll
        for (int j = 0; j < 2; ++j) { const int n = (lane >> 2) + 16 * j; const LAS float* sp = scr + (16 * c) * 33 + n; int w[4];
#pragma unroll
            for (int q = 0; q < 4; ++q) { int d = 0; d = __builtin_amdgcn_cvt_pk_fp8_f32(sp[(4 * q) * 33] * sc, sp[(4 * q + 1) * 33] * sc, d, false);
                d = __builtin_amdgcn_cvt_pk_fp8_f32(sp[(4 * q + 2) * 33] * sc, sp[(4 * q + 3) * 33] * sc, d, true); w[q] = d; }
            *(u32x4*)(d8 + (size_t)n * t.ldd + 16 * c) = (u32x4){(unsigned)w[0], (unsigned)w[1], (unsigned)w[2], (unsigned)w[3]}; }
    } else {
        const int c = lane & 7;
#pragma unroll
        for (int j = 0; j < 4; ++j) { const int n = (lane >> 3) + 8 * j; const LAS float* sp = scr + (8 * c) * 33 + n;
            u32x4 o; o.x = cvt_pk(sp[0 * 33], sp[1 * 33]); o.y = cvt_pk(sp[2 * 33], sp[3 * 33]); o.z = cvt_pk(sp[4 * 33], sp[5 * 33]); o.w = cvt_pk(sp[6 * 33], sp[7 * 33]);
            *(u32x4*)(t.dst + (size_t)n * t.ldd + 8 * c) = o; }
    }
    LDS_WAIT(); asm volatile("" ::: "memory");
}

__device__ __forceinline__ void p0_prologue(const In& in, unsigned char* ws, LAS unsigned char* lds, int vcu, int G) {
    const int tid = threadIdx.x, lane = tid & 63; const int wave = __builtin_amdgcn_readfirstlane(tid >> 6);
    bf16_t* WIN = (bf16_t*)(ws + WS_WIN); bf16_t* WBA = (bf16_t*)(ws + WS_WBA); bf16_t* WOUT = (bf16_t*)(ws + WS_WOUT);
    bf16_t* WROUT = (bf16_t*)(ws + WS_WROUT); unsigned char* WGU = ws + WS_WGU; unsigned char* WDN = ws + WS_WDN;
    if (vcu < 192) {
        LAS float* s = (LAS float*)lds;
        const int kq = tid >> 5, col = tid & 31, col0 = vcu * 32;
        float w[16][4];
#pragma unroll
        for (int k4 = 0; k4 < 16; ++k4)
#pragma unroll
            for (int e = 0; e < 4; ++e) w[k4][e] = in.w_ada[(size_t)(64 * kq + 4 * k4 + e) * 6144 + col0 + col];
        { f32x4 cv[16];
#pragma unroll
          for (int j = 0; j < 16; ++j) cv[j] = *(const f32x4*)(in.c + 4 * (tid + 512 * j));
#pragma unroll
          for (int j = 0; j < 16; ++j) { f32x4 o; o[0] = cv[j][0] * sigmoidf_(cv[j][0]); o[1] = cv[j][1] * sigmoidf_(cv[j][1]); o[2] = cv[j][2] * sigmoidf_(cv[j][2]); o[3] = cv[j][3] * sigmoidf_(cv[j][3]);
              *(LAS f32x4*)(s + 4 * (tid + 512 * j)) = o; } }
        LDS_WAIT(); __syncthreads();
        float acc[32];
#pragma unroll
        for (int bb = 0; bb < 32; ++bb) acc[bb] = 0.f;
#pragma unroll
        for (int k4 = 0; k4 < 16; ++k4) { const int k = 64 * kq + 4 * k4;
#pragma unroll
            for (int bb = 0; bb < 32; ++bb) { const f32x4 sv = *(const LAS f32x4*)(s + bb * 1024 + k); acc[bb] += (sv[0] * w[k4][0] + sv[1] * w[k4][1]) + (sv[2] * w[k4][2] + sv[3] * w[k4][3]); } }
        __syncthreads();
        LAS float* red = (LAS float*)lds;
#pragma unroll
        for (int bb = 0; bb < 32; ++bb) red[(kq * 32 + bb) * 32 + col] = acc[bb];
        LDS_WAIT(); __syncthreads();
        float* mod = (float*)(ws + WS_MOD);
        for (int o = tid; o < 1024; o += 512) { const int bb = o >> 5, cc = o & 31; float v = in.b_ada[col0 + cc];
#pragma unroll
            for (int q = 0; q < 16; ++q) v += red[(q * 32 + bb) * 32 + cc];
            mod[(size_t)bb * 6144 + col0 + cc] = v; }
        __syncthreads();
    }
    { const int gt = vcu * 512 + tid, GT = G * 512;
      float* WF = (float*)(ws + WS_WF);
      for (int i = gt; i < 8 * 1024; i += GT) { const int hd = i >> 10, k = i & 1023; WF[i] = in.w_in[(size_t)k * INCOLS + 1536 + hd]; }
      bf16_t* WR = (bf16_t*)(ws + WS_WRNN);
      for (int i = gt; i < 16 * 6 * 4 * 64 * 8; i += GT) { const int jj = i & 7, ln = (i >> 3) & 63, ks = (i >> 9) & 3, nbk = (i >> 11); const int nb = nbk % 6, blk = nbk / 6;
          const int c = 16 * ks + 8 * (ln >> 5) + jj, n = 32 * nb + (ln & 31); float v;
          if (n < 64) v = in.w_rg[((size_t)blk * 64 + c) * 64 + n]; else if (n < 128) v = in.w_ig[((size_t)blk * 64 + c) * 64 + (n - 64)]; else v = (c == n - 128) ? 1.f : 0.f;
          WR[i] = (bf16_t)f2bf(v); } }
    LAS float* scr = (LAS float*)(lds + wave * 16384);
    const int gw = vcu * NWAVES + wave, NGW = G * NWAVES;
    constexpr int I_EXP = (1024 / 64) * (256 / 32);
    constexpr int NITEMS = 768 + 2048 + 256 + 512 + 512 + 32 + 3 * 65 * I_EXP;
    auto decode = [&](int it, TItem& t) {
        int r = it;
        if (dec_mat(r, in.w_in, 1024, 1536, INCOLS, WIN, 1024, t, 32.f)) return;
        if (dec_mat(r, in.w_in + 1544, 1024, 4096, INCOLS, (bf16_t*)((unsigned char*)WIN + (size_t)1536 * 1024), 1024, t, 32.f)) return;
        if (dec_mat(r, in.w_ba, 512, 1024, 1024, WBA, 1536, t)) return;
        if (dec_mat(r, in.w_br, 1024, 1024, 1024, WBA + 512, 1536, t)) return;
        if (dec_mat(r, in.w_out, 1024, 1024, 1024, WOUT, 1024, t)) return;
        if (dec_mat(r, in.w_router, 1024, 64, 64, WROUT, 1024, t)) return;
        const int kind = r / (65 * I_EXP), rr = r % (65 * I_EXP), e = rr / I_EXP, ii = rr % I_EXP;
        if (kind < 2) {
            const float* W = (e < 64) ? ((kind == 0 ? in.w_eg : in.w_eu) + (size_t)e * 1024 * 256) : (kind == 0 ? in.w_sg : in.w_su);
            const int kb = ii / 8, nb = ii % 8, n0 = 32 * nb;
            t.W = W + (size_t)(64 * kb) * 256 + n0; t.ldw = 256; t.dst = (bf16_t*)(WGU + ((size_t)e * 512 + (n0 >> 7) * 256 + kind * 128 + (n0 & 127)) * 1024 + 64 * kb); t.ldd = 1024; t.sc = 32.f;
        } else {
            const float* W = (e < 64) ? (in.w_ed + (size_t)e * 256 * 1024) : in.w_sd;
            const int kb = ii / 32, nb = ii % 32;
            t.W = W + (size_t)(64 * kb) * 1024 + 32 * nb; t.ldw = 1024; t.dst = (bf16_t*)(WDN + ((size_t)e * 1024 + 32 * nb) * 256 + 64 * kb); t.ldd = 256; t.sc = 16.f;
        }
    };
    for (int it = gw; it < NITEMS; it += 2 * NGW) {
        TItem ta, tb; float va[32], vb[32];
        const bool hb = (it + NGW) < NITEMS;
        decode(it, ta); tb_load(ta, va, lane);
        if (hb) { decode(it + NGW, tb); tb_load(tb, vb, lane); }
        tb_store(ta, va, scr, lane);
        if (hb) tb_store(tb, vb, scr, lane);
    }
}

__device__ __forceinline__ void p1_norm(int tile, const In& in, unsigned char* ws, LAS unsigned char* lds) {
    const int tid = threadIdx.x, lane = tid & 63; const int wave = __builtin_amdgcn_readfirstlane(tid >> 6);
    const int b = tile >> 3;
    LAS float* lc = (LAS float*)(lds + 32768);
    LAS float* wtot = (LAS float*)(lds + 40960);
    const float* WF = (const float*)(ws + WS_WF); const float* mod = (const float*)(ws + WS_MOD) + (size_t)b * 6144;
    __syncthreads();
    constexpr int NHR = 5;
    LAS float* wf = (LAS float*)lds;
    for (int i = tid; i < 2048; i += 512) *(LAS f32x4*)(wf + 4 * i) = *(const f32x4*)(WF + 4 * i);
    f32x4 wfr[NHR][4];
#pragma unroll
    for (int hd = 0; hd < NHR; ++hd)
#pragma unroll
        for (int j = 0; j < 4; ++j) wfr[hd][j] = *(const f32x4*)(WF + hd * 1024 + 4 * lane + 256 * j);
    f32x4 A[4], B[4];
#pragma unroll
    for (int j = 0; j < 4; ++j) { const int col = 4 * lane + 256 * j; const f32x4 g = *(const f32x4*)(in.g_pre_mix + col), sc = *(const f32x4*)(mod + 1024 + col); A[j] = g * (sc + 1.0f); B[j] = *(const f32x4*)(mod + col); }
    const int hdl = lane >> 3;
    const float bfg = in.b_forget[hdl];
    const bool b5 = (lane & 32) != 0, b4 = (lane & 16) != 0, b3 = (lane & 8) != 0;
    LDS_WAIT(); __syncthreads();
    unsigned char* H8 = ws + R_H;
    const int rot = (tile * 5) & 31;
    f32x4 nv[4];
#pragma unroll
    for (int j = 0; j < 4; ++j) nv[j] = *(const f32x4*)(in.x + ((size_t)tile * 256 + ((rot & 31) << 3) + wave) * 1024 + 4 * lane + 256 * j);
    for (int i = 0; i < 32; ++i) { const int tl = (((i + rot) & 31) << 3) + wave; const size_t tok = (size_t)tile * 256 + tl;
        f32x4 v[4]; float ss = 0.f;
#pragma unroll
        for (int j = 0; j < 4; ++j) v[j] = nv[j];
        { const size_t ntok = (size_t)tile * 256 + (((i + 1 + rot) & 31) << 3) + wave;
#pragma unroll
          for (int j = 0; j < 4; ++j) nv[j] = *(const f32x4*)(in.x + ntok * 1024 + 4 * lane + 256 * j); }
#pragma unroll
        for (int j = 0; j < 4; ++j) ss += (v[j][0] * v[j][0] + v[j][1] * v[j][1]) + (v[j][2] * v[j][2] + v[j][3] * v[j][3]);
        const float rstd = fast_rsq(wave_sum(ss) * (1.0f / 1024.0f) + NORM_EPS);
#pragma unroll
        for (int j = 0; j < 4; ++j) { v[j] = v[j] * rstd * A[j] + B[j];
            int d = 0; d = __builtin_amdgcn_cvt_pk_fp8_f32(v[j][0], v[j][1], d, false); d = __builtin_amdgcn_cvt_pk_fp8_f32(v[j][2], v[j][3], d, true); *(unsigned*)(H8 + tok * 1024 + 4 * lane + 256 * j) = (unsigned)d; }
        float p[8];
#pragma unroll
        for (int hd = 0; hd < 8; ++hd) { float a = 0.f;
#pragma unroll
            for (int j = 0; j < 4; ++j) { f32x4 w4; if (hd < NHR) w4 = wfr[hd < NHR ? hd : 0][j]; else w4 = *(const LAS f32x4*)(wf + hd * 1024 + 4 * lane + 256 * j); a += (v[j][0] * w4[0] + v[j][1] * w4[1]) + (v[j][2] * w4[2] + v[j][3] * w4[3]); }
            p[hd] = a; }
        float q[4], r2[2];
#pragma unroll
        for (int j = 0; j < 4; ++j) { float X = p[j], Y = p[j + 4]; swap32(X, Y); q[j] = X + Y; }
#pragma unroll
        for (int j = 0; j < 2; ++j) { float X = q[j], Y = q[j + 2]; swap16(X, Y); r2[j] = X + Y; }
        float f; { const float send = b3 ? r2[0] : r2[1], keep = b3 ? r2[1] : r2[0]; f = keep + dpp_f<0x128, 0xF>(send); }
        f = sum8(f);
        f += bfg;
        const float ls = -fast_log2(1.0f + fast_exp2(-f * LOG2E));
        if ((lane & 7) == 0) lc[tl * 8 + hdl] = ls;
    }
    LDS_WAIT(); __syncthreads();
    if (tid < 64) { const int hd = tid & 7, sg = tid >> 3; float r = 0.f;
        float pv[32];
#pragma unroll
        for (int k = 0; k < 32; ++k) pv[k] = lc[(sg * 32 + k) * 8 + hd];
#pragma unroll
        for (int k = 0; k < 32; ++k) { r += pv[k]; lc[(sg * 32 + k) * 8 + hd] = r; }
        wtot[sg * 8 + hd] = r; }
    LDS_WAIT(); __syncthreads();
    float* LC = (float*)(ws + WS_LCUM); float* TOT = (float*)(ws + WS_TOT);
    for (int i = tid; i < 2048; i += 512) { const int tk = i >> 3, hd = i & 7; float off = 0.f; const int w = tk >> 5;
#pragma unroll
        for (int q = 0; q < 7; ++q) { const float wq = wtot[q * 8 + hd]; off += (q < w) ? wq : 0.f; }
        LC[((size_t)tile * 256 + tk) * 8 + hd] = lc[i] + off; }
    if (tid < 8) { float t = 0.f;
#pragma unroll
        for (int q = 0; q < 8; ++q) t += wtot[q * 8 + tid];
        TOT[tile * 8 + tid] = t; }
}

namespace p6 {
constexpr int HP = 2064;
constexpr int L_H2 = 0, L_PART = 66560, L_HIST = 99328;
__device__ __forceinline__ void run(int tile, const In& in, float* out, unsigned char* ws, LAS unsigned char* lds, bool do_store = true) {
    const int tid = threadIdx.x, lane = tid & 63, n31 = lane & 31, hh = lane >> 5; const int wave = __builtin_amdgcn_readfirstlane(tid >> 6);
    const int b = tile >> 3;
    const float* mod = (const float*)(ws + WS_MOD) + (size_t)b * 6144;
    bf16_t* H = (bf16_t*)(ws + R_H); unsigned char* H8 = ws + R_H8; const float* SSQ = (const float*)(ws + WS_SSQ); const bf16_t* WROUT = (const bf16_t*)(ws + WS_WROUT);
    int* EP = (int*)(ws + WS_EP); float* EW = (float*)(ws + WS_EW); int* HIST = (int*)(ws + WS_HIST);
    LAS float* part = (LAS float*)(lds + L_PART); LAS int* histl = (LAS int*)(lds + L_HIST);
    f32x4 G1[4], A2[4], B2[4];
#pragma unroll
    for (int j = 0; j < 4; ++j) { const int col = 4 * lane + 256 * j;
        G1[j] = *(const f32x4*)(mod + 2048 + col) * *(const f32x4*)(in.g_post_mix + col);
        A2[j] = *(const f32x4*)(in.g_pre_ffn + col) * (*(const f32x4*)(mod + 4096 + col) + 1.0f);
        B2[j] = *(const f32x4*)(mod + 3072 + col); }
    const int kq = wave >> 1, nb = wave & 1;
    bf16x8 wr[16];
#pragma unroll
    for (int ks = 0; ks < 16; ++ks) wr[ks] = *(const bf16x8*)(WROUT + (size_t)(32 * nb + n31) * 1024 + 256 * kq + 16 * ks + 8 * hh);
    const float rbias = in.r_bias[lane];
    __syncthreads();
    if (tid < 64) histl[tid] = 0;
    LDS_WAIT(); __syncthreads();
    u32x2 amv[4], bmv[4]; f32x4 axv[4], bxv[4]; float asq, bsq;
#define P6_LOAD(P, n_) do { const size_t tk_ = (size_t)tile * 256 + ((((n_) >> 2) + tile) & 7) * 32 + wave * 4 + ((n_) & 3); \
        _Pragma("unroll") for (int j = 0; j < 4; ++j) { P##mv[j] = *(const u32x2*)(H + tk_ * 1024 + 4 * lane + 256 * j); P##xv[j] = *(const f32x4*)(in.x + tk_ * 1024 + 4 * lane + 256 * j); } \
        P##sq = SSQ[tk_ * 16 + (lane & 15)]; } while (0)
    P6_LOAD(a, 0); P6_LOAD(b, 1);
    for (int sub0 = 0; sub0 < 8; ++sub0) { const int sub = (sub0 + tile) & 7;
#pragma unroll
        for (int i = 0; i < 4; ++i) { const int tl = wave * 4 + i; const size_t tok = (size_t)tile * 256 + sub * 32 + tl;
            u32x2 mv[4]; f32x4 xv[4];
#pragma unroll
            for (int j = 0; j < 4; ++j) { mv[j] = amv[j]; xv[j] = axv[j]; amv[j] = bmv[j]; axv[j] = bxv[j]; }
            const float sq = asq; asq = bsq;
            { const int nn = sub0 * 4 + i + 2; P6_LOAD(b, nn < 32 ? nn : 31); }
            const float s1 = wave_sum(lane < 16 ? sq : 0.f);
            const float rstd1 = fast_rsq(s1 * (1.0f / 1024.0f) + NORM_EPS);
            float ss = 0.f;
#pragma unroll
            for (int j = 0; j < 4; ++j) { f32x4 m; m[0] = bflo(mv[j].x); m[1] = bfhi(mv[j].x); m[2] = bflo(mv[j].y); m[3] = bfhi(mv[j].y);
                xv[j] = xv[j] + G1[j] * (m * rstd1);
                if (do_store) { u32x2 w1; w1.x = cvt_pk(xv[j][0], xv[j][1]); w1.y = cvt_pk(xv[j][2], xv[j][3]); *(u32x2*)(H + tok * 1024 + 4 * lane + 256 * j) = w1; }
                ss += (xv[j][0] * xv[j][0] + xv[j][1] * xv[j][1]) + (xv[j][2] * xv[j][2] + xv[j][3] * xv[j][3]); }
            const float rstd2 = fast_rsq(wave_sum(ss) * (1.0f / 1024.0f) + NORM_EPS);
#pragma unroll
            for (int j = 0; j < 4; ++j) { const f32x4 hv = xv[j] * rstd2 * A2[j] + B2[j];
                u32x2 w; w.x = cvt_pk(hv[0], hv[1]); w.y = cvt_pk(hv[2], hv[3]);
                if (do_store) { int d = 0; d = __builtin_amdgcn_cvt_pk_fp8_f32(hv[0], hv[1], d, false); d = __builtin_amdgcn_cvt_pk_fp8_f32(hv[2], hv[3], d, true);
                    *(unsigned*)(H8 + tok * 1024 + 4 * lane + 256 * j) = (unsigned)d; }
                *(LAS u32x2*)(lds + L_H2 + tl * HP + (4 * lane + 256 * j) * 2) = w; }
        }
        LDS_WAIT(); __syncthreads();
        { f32x16 acc = f32x16{};
#pragma unroll
          for (int ks = 0; ks < 16; ++ks) { const bf16x8 a = *(const LAS bf16x8*)(lds + L_H2 + n31 * HP + (256 * kq + 16 * ks + 8 * hh) * 2);
              acc = __builtin_amdgcn_mfma_f32_32x32x16_bf16(a, wr[ks], acc, 0, 0, 0); }
#pragma unroll
          for (int r = 0; r < 16; ++r) part[(kq * 32 + att::crow(r, hh)) * 64 + 32 * nb + n31] = acc[r]; }
        LDS_WAIT(); __syncthreads();
        for (int i = 0; i < 4; ++i) { const int tl = wave * 4 + i; const size_t tok = (size_t)tile * 256 + sub * 32 + tl;
            const float logit = (part[(0 * 32 + tl) * 64 + lane] + part[(1 * 32 + tl) * 64 + lane]) + (part[(2 * 32 + tl) * 64 + lane] + part[(3 * 32 + tl) * 64 + lane]);
            const float score = sigmoidf_(logit); const float sel = score + rbias;
            const float m1 = max8(sel); const float cand = (sel == m1) ? (float)(lane & 7) : 8.f; const float imin = -max8(-cand);
            const float m2 = max8(((float)(lane & 7) == imin) ? -INFINITY : sel);
            const float gs = m1 + m2;
            int gr = 0; const int g = lane >> 3;
#pragma unroll
            for (int j = 0; j < 8; ++j) { const float o = __builtin_bit_cast(float, __builtin_amdgcn_readlane(__builtin_bit_cast(int, gs), j * 8)); gr += (o > gs || (o == gs && j < g)) ? 1 : 0; }
            const bool gsel = gr < 4; const float msel = gsel ? sel : -INFINITY;
            int rk = 0;
#pragma unroll
            for (int j = 0; j < 64; ++j) { const float o = __builtin_bit_cast(float, __builtin_amdgcn_readlane(__builtin_bit_cast(int, msel), j)); rk += (o > msel || (o == msel && j < lane)) ? 1 : 0; }
            const bool chosen = gsel && rk < 6;
            const float wsum = wave_sum(chosen ? score : 0.f);
            if (chosen) { const int li = __hip_atomic_fetch_add(histl + lane, 1, __ATOMIC_RELAXED, __HIP_MEMORY_SCOPE_WORKGROUP);
                if (do_store) { EP[tok * 6 + rk] = lane | (li << 8); EW[tok * 6 + rk] = score / wsum * 2.5f; } }
        }
    }
    LDS_WAIT(); __syncthreads();
    if (tid < 64 && do_store) HIST[tile * 64 + tid] = histl[tid];
}
}

__device__ __forceinline__ void p7_place(int tile, unsigned char* ws, LAS unsigned char* lds) {
    const int tid = threadIdx.x;
    LAS int* cntb = (LAS int*)lds; LAS int* tot = cntb + 64; LAS int* base = cntb + 128; LAS int* tst = cntb + 192;
    const int* HIST = (const int*)(ws + WS_HIST); const int* EP = (const int*)(ws + WS_EP); int* POS = (int*)(ws + WS_POS);
    int* SLOTTOK = (int*)(ws + WS_SLOTTOK); int* RTAB = (int*)(ws + WS_RTAB);
    __syncthreads();
    { LAS int* pc = cntb + 320; LAS int* pt = pc + 512;
      const int e = tid & 63, part = tid >> 6; int cb = 0, tt = 0;
#pragma unroll 16
      for (int i = part * 32; i < part * 32 + 32; ++i) { const int v = HIST[i * 64 + e]; tt += v; if (i < tile) cb += v; }
      pc[tid] = cb; pt[tid] = tt;
      LDS_WAIT(); __syncthreads();
      if (tid < 64) { int a = 0, b2 = 0;
#pragma unroll
          for (int q = 0; q < 8; ++q) { a += pc[q * 64 + tid]; b2 += pt[q * 64 + tid]; }
          cntb[tid] = a; tot[tid] = b2; } }
    LDS_WAIT(); __syncthreads();
    if (tid < 64) { const int nt_e = (tot[tid] + 255) >> 8; int inc = nt_e;
#pragma unroll
        for (int o = 1; o < 64; o <<= 1) { const int up = __shfl_up(inc, o); if (tid >= o) inc += up; }
        tst[tid] = inc - nt_e; if (tid == 63) tst[64] = inc; }
    LDS_WAIT(); __syncthreads();
    if (tid < 64) base[tid] = tst[tid] * 256 + cntb[tid];
    if (tile == 0) { if (tid < 65) RTAB[tid] = tst[tid]; if (tid < 64) RTAB[128 + tid] = tot[tid]; }
    LDS_WAIT(); __syncthreads();
    for (int p = tid; p < 1536; p += 512) { const int token = tile * 256 + p / 6; const int ep = EP[(size_t)tile * 1536 + p]; const int e = ep & 255, li = ep >> 8;
        const int slot = base[e] + li; POS[(size_t)tile * 1536 + p] = slot; SLOTTOK[slot] = token; }
}

__device__ __forceinline__ void combine_all(const In& in, float* out, unsigned char* ws, int gw, int NGW, bool do_store = true) {
    const int lane = threadIdx.x & 63;
    const unsigned char* Y = (const unsigned char*)(ws + R_Y); const int* POS = (const int*)(ws + WS_POS); const float* EW = (const float*)(ws + WS_EW);
    const bf16_t* X1 = (const bf16_t*)(ws + R_H);
    const int per = (T + NGW - 1) / NGW, i0 = gw * per, i1 = (i0 + per < T) ? i0 + per : T;
    if (i0 >= T) return;
    int nslot = 0; float nw = 1.0f;
#define CMB_SLOTS(ix) do { nslot = 0; nw = 1.0f; if ((ix) < i1) { if (lane < 6) { nslot = POS[(size_t)(ix) * 6 + lane]; nw = EW[(size_t)(ix) * 6 + lane]; } if (lane == 6) nslot = (RT_MAX + ((ix) >> 8)) * 256 + ((ix) & 255); } } while (0)
    u32x2 ny[7][2]; u32x4 nx[2];
#define CMB_ROWS(ix) do { _Pragma("unroll") for (int k = 0; k < 7; ++k) { const int sl = __builtin_amdgcn_readlane(nslot, k); \
            _Pragma("unroll") for (int j = 0; j < 2; ++j) ny[k][j] = *(const u32x2*)(Y + (size_t)sl * 1024 + 8 * lane + 512 * j); } \
        _Pragma("unroll") for (int j = 0; j < 2; ++j) nx[j] = *(const u32x4*)(X1 + (size_t)(ix) * 1024 + 8 * lane + 512 * j); } while (0)
    CMB_SLOTS(i0); CMB_ROWS(i0);
    float cw = nw;
    CMB_SLOTS(i0 + 1);
    f32x4 gfr[2][2]; int bcur = -1;
    for (int idx = i0; idx < i1; ++idx) { const size_t tok = (size_t)idx; const int b = (int)(tok >> 11);
        if (b != bcur) { bcur = b; const float* mod = (const float*)(ws + WS_MOD) + (size_t)b * 6144;
#pragma unroll
            for (int j = 0; j < 2; ++j)
#pragma unroll
                for (int hq = 0; hq < 2; ++hq) { const int col = 8 * lane + 512 * j + 4 * hq; gfr[j][hq] = *(const f32x4*)(mod + 5120 + col) * *(const f32x4*)(in.g_post_ffn + col); } }
        u32x2 cy[7][2]; u32x4 cx[2]; const float w = cw;
#pragma unroll
        for (int k = 0; k < 7; ++k) { cy[k][0] = ny[k][0]; cy[k][1] = ny[k][1]; }
        cx[0] = nx[0]; cx[1] = nx[1];
        if (idx + 1 < i1) { CMB_ROWS(idx + 1); cw = nw; CMB_SLOTS(idx + 2); }
        float a[2][8];
#pragma unroll
        for (int j = 0; j < 2; ++j)
#pragma unroll
            for (int e = 0; e < 8; ++e) a[j][e] = 0.f;
#pragma unroll
        for (int k = 0; k < 7; ++k) { const float wk = __builtin_bit_cast(float, __builtin_amdgcn_readlane(__builtin_bit_cast(int, w), k));
#pragma unroll
            for (int j = 0; j < 2; ++j) { const u32x2 v = cy[k][j];
                const f32x2 p0 = __builtin_amdgcn_cvt_pk_f32_fp8((int)v.x, false), p1 = __builtin_amdgcn_cvt_pk_f32_fp8((int)v.x, true);
                const f32x2 p2 = __builtin_amdgcn_cvt_pk_f32_fp8((int)v.y, false), p3 = __builtin_amdgcn_cvt_pk_f32_fp8((int)v.y, true);
                a[j][0] += wk * p0[0]; a[j][1] += wk * p0[1]; a[j][2] += wk * p1[0]; a[j][3] += wk * p1[1];
                a[j][4] += wk * p2[0]; a[j][5] += wk * p2[1]; a[j][6] += wk * p3[0]; a[j][7] += wk * p3[1]; } }
        float ss = 0.f;
#pragma unroll
        for (int j = 0; j < 2; ++j)
#pragma unroll
            for (int e = 0; e < 8; ++e) ss += a[j][e] * a[j][e];
        const float rstd = fast_rsq(wave_sum(ss) * (1.0f / 1024.0f) + NORM_EPS);
#pragma unroll
        for (int j = 0; j < 2; ++j)
#pragma unroll
            for (int hq = 0; hq < 2; ++hq) { const int col = 8 * lane + 512 * j + 4 * hq;
                const f32x4 gf = gfr[j][hq];
                const unsigned xa = hq ? cx[j].z : cx[j].x, xb2 = hq ? cx[j].w : cx[j].y;
                f32x4 x1 = (f32x4){bflo(xa), bfhi(xa), bflo(xb2), bfhi(xb2)};
                const f32x4 av = (f32x4){a[j][4 * hq], a[j][4 * hq + 1], a[j][4 * hq + 2], a[j][4 * hq + 3]};
                x1 = x1 + gf * (av * rstd);
                if (do_store) *(f32x4*)(out + tok * 1024 + col) = x1; }
    }
#undef CMB_SLOTS
#undef CMB_ROWS
}

#define XB_TMO      128
#define XB_XCNT(j)  (256  + 64 * (j))
#define XB_XSUB(j)  (1280 + 64 * (j))
#define XB_XGEN(j)  (2304 + 64 * (j))
#define XB_TOP      3328
#define XB_TOPGEN   3392
#define XCD_BAR_WORDS 3456
#define XB_SPIN_CAP (1u << 18)
__device__ __forceinline__ unsigned xb_ld(unsigned* p)              { return __hip_atomic_load(p, __ATOMIC_RELAXED, __HIP_MEMORY_SCOPE_AGENT); }
__device__ __forceinline__ unsigned xb_add(unsigned* p, unsigned v) { return __hip_atomic_fetch_add(p, v, __ATOMIC_RELAXED, __HIP_MEMORY_SCOPE_AGENT); }
__device__ __forceinline__ unsigned xb_xcc_id() { return (unsigned)__builtin_amdgcn_s_getreg((3 << 11) | 20) & 0xFu; }
#define XB_SPIN(cond, bar) do { unsigned _sp = 0; while (cond) { __builtin_amdgcn_s_sleep(1); \
    if ((++_sp & 255u) == 0u) { if (xb_ld(&(bar)[XB_TMO])) break; if (_sp > XB_SPIN_CAP) { atomicAdd(&(bar)[XB_TMO], 1u); break; } } } } while (0)
struct XcdBarrier { unsigned* bar; unsigned x; volatile LAS unsigned* st; };
__device__ __forceinline__ XcdBarrier xcd_barrier_post(unsigned* bar, volatile LAS unsigned* st) {
    XcdBarrier b; b.bar = bar; b.x = xb_xcc_id(); b.st = st;
    if (threadIdx.x == 0) (void)xb_add(&bar[XB_XCNT(b.x)], 1u);
    return b;
}
__device__ __forceinline__ void xcd_barrier_complete(unsigned* bar, unsigned x, unsigned& nloc, unsigned& nx) {
    const unsigned G = gridDim.x * gridDim.y * gridDim.z;
    unsigned sum, cnt, mine, sp = 0u;
    for (;;) {
        sum = 0u; cnt = 0u; mine = 0u;
#pragma unroll
        for (unsigned j = 0; j < 16; ++j) { const unsigned c = xb_ld(&bar[XB_XCNT(j)]); sum += c; cnt += (c > 0u) ? 1u : 0u; mine = (j == x) ? c : mine; }
        if (sum == G) break;
        __builtin_amdgcn_s_sleep(1);
        if ((++sp & 255u) == 0u) { if (xb_ld(&bar[XB_TMO])) break; if (sp > XB_SPIN_CAP) { atomicAdd(&bar[XB_TMO], 1u); break; } }
    }
    nloc = mine > 0u ? mine : 1u; nx = cnt > 0u ? cnt : 1u;
}
__device__ __forceinline__ void xcd_barrier(const XcdBarrier& b) {
    asm volatile("s_waitcnt vmcnt(0)" ::: "memory");
    __syncthreads();
    if (threadIdx.x == 0) {
        unsigned* bar = b.bar;
        __builtin_amdgcn_s_waitcnt(0);
        unsigned nloc = b.st[0], nx = b.st[1];
        if (nloc == 0u) { xcd_barrier_complete(bar, b.x, nloc, nx); b.st[0] = nloc; b.st[1] = nx; }
        const unsigned old = xb_add(&bar[XB_XSUB(b.x)], 1u);
        const unsigned gen = old / nloc;
        if (old + 1u == (gen + 1u) * nloc) {
            __builtin_amdgcn_fence(__ATOMIC_RELEASE, "agent");
            asm volatile("s_waitcnt vmcnt(0)" ::: "memory");
            const unsigned og = xb_add(&bar[XB_TOP], 1u);
            const unsigned tg = og / nx;
            if (og + 1u == (tg + 1u) * nx) xb_add(&bar[XB_TOPGEN], 1u);
            else XB_SPIN(xb_ld(&bar[XB_TOPGEN]) == tg, bar);
            __builtin_amdgcn_fence(__ATOMIC_ACQUIRE, "agent");
            xb_add(&bar[XB_XGEN(b.x)], 1u);
            asm volatile("s_waitcnt vmcnt(0)" ::: "memory");
        } else {
            XB_SPIN(xb_ld(&bar[XB_XGEN(b.x)]) == gen, bar);
            __builtin_amdgcn_fence(__ATOMIC_ACQUIRE, "agent");
            asm volatile("s_waitcnt vmcnt(0)" ::: "memory");
        }
    }
    __syncthreads();
}

__device__ __forceinline__ void moe_load_tab(unsigned char* ws, LAS int* tab, int vcu, int G, int lg) {
    const int* RTAB = (const int*)(ws + WS_RTAB);
    __syncthreads();
    if (threadIdx.x < 65) tab[threadIdx.x] = RTAB[threadIdx.x];
    if (threadIdx.x < 64) tab[128 + threadIdx.x] = RTAB[128 + threadIdx.x];
    LDS_WAIT(); __syncthreads();
    if (threadIdx.x < 32) { const int ri = ((int)threadIdx.x * G + vcu) >> lg; int e = 0;
#pragma unroll 8
        for (int j = 1; j <= 64; ++j) e += (tab[j] <= ri) ? 1 : 0;
        tab[192 + threadIdx.x] = e; }
    LDS_WAIT(); __syncthreads();
}
__device__ __forceinline__ void moe_gateup(unsigned char* ws, LAS unsigned char* lds, int vcu, int G) {
    LAS int* tok = (LAS int*)(lds + TOK_OFF); LAS int* tab = (LAS int*)(lds + TAB_OFF);
    moe_load_tab(ws, tab, vcu, G, 1);
    const int NT = tab[64], U = 2 * (NT + SH_TILES);
    MoeSched S; S.tab = tab; S.NT = NT; S.U = U; S.G = G; S.vcu = vcu; S.npn = 2; S.lg = 1; S.A = (const char*)(ws + R_H8); S.B = (const char*)(ws + WS_WGU);
    S.atile = 0; S.btile_e = (size_t)512 * 1024; S.btile_n = (size_t)256 * 1024;
    const int* SLOTTOK = (const int*)(ws + WS_SLOTTOK);
    { const int wv = threadIdx.x >> 6, ln = threadIdx.x & 63;
#pragma unroll
      for (int k = 0; k < 2; ++k) { const int i = wv + 8 * k; pg8::Unit u;
          if (S.next(i, u)) {
              int tk[4];
#pragma unroll
              for (int q = 0; q < 4; ++q) { const int row = ln + 64 * q;
                  if (u.aux) { const int valid = tab[128 + u.e] - (u.pm - tab[u.e]) * 256; tk[q] = (row < valid) ? SLOTTOK[u.pm * 256 + row] : 0; }
                  else tk[q] = (u.pm - RT_MAX) * 256 + row; }
#pragma unroll
              for (int q = 0; q < 4; ++q) tok[i * 256 + ln + 64 * q] = tk[q]; } } }
    LDS_WAIT(); __syncthreads();
    EpiGateUp E{(unsigned char*)(ws + R_ACT)};
    int Kg = 512; asm volatile("" : "+s"(Kg));
    pg8::gemm_phase<EpiGateUp, MoeSched, true>(lds, Kg, 512, 512, S, E, tok);
}
__device__ __forceinline__ void moe_down(unsigned char* ws, LAS unsigned char* lds, int vcu, int G, bool st = true) {
    LAS int* tab = (LAS int*)(lds + TAB_OFF);
    moe_load_tab(ws, tab, vcu, G, 2);
    const int NT = tab[64], U = 4 * (NT + SH_TILES);
    MoeSched S; S.tab = tab; S.NT = NT; S.U = U; S.G = G; S.vcu = vcu; S.npn = 4; S.lg = 2; S.A = (const char*)(ws + R_ACT); S.B = (const char*)(ws + WS_WDN);
    S.atile = (size_t)256 * 256; S.btile_e = (size_t)1024 * 256; S.btile_n = (size_t)256 * 256;
    EpiDown E{(unsigned char*)(ws + R_Y), st};
    int Kd = 128; asm volatile("" : "+s"(Kd));
    pg8::gemm_phase<EpiDown, MoeSched, false>(lds, Kd, 128, 128, S, E, nullptr);
}

enum { PH_PRO = 0, PH_NORM1, PH_INPROJ, PH_MIX, PH_BRANCH, PH_OUT, PH_TOK2, PH_PLACE, PH_GU, PH_DN, PH_CMB, NPHASE };
struct Args { const float* in[28]; float* out; unsigned char* ws; int ph_lo, ph_hi, li, pad; };

__global__ void __launch_bounds__(NWAVES * 64, 2) hybrid_fwd(Args args) {
    extern __shared__ __attribute__((aligned(16))) unsigned char lds_raw[];
    LAS unsigned char* lds = (LAS unsigned char*)lds_raw;
    volatile LAS unsigned* MISC = (volatile LAS unsigned*)(lds + MISC_OFF);
    const int tid = threadIdx.x; const int wave = __builtin_amdgcn_readfirstlane(tid >> 6);
    const int G = gridDim.x; const int bx = blockIdx.x; const int vcu = (G % 8 == 0) ? (bx % 8) * (G / 8) + bx / 8 : bx;
    unsigned char* ws = args.ws; float* out = args.out;
    In in;
    in.x = args.in[0]; in.c = args.in[1]; in.w_ada = args.in[2]; in.b_ada = args.in[3]; in.g_pre_mix = args.in[4]; in.g_post_mix = args.in[5]; in.g_pre_ffn = args.in[6]; in.g_post_ffn = args.in[7];
    in.w_in = args.in[8]; in.b_forget = args.in[9]; in.w_conv = args.in[10]; in.b_conv = args.in[11]; in.w_rg = args.in[12]; in.b_rg = args.in[13]; in.w_ig = args.in[14]; in.b_ig = args.in[15]; in.lam = args.in[16];
    in.w_ba = args.in[17]; in.w_br = args.in[18]; in.w_out = args.in[19]; in.w_router = args.in[20]; in.r_bias = args.in[21]; in.w_eg = args.in[22]; in.w_eu = args.in[23]; in.w_ed = args.in[24];
    in.w_sg = args.in[25]; in.w_su = args.in[26]; in.w_sd = args.in[27];
    for (int u = tid; u < 256; u += NWAVES * 64) ((LAS unsigned*)(lds + LDSCTL_OFF))[u] = 0u;
    __syncthreads();
    const int lo = args.ph_lo, hi = args.ph_hi;
    XcdBarrier bar; bar.bar = (unsigned*)(ws + WS_CTL) + CW_BAR; bar.x = 0; bar.st = nullptr;
    if (hi - lo > 1) bar = xcd_barrier_post((unsigned*)(ws + WS_CTL) + CW_BAR + args.li * XCD_BAR_WORDS, MISC + 8);
#ifndef PHASE_MASK
#define PHASE_MASK 0xFFFF
#endif
#define IN(k) (((PHASE_MASK >> (k)) & 1) && lo <= (k) && (k) < hi)
#define SEAM(k) do { if (IN(k) && IN((k) + 1)) xcd_barrier(bar); } while (0)

#ifndef DUP_MASK
#define DUP_MASK 0
#endif
#ifndef DRY_STORE
#define DRY_STORE 0
#endif
    const bool never = (args.pad == 12345);
#define REP(k, ...) do { if ((DUP_MASK >> (k)) & 1) { const bool st = never; __VA_ARGS__ } { const bool st = true; __VA_ARGS__ } } while (0)
    if (IN(PH_PRO)) { REP(PH_PRO, { (void)st; p0_prologue(in, ws, lds, vcu, G); __syncthreads(); }); }
    SEAM(PH_PRO);
    if (IN(PH_NORM1)) { REP(PH_NORM1, { (void)st; for (int tile = vcu; tile < 256; tile += G) p1_norm(tile, in, ws, lds); }); }
    SEAM(PH_NORM1);
    if (IN(PH_INPROJ)) { REP(PH_INPROJ, {
        DenseSchedT<256, 22> S; S.init(T, NIN, G, bx, ws + R_H, 512, ws + WS_WIN, 512);
        EpiInProj E{(bf16_t*)(ws + R_QKV), (bf16_t*)(ws + R_GT), st || DRY_STORE};
#ifdef STAGGER_TICKS
        { const unsigned long long t0 = __builtin_amdgcn_s_memrealtime(); const unsigned long long dl = (unsigned long long)(bx & 15) * STAGGER_TICKS;
          while (__builtin_amdgcn_s_memrealtime() - t0 < dl) __builtin_amdgcn_s_sleep(8); }
#endif
        __syncthreads();
#ifndef DRY_K
#define DRY_K 1024
#endif
        int Kp = st ? 512 : DRY_K; asm volatile("" : "+s"(Kp));
        pg8::gemm_phase<EpiInProj, DenseSchedT<256, 22>, false>(lds, Kp, 512, 512, S, E, nullptr); });
    }
    SEAM(PH_INPROJ);
    if (IN(PH_MIX)) {
        REP(13, { for (int u = vcu; u < NBATCH * NHEAD; u += G) { __syncthreads(); att::attn_bh(u >> 3, u & 7, (bf16_t*)(ws + R_QKV), (const float*)(ws + WS_LCUM), (const float*)(ws + WS_TOT), lds, st); } });
        REP(14, { for (int u = vcu; u < NBATCH * 16; u += G) rnn::rnn_unit(u >> 4, u & 15, (bf16_t*)(ws + R_QKV) + 1536, (const bf16_t*)(ws + WS_WRNN), in.w_conv, in.b_conv, in.b_rg, in.b_ig, in.lam, lds, st); });
    }
    SEAM(PH_MIX);
    if (IN(PH_BRANCH)) { REP(PH_BRANCH, { (void)st;
        bf16_t* qx = (bf16_t*)(ws + R_QKV);
        BranchSched S; S.d.init(T, 1024, G, bx, qx, QXP, ws + WS_WBA, 1536);
        EpiBranchF E{(const bf16_t*)(ws + R_GT), (const bf16_t*)(ws + R_GT) + 1024, 2048, qx + 512, QXP};
        __syncthreads();
        pg8::gemm_phase<EpiBranchF, BranchSched, false>(lds, 512, QXP, 1536, S, E, nullptr); });
    }
    SEAM(PH_BRANCH);
    if (IN(PH_OUT)) { REP(PH_OUT, { (void)st;
        DenseSchedT<256, 4> S; S.init(T, 1024, G, bx, (bf16_t*)(ws + R_QKV) + 512, QXP, ws + WS_WOUT, 1024);
        EpiOut E{(bf16_t*)(ws + R_H), (float*)(ws + WS_SSQ)};
        __syncthreads();
        pg8::gemm_phase<EpiOut, DenseSchedT<256, 4>, false>(lds, 1024, QXP, 1024, S, E, nullptr); });
    }
    SEAM(PH_OUT);
    if (IN(PH_TOK2)) { REP(PH_TOK2, { for (int tile = vcu; tile < 256; tile += G) p6::run(tile, in, out, ws, lds, st); }); }
    SEAM(PH_TOK2);
    if (IN(PH_PLACE)) { REP(PH_PLACE, { (void)st; for (int tile = vcu; tile < 256; tile += G) p7_place(tile, ws, lds); }); }
    SEAM(PH_PLACE);
    if (IN(PH_GU)) { REP(PH_GU, { (void)st; moe_gateup(ws, lds, vcu, G); }); }
    SEAM(PH_GU);
    if (IN(PH_DN)) { REP(PH_DN, { moe_down(ws, lds, vcu, G, st || DRY_STORE); }); }
    SEAM(PH_DN);
    if (IN(PH_CMB)) { REP(PH_CMB, { combine_all(in, out, ws, vcu * NWAVES + wave, G * NWAVES, st); }); }
#ifdef GEMM_STAMP
    xcd_barrier(bar);
    if (blockIdx.x == GEMM_STAMP_BLOCK) {
        const float n = (float)g_dbg[4]; const float cyc2us = 1.0f / 2100.0f;
        const float vals[6] = {(float)g_dbg[0] / n * cyc2us, (float)g_dbg[1] / n * cyc2us, (float)g_dbg[2] / n * cyc2us, (float)g_dbg[3] / n * cyc2us, n, (float)g_dbg[5] * cyc2us};
        const float A = floorf(vals[STAMP_A] + 0.5f) * 100.0f, B = floorf(vals[STAMP_B] + 0.5f);
        if (tid == 0) out[0] += A;
        for (int i = 1 + tid; i <= (1 << 20); i += 512) out[i] += B;
    }
#endif
#undef IN
#undef SEAM
}

extern "C" void kernel_launch(void* const* d_in, const int* in_sizes, int n_in, void* d_out, int out_size, void* d_ws, size_t ws_size, hipStream_t stream) {
    static int grid = 0;
    if (grid == 0) {
        if (n_in != 28 || in_sizes[0] != T * D || out_size != T * D || ws_size < WS_END) { fprintf(stderr, "kernel_launch: unexpected shapes / workspace (n_in %d, ws %zu)\n", n_in, ws_size); grid = -1; return; }
        int dev = 0, cus = 0, per_cu = 0;
        if (hipGetDevice(&dev) != hipSuccess || hipDeviceGetAttribute(&cus, hipDeviceAttributeMultiprocessorCount, dev) != hipSuccess) { grid = -1; return; }
        if (hipFuncSetAttribute((const void*)hybrid_fwd, hipFuncAttributeMaxDynamicSharedMemorySize, LDS_BYTES) != hipSuccess) { fprintf(stderr, "kernel_launch: hipFuncSetAttribute failed\n"); grid = -1; return; }
        if (hipOccupancyMaxActiveBlocksPerMultiprocessor(&per_cu, (const void*)hybrid_fwd, NWAVES * 64, LDS_BYTES) != hipSuccess || per_cu < 1) { fprintf(stderr, "kernel_launch: occupancy query says %d\n", per_cu); per_cu = 1; }
        (void)hipGetLastError();
        grid = cus;
    }
    if (grid < 0) return;
    (void)hipMemsetAsync((char*)d_ws + WS_CTL, 0, CTL_ZERO_BYTES, stream);
    Args a{};
    for (int i = 0; i < 28; ++i) a.in[i] = (const float*)d_in[i];
    a.out = (float*)d_out; a.ws = (unsigned char*)d_ws;
#if MK_N_LAUNCHES == 1
    a.ph_lo = 0; a.ph_hi = NPHASE; a.li = 0;
    void* kargs[] = {&a};
    hipError_t e = hipLaunchCooperativeKernel((const void*)hybrid_fwd, dim3(grid), dim3(NWAVES * 64), kargs, LDS_BYTES, stream);
    if (e != hipSuccess) fprintf(stderr, "kernel_launch: cooperative launch failed: %s (grid %d)\n", hipGetErrorString(e), grid);
#else
    for (int li = 0; li < NPHASE; ++li) { a.ph_lo = li; a.ph_hi = li + 1; a.li = li;
        hipLaunchKernelGGL(hybrid_fwd, dim3(grid), dim3(NWAVES * 64), LDS_BYTES, stream, a); }
#endif
}
```

```cpp
#include <hip/hip_runtime.h>
#include <cstdio>
#include <cstdint>

#ifndef MK_N_LAUNCHES
#define MK_N_LAUNCHES 1
#endif
#ifndef ATT_NS
#define ATT_NS att2
#endif

#define LAS __attribute__((address_space(3)))
#define GAS __attribute__((address_space(1)))
typedef unsigned short bf16_t;
typedef short bf16x8 __attribute__((ext_vector_type(8)));
typedef short s16x4 __attribute__((ext_vector_type(4)));
typedef float f32x4 __attribute__((ext_vector_type(4)));
typedef float f32x2 __attribute__((ext_vector_type(2)));
typedef float f32x16 __attribute__((ext_vector_type(16)));
typedef unsigned u32x4 __attribute__((ext_vector_type(4)));
typedef unsigned u32x2 __attribute__((ext_vector_type(2)));
typedef GAS unsigned gu32;

constexpr int T = 65536, D = 1024, NBATCH = 32, SEQ = 2048, NHEAD = 8, HD = 64;
constexpr int NIN = 5632;
constexpr int INCOLS = 5640;
constexpr int NEXP = 64, TOPK = 6, EFF = 256;
constexpr int RT_MAX = 1600;
constexpr int SH_TILES = 256;
constexpr int RND_TILES = RT_MAX + SH_TILES;
constexpr float NORM_EPS = 1e-6f;
constexpr float LOG2E = 1.4426950408889634f;
constexpr float QSCALE = 0.125f * LOG2E;

constexpr size_t MiB = 1u << 20, KiB = 1u << 10;
constexpr size_t WS_CTL = 0, CTL_ZERO_BYTES = 1 * MiB;
constexpr size_t WS_MOD = 1 * MiB;
constexpr size_t WS_TOT = 1 * MiB + 768 * KiB;
constexpr size_t WS_HIST = 2 * MiB;
constexpr size_t WS_RTAB = 2 * MiB + 64 * KiB;
constexpr size_t WS_LCUM = 3 * MiB;
constexpr size_t WS_SSQ = 5 * MiB;
constexpr size_t WS_EP = 9 * MiB;
constexpr size_t WS_EW = 11 * MiB;
constexpr size_t WS_POS = 13 * MiB;
constexpr size_t WS_SLOTTOK = 15 * MiB;
constexpr size_t WS_WF = 17 * MiB;
constexpr size_t WS_WRNN = 17 * MiB + 64 * KiB;
constexpr size_t WS_WROUT = 17 * MiB + 512 * KiB;
constexpr size_t WS_WIN = 18 * MiB;
constexpr size_t WS_WBA = 29 * MiB;
constexpr size_t WS_WOUT = 32 * MiB;
constexpr size_t WS_WGU = 34 * MiB;
constexpr size_t WS_WDN = 68 * MiB;
constexpr size_t R_H = 144 * MiB;
constexpr size_t R_QKV = 272 * MiB;
constexpr int QXP = 3584;
constexpr size_t R_GT = 720 * MiB;
constexpr size_t R_ACT = 272 * MiB;
constexpr size_t R_Y = 392 * MiB;
constexpr size_t R_H8 = 856 * MiB;
constexpr size_t WS_END = 976 * MiB;
static_assert(WS_WDN + (size_t)65 * 1024 * 256 <= R_H && WS_WGU + (size_t)65 * 512 * 1024 <= WS_WDN, "weights fit");
static_assert(R_Y + (size_t)RND_TILES * 256 * 1024 <= WS_END, "y fits");
static_assert(R_ACT + (size_t)RND_TILES * 256 * 256 <= R_Y && R_Y + (size_t)RND_TILES * 256 * 1024 <= R_H8 && R_H8 + (size_t)T * 1024 <= WS_END, "act / y / h8 fit");

constexpr int CW_TMO = 0, CW_CODE = 1;
constexpr int CW_BAR = 4096;

constexpr int RING_BYTES = 131072;
constexpr int LDSCTL_OFF = RING_BYTES;
constexpr int MISC_OFF = LDSCTL_OFF + 320;
constexpr int TOK_OFF = RING_BYTES + 1024;
constexpr int EST_OFF = TOK_OFF;
constexpr int TAB_OFF = TOK_OFF + 16384;
constexpr int LDS_BYTES = TAB_OFF + 1024;
constexpr int NWAVES = 8;

#define RLX_AGENT __ATOMIC_RELAXED, __HIP_MEMORY_SCOPE_AGENT
#define LDS_WAIT() asm volatile("s_waitcnt lgkmcnt(0)" ::: "memory")
#define VM_WAIT() asm volatile("s_waitcnt vmcnt(0)" ::: "memory")

__device__ __forceinline__ unsigned f2bf(float f) { unsigned u = __builtin_bit_cast(unsigned, f); return (u + 0x7fffu + ((u >> 16) & 1u)) >> 16; }
__device__ __forceinline__ unsigned pk2(float lo, float hi) { return f2bf(lo) | (f2bf(hi) << 16); }
__device__ __forceinline__ float bf2f(unsigned short b) { return __builtin_bit_cast(float, (unsigned)b << 16); }
__device__ __forceinline__ float bflo(unsigned w) { return __builtin_bit_cast(float, w << 16); }
__device__ __forceinline__ float bfhi(unsigned w) { return __builtin_bit_cast(float, w & 0xffff0000u); }
__device__ __forceinline__ float fast_exp2(float x) { return __builtin_amdgcn_exp2f(x); }
__device__ __forceinline__ float fast_rcp(float x) { return __builtin_amdgcn_rcpf(x); }
__device__ __forceinline__ float fast_rsq(float x) { return __builtin_amdgcn_rsqf(x); }
__device__ __forceinline__ float fast_log2(float x) { return __builtin_amdgcn_logf(x); }
__device__ __forceinline__ unsigned cvt_pk(float lo, float hi) { unsigned r; asm volatile("v_cvt_pk_bf16_f32 %0, %1, %2" : "=v"(r) : "v"(lo), "v"(hi)); return r; }
__device__ __forceinline__ float sigmoidf_(float x) { return fast_rcp(1.0f + fast_exp2(-x * LOG2E)); }
template <int CTRL, int RMASK> __device__ __forceinline__ float dpp_f(float v) { return __builtin_bit_cast(float, __builtin_amdgcn_update_dpp(0, __builtin_bit_cast(int, v), CTRL, RMASK, 0xF, false)); }
__device__ __forceinline__ float wave_sum(float v) {
    v += dpp_f<0xB1, 0xF>(v);
    v += dpp_f<0x4E, 0xF>(v);
    v += dpp_f<0x141, 0xF>(v);
    v += dpp_f<0x140, 0xF>(v);
    v += dpp_f<0x142, 0xA>(v);
    v += dpp_f<0x143, 0xC>(v);
    return __builtin_bit_cast(float, __builtin_amdgcn_readlane(__builtin_bit_cast(int, v), 63));
}
__device__ __forceinline__ void swap32(float& a, float& b) { asm("s_nop 1\n\tv_permlane32_swap_b32 %0, %1" : "+v"(a), "+v"(b)); }
__device__ __forceinline__ void swap16(float& a, float& b) { asm("s_nop 1\n\tv_permlane16_swap_b32 %0, %1" : "+v"(a), "+v"(b)); }
__device__ __forceinline__ float xor32_sum(float v) { float a = v, b = v; swap32(a, b); return a + b; }
__device__ __forceinline__ float xor32_max(float v) { float a = v, b = v; swap32(a, b); return fmaxf(a, b); }
__device__ __forceinline__ float xor16_sum(float v) { float a = v, b = v; swap16(a, b); return a + b; }
__device__ __forceinline__ float wave_max(float v) {
    v = fmaxf(v, dpp_f<0xB1, 0xF>(v)); v = fmaxf(v, dpp_f<0x4E, 0xF>(v)); v = fmaxf(v, dpp_f<0x141, 0xF>(v)); v = fmaxf(v, dpp_f<0x140, 0xF>(v));
    v = fmaxf(v, __builtin_bit_cast(float, __builtin_amdgcn_update_dpp(__builtin_bit_cast(int, v), __builtin_bit_cast(int, v), 0x142, 0xA, 0xF, false)));
    v = fmaxf(v, __builtin_bit_cast(float, __builtin_amdgcn_update_dpp(__builtin_bit_cast(int, v), __builtin_bit_cast(int, v), 0x143, 0xC, 0xF, false)));
    return __builtin_bit_cast(float, __builtin_amdgcn_readlane(__builtin_bit_cast(int, v), 63));
}
__device__ __forceinline__ float max8(float v) { v = fmaxf(v, dpp_f<0xB1, 0xF>(v)); v = fmaxf(v, dpp_f<0x4E, 0xF>(v)); v = fmaxf(v, dpp_f<0x141, 0xF>(v)); return v; }
__device__ __forceinline__ float sum8(float v) { v += dpp_f<0xB1, 0xF>(v); v += dpp_f<0x4E, 0xF>(v); v += dpp_f<0x141, 0xF>(v); return v; }

#ifndef STAMP_INPROJ
#define STAMP_INPROJ -1
#endif
#ifndef STAMP_DOWN
#define STAMP_DOWN -1
#endif
#ifndef GEMM_STAMP_BLOCK
#define GEMM_STAMP_BLOCK 0
#endif
#ifndef GEMM_STAMP_THREAD
#define GEMM_STAMP_THREAD 0
#endif
#ifdef GEMM_STAMP
__device__ unsigned long long g_dbg[16];
#endif
namespace pg8 {
constexpr int BM = 256, BK = 64, HALF = 128, HTB = HALF * BK * 2, STAGE_BYTES = 8 * HTB;
__host__ __device__ __forceinline__ int lds_byte(int r, int c) { const int st = (r >> 4) * 2 + (c >> 5), rr = r & 15, cc = c & 31, ob = rr * 64 + cc * 2; return st * 1024 + (ob ^ (((ob >> 9) & 1) << 5)); }
__host__ __device__ __forceinline__ void stage_rc(int b, int& R, int& C) { const int st = b / 1024, sb = b % 1024, swz = sb ^ (((sb >> 9) & 1) << 5); R = (st >> 1) * 16 + swz / 64; C = (st & 1) * 32 + (swz % 64) / 2; }
__host__ __device__ __forceinline__ int perm32(int rho) { const int n = rho >> 4, i = rho & 15; return 8 * (i >> 2) + 4 * n + (i & 3); }

struct Unit { int pm, pn, e, aux; };
typedef long l2v __attribute__((ext_vector_type(2)));
typedef int v8i __attribute__((ext_vector_type(8)));

__device__ __forceinline__ unsigned cvt_pk_bf16(float lo, float hi) { unsigned r; asm volatile("v_cvt_pk_bf16_f32 %0, %1, %2" : "=v"(r) : "v"(lo), "v"(hi)); return r; }
#ifndef EPI_SC1
#define EPI_SC1 0
#endif
__device__ __forceinline__ void st16(void* p, u32x4 v) {
#if EPI_SC1
    asm volatile("global_store_dwordx4 %0, %1, off sc1\n\ts_nop 1" :: "v"(p), "v"(v) : "memory");
#else
    *(u32x4*)p = v;
#endif
}

template <class Epi, class Sched, bool GATHER>
__device__ __forceinline__ void gemm_phase(LAS unsigned char* lds, const int K, const int lda, const int ldb, const Sched& S, const Epi& E, const LAS int* tokLDS) {
    const int tid = threadIdx.x, wid = __builtin_amdgcn_readfirstlane(tid >> 6), lane = tid & 63, wr = wid >> 2, wc = wid & 3, fr = lane & 15, fq = lane >> 4;
    int nt = K / BK;
    int Rr[2], Cc[2];
    unsigned voffB0[2], voffB1[2];
#pragma unroll
    for (int i = 0; i < 2; ++i) { int R, C; stage_rc(tid * 16 + i * 8192, R, C); Rr[i] = R; Cc[i] = C;
        if constexpr (Epi::WIDE) { const int n0 = 64 * (R >> 5) + perm32(R & 31); voffB0[i] = (unsigned)(n0 * ldb + C) * 2u; voffB1[i] = (unsigned)((n0 + 32) * ldb + C) * 2u; }
        else { const int Rb = (R & ~31) + perm32(R & 31); voffB0[i] = (unsigned)(Rb * ldb + C) * 2u; voffB1[i] = (unsigned)((Rb + HALF) * ldb + C) * 2u; } }
    const size_t kstep = (size_t)(BK * 2);
    const unsigned ldsw = (unsigned)wid * 1024u;
    const int aoff = lds_byte(wr * 64 + fr, fq * 8), boff = lds_byte(wc * 32 + fr, fq * 8);
#define PG8_SA(b, h) (((b) * 2 + (h)) * HTB)
#define PG8_SB(b, h) ((4 + (b) * 2 + (h)) * HTB)
#define PG8_STAGE2(bufoff, gbase, v0, v1) do { \
        __builtin_amdgcn_global_load_lds((const unsigned*)((const char*)(gbase) + (v0)), (LAS unsigned*)(lds + (bufoff) + ldsw), 16, 0, 0); \
        __builtin_amdgcn_global_load_lds((const unsigned*)((const char*)(gbase) + (v1)), (LAS unsigned*)(lds + (bufoff) + ldsw + 8192), 16, 0, 0); } while (0)
#define PG8_STAGEB0(bufoff, gbase) PG8_STAGE2(bufoff, gbase, voffB0[0], voffB0[1])
#define PG8_STAGEB1(bufoff, gbase) PG8_STAGE2(bufoff, gbase, voffB1[0], voffB1[1])
#define MX_LD(var, LO, HI, ALL, addr, off) asm volatile("ds_read_b128 " LO ", %1 offset:%2\n\tds_read_b128 " HI ", %1 offset:%3" : "={" ALL "}"(var) : "v"(addr), "i"(off), "i"((off) + 1024) : "memory")
#define MX_LDA(b, h) do { MX_LD(At_8[0], "v[192:195]", "v[196:199]", "v[192:199]", aaddr, PG8_SA(b, h)); MX_LD(At_8[1], "v[200:203]", "v[204:207]", "v[200:207]", aaddr, PG8_SA(b, h) + 2048); \
        MX_LD(At_8[2], "v[208:211]", "v[212:215]", "v[208:215]", aaddr, PG8_SA(b, h) + 4096); MX_LD(At_8[3], "v[216:219]", "v[220:223]", "v[216:223]", aaddr, PG8_SA(b, h) + 6144); } while (0)
#define MX_LDB_B0(b, h) do { MX_LD(B0_8[0], "v[224:227]", "v[228:231]", "v[224:231]", baddr, PG8_SA(b, h)); MX_LD(B0_8[1], "v[232:235]", "v[236:239]", "v[232:239]", baddr, PG8_SA(b, h) + 2048); } while (0)
#define MX_LDB_B1(b, h) do { MX_LD(B1_8[0], "v[240:243]", "v[244:247]", "v[240:247]", baddr, PG8_SA(b, h)); MX_LD(B1_8[1], "v[248:251]", "v[252:255]", "v[248:255]", baddr, PG8_SA(b, h) + 2048); } while (0)
#define PG8_LDA(dst, b, h) do { if constexpr (Epi::FP8) { MX_LDA(b, h); } else { _Pragma("unroll") for (int m = 0; m < 4; ++m) _Pragma("unroll") for (int k = 0; k < 2; ++k) dst[m][k] = *(const LAS bf16x8*)(lds + PG8_SA(b, h) + aoff + m * 2048 + k * 1024); } } while (0)
#define PG8_LDB(dst, b, h) do { if constexpr (Epi::FP8) { MX_LDB_##dst(b, h); } else { _Pragma("unroll") for (int n = 0; n < 2; ++n) _Pragma("unroll") for (int k = 0; k < 2; ++k) dst[n][k] = *(const LAS bf16x8*)(lds + PG8_SB(b, h) + boff + n * 2048 + k * 1024); } } while (0)
#define PG8_MMA(ai, bj, At, Bt) do { __builtin_amdgcn_s_setprio(1); _Pragma("unroll") for (int m = 0; m < 4; ++m) _Pragma("unroll") for (int n = 0; n < 2; ++n) _Pragma("unroll") for (int k = 0; k < 2; ++k) { \
        if constexpr (Epi::FP8) { if (k == 0) acc[ai][bj][m][n] = __builtin_amdgcn_mfma_scale_f32_16x16x128_f8f6f4(Bt##_8[n], At##_8[m], acc[ai][bj][m][n], 0, 0, 0, Epi::SCALE_W, 0, Epi::SCALE_A); } \
        else acc[ai][bj][m][n] = __builtin_amdgcn_mfma_f32_16x16x32_bf16(Bt[n][k], At[m][k], acc[ai][bj][m][n], 0, 0, 0); } __builtin_amdgcn_s_setprio(0); } while (0)
#define PG8_WAIT_V(n) asm volatile("s_waitcnt vmcnt(" #n ")" ::: "memory")
#define PG8_WAIT_L(n) asm volatile("s_waitcnt lgkmcnt(" #n ")" ::: "memory")
#define PG8_BAR __builtin_amdgcn_s_barrier()
#define PG8_SCHED __builtin_amdgcn_sched_barrier(0)
    Unit cur, nxt; int ui = 0;
    if (!S.next(0, cur)) return;
    if constexpr (Sched::PARTS) nt = S.nt(cur);
    unsigned ts1 = 0, tsa = 0, ts2 = 0, d12 = 0, d2a = 0, dab = 0; bool stamped = false;
    unsigned vA0[2], vA1[2], nA0[2], nA1[2];
#pragma unroll
    for (int i = 0; i < 2; ++i) {
        if constexpr (GATHER) { vA0[i] = (unsigned)(tokLDS[Rr[i]] * lda + Cc[i]) * 2u; vA1[i] = (unsigned)(tokLDS[HALF + Rr[i]] * lda + Cc[i]) * 2u; }
        else { vA0[i] = (unsigned)(Rr[i] * lda + Cc[i]) * 2u; vA1[i] = (unsigned)((HALF + Rr[i]) * lda + Cc[i]) * 2u; }
        nA0[i] = vA0[i]; nA1[i] = vA1[i];
    }
    f32x4 acc[2][2][4][2];
#pragma unroll
    for (int a = 0; a < 2; ++a)
#pragma unroll
        for (int b = 0; b < 2; ++b)
#pragma unroll
            for (int m = 0; m < 4; ++m)
#pragma unroll
                for (int n = 0; n < 2; ++n) acc[a][b][m][n] = (f32x4){0.f, 0.f, 0.f, 0.f};
    bf16x8 At[4][2], B0[2][2], B1[2][2];
    v8i At_8[4], B0_8[2], B1_8[2];
    const unsigned aaddr = (unsigned)(uintptr_t)lds + (unsigned)aoff, baddr = (unsigned)(uintptr_t)lds + 4u * HTB + (unsigned)boff;
    const char* cA = S.aptr(cur); const char* cB = S.bptr(cur);
    PG8_STAGEB0(PG8_SB(0, 0), cB); PG8_STAGEB1(PG8_SB(0, 1), cB); PG8_STAGE2(PG8_SA(0, 0), cA, vA0[0], vA0[1]); PG8_STAGE2(PG8_SA(0, 1), cA, vA1[0], vA1[1]);
    if (wr == 1) PG8_BAR;
    PG8_WAIT_V(2); PG8_BAR;
    PG8_STAGEB0(PG8_SB(1, 0), cB + kstep); PG8_STAGE2(PG8_SA(1, 0), cA + kstep, vA0[0], vA0[1]); PG8_STAGEB1(PG8_SB(1, 1), cB + kstep);
    PG8_WAIT_V(6); PG8_BAR;
    for (;;) {
        const bool has_next = S.next(ui + 1, nxt);
        const char* nAp = has_next ? S.aptr(nxt) : cA; const char* nBp = has_next ? S.bptr(nxt) : cB;
        if constexpr (GATHER) {
            if (has_next) {
#pragma unroll
                for (int i = 0; i < 2; ++i) { nA0[i] = (unsigned)(tokLDS[(ui + 1) * 256 + Rr[i]] * lda + Cc[i]) * 2u; nA1[i] = (unsigned)(tokLDS[(ui + 1) * 256 + HALF + Rr[i]] * lda + Cc[i]) * 2u; }
            } else {
#pragma unroll
                for (int i = 0; i < 2; ++i) { nA0[i] = vA0[i]; nA1[i] = vA1[i]; }
            }
        }
        for (int t = 0; t < nt; t += 2) {
            const bool last = (t == nt - 2);
            const char* a1 = cA + (size_t)(t + 1) * kstep;
            const char* a2 = last ? nAp : cA + (size_t)(t + 2) * kstep; const char* b2 = last ? nBp : cB + (size_t)(t + 2) * kstep;
            const char* a3 = a2 + kstep; const char* b3 = b2 + kstep;
            unsigned w0[2], w1[2];
#pragma unroll
            for (int i = 0; i < 2; ++i) { w0[i] = (GATHER && last) ? nA0[i] : vA0[i]; w1[i] = (GATHER && last) ? nA1[i] : vA1[i]; }
            PG8_LDB(B0, 0, 0); PG8_LDB(B1, 0, 1); PG8_SCHED; PG8_LDA(At, 0, 0); PG8_STAGE2(PG8_SA(1, 1), a1, vA1[0], vA1[1]);
            if constexpr (Epi::STAMP) { if (stamped) tsa = (unsigned)__builtin_amdgcn_s_memtime(); }
            PG8_WAIT_V(8); PG8_WAIT_L(0); PG8_BAR;
            if constexpr (Epi::STAMP) { if (stamped) { const unsigned tsb = (unsigned)__builtin_amdgcn_s_memtime(); d2a += tsa - ts2; dab += tsb - tsa; stamped = false; } }
            PG8_MMA(0, 0, At, B0); PG8_MMA(0, 1, At, B1); PG8_BAR; PG8_SCHED;
            PG8_LDA(At, 0, 1); PG8_STAGEB0(PG8_SB(0, 0), b2); PG8_STAGEB1(PG8_SB(0, 1), b2); PG8_STAGE2(PG8_SA(0, 0), a2, w0[0], w0[1]);
            PG8_WAIT_V(8); PG8_WAIT_L(0); PG8_BAR; PG8_MMA(1, 0, At, B0); PG8_MMA(1, 1, At, B1); PG8_BAR; PG8_SCHED;
            PG8_LDB(B0, 1, 0); PG8_LDB(B1, 1, 1); PG8_SCHED; PG8_LDA(At, 1, 0); PG8_STAGE2(PG8_SA(0, 1), a2, w1[0], w1[1]);
            PG8_WAIT_V(8); PG8_WAIT_L(0); PG8_BAR; PG8_MMA(0, 0, At, B0); PG8_MMA(0, 1, At, B1); PG8_BAR; PG8_SCHED;
            PG8_LDA(At, 1, 1); PG8_STAGEB0(PG8_SB(1, 0), b3); PG8_STAGEB1(PG8_SB(1, 1), b3); PG8_STAGE2(PG8_SA(1, 0), a3, w0[0], w0[1]);
            PG8_WAIT_V(8); PG8_WAIT_L(0); PG8_BAR; PG8_MMA(1, 0, At, B0); PG8_MMA(1, 1, At, B1); PG8_BAR; PG8_SCHED;
        }
        if (wr == 0) PG8_BAR;
        if constexpr (Epi::STAMP) ts1 = (unsigned)__builtin_amdgcn_s_memtime();
        if constexpr (Sched::PARTS) { if (cur.aux == 0) E.mid(acc, cur, wr, wc, fr, fq, lds, wid, lane); else E(acc, cur, wr, wc, fr, fq, lds, wid, lane); }
        else E(acc, cur, wr, wc, fr, fq, lds, wid, lane);
        if constexpr (Epi::STAMP) { ts2 = (unsigned)__builtin_amdgcn_s_memtime(); d12 += ts2 - ts1; stamped = true; }
        if (!has_next) break;
        if (!Sched::PARTS || nxt.aux == 0) {
#pragma unroll
        for (int a = 0; a < 2; ++a)
#pragma unroll
            for (int b = 0; b < 2; ++b)
#pragma unroll
                for (int m = 0; m < 4; ++m)
#pragma unroll
                    for (int n = 0; n < 2; ++n) acc[a][b][m][n] = (f32x4){0.f, 0.f, 0.f, 0.f};
        }
        cur = nxt; cA = nAp; cB = nBp; ++ui;
        if constexpr (Sched::PARTS) nt = S.nt(cur);
        if constexpr (GATHER) {
#pragma unroll
            for (int i = 0; i < 2; ++i) { vA0[i] = nA0[i]; vA1[i] = nA1[i]; }
        }
        if (wr == 1) PG8_BAR;
    }
    PG8_WAIT_V(0);
    PG8_BAR;
#ifdef GEMM_STAMP
    if constexpr (Epi::STAMP) if (blockIdx.x == GEMM_STAMP_BLOCK && threadIdx.x == GEMM_STAMP_THREAD) { g_dbg[0] = 0; g_dbg[1] = d12; g_dbg[2] = d2a; g_dbg[3] = dab; g_dbg[4] = ui + 1; g_dbg[5] = 0; }
#endif
#undef PG8_SA
#undef PG8_SB
#undef PG8_STAGE2
#undef PG8_STAGEB0
#undef PG8_STAGEB1
#undef PG8_LDA
#undef MX_LD
#undef MX_LDA
#undef MX_LDB_B0
#undef MX_LDB_B1
#undef PG8_LDB
#undef PG8_MMA
#undef PG8_WAIT_V
#undef PG8_WAIT_L
#undef PG8_BAR
#undef PG8_SCHED
}
}

template <int NM, int NN> struct DenseSchedT {
    static constexpr bool PARTS = false;
    static_assert(NM % 8 == 0 && (NM * NN) % 8 == 0, "8-row groups, equal XCD chunks");
    int G, c; const char* A; const char* B; size_t atile, btile;
    __device__ __forceinline__ void init(int M, int N, int G_, int c_, const void* A_, int lda, const void* B_, int ldb) {
        (void)M; (void)N; G = G_; c = c_; A = (const char*)A_; B = (const char*)B_; atile = (size_t)256 * lda * 2; btile = (size_t)256 * ldb * 2; }
    __device__ __forceinline__ bool next(int i, pg8::Unit& u) const {
        constexpr int nwg = NM * NN, q = nwg / 8, nig = 8 * NN;
        const long L = (long)i * G + c; if (L >= nwg) return false;
        int wgid = (int)L; { const int xcd = wgid % 8, off = wgid / 8; wgid = xcd * q + off; }
        const int gid = wgid / nig, fm = gid * 8, w = wgid % nig;
        u.pm = fm + (w % 8); u.pn = w / 8; u.e = 0; u.aux = 0; return true;
    }
    __device__ __forceinline__ const char* aptr(const pg8::Unit& u) const { return A + (size_t)u.pm * atile; }
    __device__ __forceinline__ const char* bptr(const pg8::Unit& u) const { return B + (size_t)u.pn * btile; }
};

struct BranchSched {
    static constexpr bool PARTS = true;
    DenseSchedT<256, 4> d;
    __device__ __forceinline__ bool next(int i, pg8::Unit& u) const { if (!d.next(i >> 1, u)) return false; u.aux = i & 1; return true; }
    __device__ __forceinline__ int nt(const pg8::Unit& u) const { return u.aux ? 16 : 8; }
    __device__ __forceinline__ const char* aptr(const pg8::Unit& u) const { return d.A + (size_t)u.pm * d.atile + (u.aux ? 2560 * 2 : 0); }
    __device__ __forceinline__ const char* bptr(const pg8::Unit& u) const { return d.B + (size_t)u.pn * d.btile + (u.aux ? 512 * 2 : 0); }
};

struct MoeSched {
    static constexpr bool PARTS = false;
    const LAS int* tab;
    int NT, U, G, vcu, npn, lg; const char* A; const char* B; size_t atile, btile_e, btile_n;
    __device__ __forceinline__ bool next(int i, pg8::Unit& u) const {
        const int id = i * G + vcu; if (id >= U) return false;
        const int ri = id >> lg; u.pn = id & (npn - 1);
        if (ri < NT) { u.e = tab[192 + i]; u.pm = ri; u.aux = 1; }
        else { u.e = 64; u.pm = RT_MAX + (ri - NT); u.aux = 0; }
        return true;
    }
    __device__ __forceinline__ const char* aptr(const pg8::Unit& u) const { return A + (size_t)u.pm * atile; }
    __device__ __forceinline__ const char* bptr(const pg8::Unit& u) const { return B + (size_t)u.e * btile_e + (size_t)u.pn * btile_n; }
};


__device__ __forceinline__ void wide_store16(LAS unsigned char* stg, int fr, int fq, int lane, u32x4 w0, u32x4 w1, bf16_t* rowbase, size_t ld, bool st) {
    *(LAS u32x4*)(stg + fr * 128 + ((fq ^ (fr & 7)) * 16)) = w0;
    *(LAS u32x4*)(stg + fr * 128 + (((4 + fq) ^ (fr & 7)) * 16)) = w1;
#pragma unroll
    for (int s2 = 0; s2 < 2; ++s2) { const int rr = (lane >> 3) + 8 * s2, p = lane & 7;
        const u32x4 v = *(const LAS u32x4*)(stg + rr * 128 + ((p ^ (rr & 7)) * 16));
        if (st) *(u32x4*)(rowbase + (size_t)rr * ld + p * 8) = v; }
}
#define EPI_ARGS const f32x4 (&acc)[2][2][4][2], const pg8::Unit& u, int wr, int wc, int fr, int fq, LAS unsigned char* lds, int wid, int lane
struct EpiInProj {
    bf16_t* qkv; bf16_t* gt; bool st; static constexpr bool STAMP = (STAMP_INPROJ >= 0); static constexpr bool WIDE = true; static constexpr bool FP8 = true; static constexpr int SCALE_W = 0, SCALE_A = 0;
    __device__ __forceinline__ void operator()(EPI_ARGS) const {
        bf16_t* base; int ld, colt; float sc = 1.f / 32.f;
        if (u.pn < 14) { base = qkv; ld = QXP; colt = u.pn * 256; if (u.pn < 2) sc = QSCALE / 32.f; }
        else { base = gt; ld = 2048; colt = (u.pn - 14) * 256; }
        LAS unsigned char* stg = lds + EST_OFF + wid * 2048;
#pragma unroll
        for (int ai = 0; ai < 2; ++ai)
#pragma unroll
            for (int m = 0; m < 4; ++m) { bf16_t* rowbase = base + (size_t)(u.pm * 256 + wr * 64 + ai * 128 + m * 16) * ld + colt + 64 * wc;
                u32x4 w[2];
#pragma unroll
                for (int bj = 0; bj < 2; ++bj) { const f32x4 v0 = acc[ai][bj][m][0] * sc, v1 = acc[ai][bj][m][1] * sc;
                    w[bj].x = pg8::cvt_pk_bf16(v0[0], v0[1]); w[bj].y = pg8::cvt_pk_bf16(v0[2], v0[3]); w[bj].z = pg8::cvt_pk_bf16(v1[0], v1[1]); w[bj].w = pg8::cvt_pk_bf16(v1[2], v1[3]); }
                wide_store16(stg, fr, fq, lane, w[0], w[1], rowbase, (size_t)ld, st); }
    }
};
template <int MODE> struct EpiBranch {
    const bf16_t* gate; int ldg; bf16_t* mg; int ldm; static constexpr bool STAMP = false; static constexpr bool WIDE = true; static constexpr bool FP8 = false;
    __device__ __forceinline__ void operator()(EPI_ARGS) const {
        const int row0 = u.pm * 256 + wr * 64 + fr, colw = u.pn * 256 + 64 * wc;
        LAS unsigned char* stg = lds + EST_OFF + wid * 2048;
#pragma unroll
        for (int ai = 0; ai < 2; ++ai)
#pragma unroll
            for (int m = 0; m < 4; ++m) { const size_t r = (size_t)(row0 + ai * 128 + m * 16);
                u32x4 w[2];
#pragma unroll
                for (int bj = 0; bj < 2; ++bj) { const int col0 = colw + 32 * bj + 8 * fq;
                    const u32x4 g = *(const u32x4*)(gate + r * ldg + col0);
                    f32x4 v0 = acc[ai][bj][m][0], v1 = acc[ai][bj][m][1];
                    v0[0] *= sigmoidf_(bflo(g.x)); v0[1] *= sigmoidf_(bfhi(g.x)); v0[2] *= sigmoidf_(bflo(g.y)); v0[3] *= sigmoidf_(bfhi(g.y));
                    v1[0] *= sigmoidf_(bflo(g.z)); v1[1] *= sigmoidf_(bfhi(g.z)); v1[2] *= sigmoidf_(bflo(g.w)); v1[3] *= sigmoidf_(bfhi(g.w));
                    if (MODE == 1) { const u32x4 o = *(const u32x4*)(mg + r * ldm + col0);
                        v0[0] += bflo(o.x); v0[1] += bfhi(o.x); v0[2] += bflo(o.y); v0[3] += bfhi(o.y); v1[0] += bflo(o.z); v1[1] += bfhi(o.z); v1[2] += bflo(o.w); v1[3] += bfhi(o.w); }
                    w[bj].x = pg8::cvt_pk_bf16(v0[0], v0[1]); w[bj].y = pg8::cvt_pk_bf16(v0[2], v0[3]); w[bj].z = pg8::cvt_pk_bf16(v1[0], v1[1]); w[bj].w = pg8::cvt_pk_bf16(v1[2], v1[3]); }
                wide_store16(stg, fr, fq, lane, w[0], w[1], mg + (size_t)(u.pm * 256 + wr * 64 + ai * 128 + m * 16) * ldm + colw, (size_t)ldm, true); }
    }
};
struct EpiBranchF {
    const bf16_t* ga; const bf16_t* gr; int ldg; bf16_t* mg; int ldm; static constexpr bool STAMP = false; static constexpr bool WIDE = true; static constexpr bool FP8 = false;
    static __device__ __forceinline__ float ratio(float a, float r) { return (1.0f + fast_exp2(-r * LOG2E)) * fast_rcp(1.0f + fast_exp2(-a * LOG2E)); }
    __device__ __forceinline__ void mid(f32x4 (&acc)[2][2][4][2], const pg8::Unit& u, int wr, int wc, int fr, int fq, LAS unsigned char* lds, int wid, int lane) const {
        const int row0 = u.pm * 256 + wr * 64 + fr, colw = u.pn * 256 + 64 * wc;
#pragma unroll
        for (int ai = 0; ai < 2; ++ai)
#pragma unroll
            for (int m = 0; m < 4; ++m) { const size_t r = (size_t)(row0 + ai * 128 + m * 16);
#pragma unroll
                for (int bj = 0; bj < 2; ++bj) { const int col0 = colw + 32 * bj + 8 * fq;
                    const u32x4 a = *(const u32x4*)(ga + r * ldg + col0), g = *(const u32x4*)(gr + r * ldg + col0);
                    f32x4& v0 = acc[ai][bj][m][0]; f32x4& v1 = acc[ai][bj][m][1];
                    v0[0] *= ratio(bflo(a.x), bflo(g.x)); v0[1] *= ratio(bfhi(a.x), bfhi(g.x)); v0[2] *= ratio(bflo(a.y), bflo(g.y)); v0[3] *= ratio(bfhi(a.y), bfhi(g.y));
                    v1[0] *= ratio(bflo(a.z), bflo(g.z)); v1[1] *= ratio(bfhi(a.z), bfhi(g.z)); v1[2] *= ratio(bflo(a.w), bflo(g.w)); v1[3] *= ratio(bfhi(a.w), bfhi(g.w)); } }
    }
    __device__ __forceinline__ void operator()(EPI_ARGS) const {
        const int row0 = u.pm * 256 + wr * 64 + fr, colw = u.pn * 256 + 64 * wc;
        LAS unsigned char* stg = lds + EST_OFF + wid * 2048;
#pragma unroll
        for (int ai = 0; ai < 2; ++ai)
#pragma unroll
            for (int m = 0; m < 4; ++m) { const size_t r = (size_t)(row0 + ai * 128 + m * 16);
                u32x4 w[2];
#pragma unroll
                for (int bj = 0; bj < 2; ++bj) { const int col0 = colw + 32 * bj + 8 * fq;
                    const u32x4 g = *(const u32x4*)(gr + r * ldg + col0);
                    f32x4 v0 = acc[ai][bj][m][0], v1 = acc[ai][bj][m][1];
                    v0[0] *= sigmoidf_(bflo(g.x)); v0[1] *= sigmoidf_(bfhi(g.x)); v0[2] *= sigmoidf_(bflo(g.y)); v0[3] *= sigmoidf_(bfhi(g.y));
                    v1[0] *= sigmoidf_(bflo(g.z)); v1[1] *= sigmoidf_(bfhi(g.z)); v1[2] *= sigmoidf_(bflo(g.w)); v1[3] *= sigmoidf_(bfhi(g.w));
                    w[bj].x = pg8::cvt_pk_bf16(v0[0], v0[1]); w[bj].y = pg8::cvt_pk_bf16(v0[2], v0[3]); w[bj].z = pg8::cvt_pk_bf16(v1[0], v1[1]); w[bj].w = pg8::cvt_pk_bf16(v1[2], v1[3]); }
                wide_store16(stg, fr, fq, lane, w[0], w[1], mg + (size_t)(u.pm * 256 + wr * 64 + ai * 128 + m * 16) * ldm + colw, (size_t)ldm, true); }
    }
};
struct EpiOut {
    bf16_t* mo; float* ssq; static constexpr bool STAMP = false; static constexpr bool WIDE = true; static constexpr bool FP8 = false;
    __device__ __forceinline__ void operator()(EPI_ARGS) const {
        const int row0 = u.pm * 256 + wr * 64 + fr, colw = u.pn * 256 + 64 * wc;
        LAS unsigned char* stg = lds + EST_OFF + wid * 2048;
#pragma unroll
        for (int ai = 0; ai < 2; ++ai)
#pragma unroll
            for (int m = 0; m < 4; ++m) { const size_t r = (size_t)(row0 + ai * 128 + m * 16); float sq = 0.f;
                u32x4 w[2];
#pragma unroll
                for (int bj = 0; bj < 2; ++bj) { const f32x4 v0 = acc[ai][bj][m][0], v1 = acc[ai][bj][m][1];
                    sq += (v0[0] * v0[0] + v0[1] * v0[1]) + (v0[2] * v0[2] + v0[3] * v0[3]) + (v1[0] * v1[0] + v1[1] * v1[1]) + (v1[2] * v1[2] + v1[3] * v1[3]);
                    w[bj].x = pg8::cvt_pk_bf16(v0[0], v0[1]); w[bj].y = pg8::cvt_pk_bf16(v0[2], v0[3]); w[bj].z = pg8::cvt_pk_bf16(v1[0], v1[1]); w[bj].w = pg8::cvt_pk_bf16(v1[2], v1[3]); }
                wide_store16(stg, fr, fq, lane, w[0], w[1], mo + (size_t)(u.pm * 256 + wr * 64 + ai * 128 + m * 16) * 1024 + colw, (size_t)1024, true);
                sq = xor16_sum(sq); sq = xor32_sum(sq);
                if (fq == 0) ssq[r * 16 + u.pn * 4 + wc] = sq; }
    }
};
struct EpiGateUp {
    unsigned char* act; static constexpr bool STAMP = false; static constexpr bool WIDE = false; static constexpr bool FP8 = true; static constexpr int SCALE_W = 0, SCALE_A = 0;
    __device__ __forceinline__ void operator()(EPI_ARGS) const {
        const int row0 = u.pm * 256 + wr * 64 + fr, col0 = u.pn * 128 + wc * 32 + 8 * fq;
#pragma unroll
        for (int ai = 0; ai < 2; ++ai)
#pragma unroll
            for (int m = 0; m < 4; ++m) { const size_t r = (size_t)(row0 + ai * 128 + m * 16);
                float v[8];
#pragma unroll
                for (int n = 0; n < 2; ++n)
#pragma unroll
                    for (int e = 0; e < 4; ++e) { const float g = acc[ai][0][m][n][e] * (1.0f / 32.0f), up = acc[ai][1][m][n][e] * (4.0f / 32.0f); v[n * 4 + e] = g * sigmoidf_(g) * up; }
                int d0 = 0, d1 = 0;
                d0 = __builtin_amdgcn_cvt_pk_fp8_f32(v[0], v[1], d0, false); d0 = __builtin_amdgcn_cvt_pk_fp8_f32(v[2], v[3], d0, true);
                d1 = __builtin_amdgcn_cvt_pk_fp8_f32(v[4], v[5], d1, false); d1 = __builtin_amdgcn_cvt_pk_fp8_f32(v[6], v[7], d1, true);
                *(u32x2*)(act + r * 256 + col0) = (u32x2){(unsigned)d0, (unsigned)d1}; }
    }
};
struct EpiDown {
    unsigned char* y; bool st; static constexpr bool STAMP = (STAMP_DOWN >= 0); static constexpr bool WIDE = true; static constexpr bool FP8 = true; static constexpr int SCALE_W = 0, SCALE_A = 0;
    __device__ __forceinline__ void operator()(EPI_ARGS) const {
        LAS unsigned char* stg = lds + EST_OFF + wid * 2048;
        const int sw = ((fr >> 1) & 3) << 1;
#pragma unroll
        for (int ai = 0; ai < 2; ++ai)
#pragma unroll
            for (int m = 0; m < 4; ++m) {
#pragma unroll
                for (int bj = 0; bj < 2; ++bj) { const f32x4 v0 = acc[ai][bj][m][0] * (1.0f / 64.0f), v1 = acc[ai][bj][m][1] * (1.0f / 64.0f); int d0 = 0, d1 = 0;
                    d0 = __builtin_amdgcn_cvt_pk_fp8_f32(v0[0], v0[1], d0, false); d0 = __builtin_amdgcn_cvt_pk_fp8_f32(v0[2], v0[3], d0, true);
                    d1 = __builtin_amdgcn_cvt_pk_fp8_f32(v1[0], v1[1], d1, false); d1 = __builtin_amdgcn_cvt_pk_fp8_f32(v1[2], v1[3], d1, true);
                    *(LAS u32x2*)(stg + fr * 64 + (((bj * 4 + fq) ^ sw) * 8)) = (u32x2){(unsigned)d0, (unsigned)d1}; }
                const int rr = lane >> 2, q = lane & 3;
                const u32x4 v = *(const LAS u32x4*)(stg + rr * 64 + (((2 * q) ^ (((rr >> 1) & 3) << 1)) * 8));
                if (st) *(u32x4*)(y + (size_t)(u.pm * 256 + wr * 64 + ai * 128 + m * 16 + rr) * 1024 + u.pn * 256 + 64 * wc + 16 * q) = v; }
    }
};

namespace att {
constexpr int PITCH = QXP, QB = 256, KVBLK = 64, SLOTB = 8192;
constexpr int L_K = 0, L_V = 2 * SLOTB, L_WS = 4 * SLOTB, L_CUM = L_WS + 8 * 64 * 4, L_OST = L_CUM + SEQ * 4, L_END = L_OST + 8 * 4096;
static_assert(L_END <= RING_BYTES, "attention LDS");
__device__ __forceinline__ int crow(int r, int hi) { return (r & 3) + 8 * (r >> 2) + 4 * hi; }
__device__ __forceinline__ void glds16(const void* gsrc, unsigned lds_dst) { unsigned keep;
    asm volatile("s_mov_b32 %0, m0\n\ts_mov_b32 m0, %2\n\ts_nop 0\n\tglobal_load_lds_dwordx4 %1, off\n\ts_mov_b32 m0, %0" : "=&s"(keep) : "v"(gsrc), "s"(lds_dst) : "memory"); }
__device__ __forceinline__ unsigned cvtpk(float lo, float hi) { unsigned r; asm volatile("v_cvt_pk_bf16_f32 %0, %1, %2" : "=v"(r) : "v"(lo), "v"(hi)); return r; }
__device__ __forceinline__ float max3f(float a, float b, float c) { return __builtin_fmaxf(__builtin_fmaxf(a, b), c); }

__device__ __forceinline__ void pv(f32x16* o, int vb, bf16x8 pa0, bf16x8 pa1, bf16x8 pa2, bf16x8 pa3) {
#pragma unroll
    for (int d0 = 0; d0 < 2; ++d0) { s16x4 lo[4], hi[4];
#pragma unroll
        for (int ks = 0; ks < 4; ++ks) {
            asm volatile("ds_read_b64_tr_b16 %0,%1 offset:%c2" : "=&v"(lo[ks]) : "v"(vb), "i"(d0 * 4096 + ks * 1024) : "memory");
            asm volatile("ds_read_b64_tr_b16 %0,%1 offset:%c2" : "=&v"(hi[ks]) : "v"(vb), "i"(d0 * 4096 + ks * 1024 + 512) : "memory"); }
        asm volatile("s_waitcnt lgkmcnt(0)" ::: "memory"); __builtin_amdgcn_sched_barrier(0);
#define PK(k) (bf16x8){lo[k][0], lo[k][1], lo[k][2], lo[k][3], hi[k][0], hi[k][1], hi[k][2], hi[k][3]}
        o[d0] = __builtin_amdgcn_mfma_f32_32x32x16_bf16(pa0, PK(0), o[d0], 0, 0, 0);
        o[d0] = __builtin_amdgcn_mfma_f32_32x32x16_bf16(pa1, PK(1), o[d0], 0, 0, 0);
        o[d0] = __builtin_amdgcn_mfma_f32_32x32x16_bf16(pa2, PK(2), o[d0], 0, 0, 0);
        o[d0] = __builtin_amdgcn_mfma_f32_32x32x16_bf16(pa3, PK(3), o[d0], 0, 0, 0);
#undef PK
    }
}

constexpr float SKIP_T = 24.0f;
constexpr int L_KN = L_OST + 8 * 4096;
static_assert(L_KN + 512 <= RING_BYTES, "attention LDS");
__device__ __forceinline__ void attn_bh(int b, int h, bf16_t* qkv, const float* lcum, const float* tot, LAS unsigned char* lds, bool do_store = true) {
    const int tid = threadIdx.x, lane = tid & 63, r32 = lane & 31, hi = lane >> 5; const int wid = __builtin_amdgcn_readfirstlane(tid >> 6);
    LAS float* cumT = (LAS float*)(lds + L_CUM);
    LAS float* wsf = (LAS float*)(lds + L_WS) + wid * 64;
    LAS float* knw = (LAS float*)(lds + L_KN); LAS float* knb = knw + 32; LAS float* rbw = knb + 8;
    const long rowbase = (long)b * SEQ;
    const bf16_t* Kh = qkv + rowbase * PITCH + 512 + h * 64; const bf16_t* Vh = qkv + rowbase * PITCH + 1024 + h * 64;
    { float tt[8], lc4[4];
#pragma unroll
      for (int j = 0; j < 8; ++j) tt[j] = tot[(b * 8 + j) * 8 + h];
#pragma unroll
      for (int q = 0; q < 4; ++q) lc4[q] = lcum[(rowbase + tid + 512 * q) * 8 + h];
#pragma unroll
      for (int q = 0; q < 4; ++q) { const int i = tid + 512 * q, ti = i >> 8; float off = 0.f;
#pragma unroll
          for (int j = 0; j < 7; ++j) off += (j < ti) ? tt[j] : 0.f;
          cumT[i] = lc4[q] + off; } }
    { float kn[4];
#pragma unroll
      for (int i = 0; i < 4; ++i) { const bf16_t* kp = Kh + (long)(tid + 512 * i) * PITCH; float ss = 0.f;
#pragma unroll
          for (int c = 0; c < 8; ++c) { const u32x4 v = *(const u32x4*)(kp + 8 * c);
              ss += bflo(v.x) * bflo(v.x) + bfhi(v.x) * bfhi(v.x) + bflo(v.y) * bflo(v.y) + bfhi(v.y) * bfhi(v.y) + bflo(v.z) * bflo(v.z) + bfhi(v.z) * bfhi(v.z) + bflo(v.w) * bflo(v.w) + bfhi(v.w) * bfhi(v.w); }
          float m = sqrtf(ss);
          kn[i] = wave_max(m); }
      if (lane == 0) { knw[wid * 4 + 0] = kn[0]; knw[wid * 4 + 1] = kn[1]; knw[wid * 4 + 2] = kn[2]; knw[wid * 4 + 3] = kn[3]; } }
    LDS_WAIT(); __syncthreads();
    if (tid < 8) { const int half = tid & 1, i = tid >> 1; float m = 0.f;
#pragma unroll
        for (int w = 0; w < 4; ++w) m = fmaxf(m, knw[(4 * half + w) * 4 + i]);
        knb[tid] = m; }
    LDS_WAIT(); __syncthreads();
    const unsigned lds0 = (unsigned)(uintptr_t)lds;
    const bf16_t* ksrc = Kh + (long)lane * PITCH + wid * 8;
    const bf16_t* vsrc = Vh + (long)(16 * (wid & 3) + (lane >> 2)) * PITCH + (wid >> 2) * 32 + (lane & 3) * 8;
    const unsigned kdst = lds0 + L_K + wid * 1024, vdst = lds0 + L_V + wid * 1024;
    const int vb0 = (int)(lds0 + L_V) + ((lane >> 4) & 1) * 32 + (lane & 3) * 8 + (4 * hi + ((lane & 15) >> 2)) * 64;
    int it = 0;
    for (int qb = 7; qb >= 0; --qb) {
        const int q0 = qb * QB;
        bf16_t* Qw = qkv + (rowbase + q0 + wid * 32) * PITCH + h * 64;
        bf16x8 qr[4];
#pragma unroll
        for (int d0 = 0; d0 < 4; ++d0) qr[d0] = *(const bf16x8*)(Qw + (long)r32 * PITCH + d0 * 16 + hi * 8);
        float qn = 0.f;
#pragma unroll
        for (int d0 = 0; d0 < 4; ++d0)
#pragma unroll
            for (int j = 0; j < 8; ++j) { const float qv = bf2f((unsigned short)qr[d0][j]); qn += qv * qv; }
        qn = xor32_sum(qn); qn = sqrtf(qn);
        float kpmax = 0.f;
#pragma unroll
        for (int j = 0; j < 8; ++j) { const float kj = knb[j]; kpmax = (j <= qb) ? fmaxf(kpmax, kj) : kpmax; }
        const int qrel = wid * 32 + r32;
        const float cq = cumT[q0 + qrel];
        float mrun = -1e30f, lrun = 0.f; f32x16 o[2]; o[0] = f32x16{}; o[1] = f32x16{};
        const int NT = (q0 + QB) / KVBLK;
        if (qb == 7) { glds16(ksrc + (long)(NT - 1) * KVBLK * PITCH, (unsigned)__builtin_amdgcn_readfirstlane(kdst)); glds16(vsrc + (long)(NT - 1) * KVBLK * PITCH, (unsigned)__builtin_amdgcn_readfirstlane(vdst)); }
        float Rb = 1e30f, Rw = 1e30f;
        for (int t = NT - 1; t >= 0; --t, ++it) {
            const int slot = (it & 1) * SLOTB;
            asm volatile("s_waitcnt vmcnt(0) lgkmcnt(0)\n\ts_barrier" ::: "memory");
            const bool more = (t >= 1) && (Rb - cumT[64 * (t - 1) + 63] >= -SKIP_T);
            if (more) { const int ns = ((it + 1) & 1) * SLOTB;
                glds16(ksrc + (long)(t - 1) * KVBLK * PITCH, (unsigned)__builtin_amdgcn_readfirstlane(kdst + ns));
                glds16(vsrc + (long)(t - 1) * KVBLK * PITCH, (unsigned)__builtin_amdgcn_readfirstlane(vdst + ns)); }
            else if (qb > 0) { const int ns = ((it + 1) & 1) * SLOTB;
                glds16(ksrc + (long)(q0 - KVBLK) * PITCH, (unsigned)__builtin_amdgcn_readfirstlane(kdst + ns));
                glds16(vsrc + (long)(q0 - KVBLK) * PITCH, (unsigned)__builtin_amdgcn_readfirstlane(vdst + ns)); }
            const int jb = t - (NT - 4);
            const bool wskip = (jb >= 0) ? (64 * jb > wid * 32 + 31) : (Rw - cumT[64 * t + 63] < -SKIP_T);
            if (!wskip) {
            f32x16 p0, p1;
            const LAS float* ck = cumT + t * KVBLK + 4 * hi;
            const float cqm = (jb >= 0) ? cq : cq - mrun;
#pragma unroll
            for (int g = 0; g < 4; ++g) { const f32x4 c0 = *(const LAS f32x4*)(ck + 8 * g), c1 = *(const LAS f32x4*)(ck + 32 + 8 * g);
#pragma unroll
                for (int e = 0; e < 4; ++e) { p0[4 * g + e] = cqm - c0[e]; p1[4 * g + e] = cqm - c1[e]; } }
            const LAS unsigned char* kb = lds + L_K + slot + hi * 1024 + r32 * 16;
#pragma unroll
            for (int d0 = 0; d0 < 4; ++d0) { const bf16x8 b0 = *(const LAS bf16x8*)(kb + d0 * 2048), b1 = *(const LAS bf16x8*)(kb + d0 * 2048 + 512);
                p0 = __builtin_amdgcn_mfma_f32_32x32x16_bf16(b0, qr[d0], p0, 0, 0, 0); p1 = __builtin_amdgcn_mfma_f32_32x32x16_bf16(b1, qr[d0], p1, 0, 0, 0); }
            if (jb >= 0) { const int kb0 = 64 * jb + 4 * hi;
#pragma unroll
                for (int r = 0; r < 16; ++r) { const int kv = kb0 + (r & 3) + 8 * (r >> 2); if (kv > qrel) p0[r] = -INFINITY; if (kv + 32 > qrel) p1[r] = -INFINITY; } }
            float rm;
            { float a = max3f(p0[0], p0[1], p1[0]), b2 = max3f(p0[2], p0[3], p1[1]); a = max3f(a, p1[2], p1[3]);
#pragma unroll
              for (int r = 4; r < 16; r += 4) { a = max3f(a, p0[r], p0[r + 1]); b2 = max3f(b2, p0[r + 2], p0[r + 3]); a = max3f(a, p1[r], p1[r + 1]); b2 = max3f(b2, p1[r + 2], p1[r + 3]); }
              rm = fmaxf(a, b2); }
            rm = xor32_max(rm);
            float alpha; bool grew;
            if (jb >= 0) {
                const float mn = fmaxf(mrun, rm); alpha = fast_exp2(mrun - mn); grew = __any(mn > mrun); mrun = mn;
#pragma unroll
                for (int r = 0; r < 16; ++r) { p0[r] -= mn; p1[r] -= mn; }
            } else {
                grew = __any(rm > 0.f); alpha = 1.0f;
                if (grew) { const float dl = fmaxf(rm, 0.f); mrun += dl; alpha = fast_exp2(-dl);
#pragma unroll
                    for (int r = 0; r < 16; ++r) { p0[r] -= dl; p1[r] -= dl; } }
            }
            float ls = 0.f;
#pragma unroll
            for (int r = 0; r < 16; ++r) { p0[r] = fast_exp2(p0[r]); p1[r] = fast_exp2(p1[r]); ls += p0[r] + p1[r]; }
            lrun = lrun * alpha + ls;
            if (grew) {
                if (hi == 0) wsf[r32] = alpha;
                asm volatile("s_waitcnt lgkmcnt(0)" ::: "memory");
#pragma unroll
                for (int r = 0; r < 16; ++r) { const float a = wsf[crow(r, hi)]; o[0][r] *= a; o[1][r] *= a; }
            }
            u32x4 pw0, pw1, pw2, pw3;
            pw0 = (u32x4){cvtpk(p0[0], p0[1]), cvtpk(p0[2], p0[3]), cvtpk(p0[4], p0[5]), cvtpk(p0[6], p0[7])};
            pw1 = (u32x4){cvtpk(p0[8], p0[9]), cvtpk(p0[10], p0[11]), cvtpk(p0[12], p0[13]), cvtpk(p0[14], p0[15])};
            pw2 = (u32x4){cvtpk(p1[0], p1[1]), cvtpk(p1[2], p1[3]), cvtpk(p1[4], p1[5]), cvtpk(p1[6], p1[7])};
            pw3 = (u32x4){cvtpk(p1[8], p1[9]), cvtpk(p1[10], p1[11]), cvtpk(p1[12], p1[13]), cvtpk(p1[14], p1[15])};
            asm volatile("s_waitcnt lgkmcnt(0)" ::: "memory"); __builtin_amdgcn_sched_barrier(0);
            pv(o, vb0 + slot, __builtin_bit_cast(bf16x8, pw0), __builtin_bit_cast(bf16x8, pw1), __builtin_bit_cast(bf16x8, pw2), __builtin_bit_cast(bf16x8, pw3));
            }
            if (jb == 0) {
                float rb = qn * kpmax + cq - mrun;
                rb = wave_max(rb);
                Rw = rb;
                if (lane == 0) rbw[wid] = rb;
                asm volatile("s_waitcnt lgkmcnt(0)\n\ts_barrier" ::: "memory");
                float R = rbw[0];
#pragma unroll
                for (int w = 1; w < 8; ++w) R = fmaxf(R, rbw[w]);
                Rb = R;
            }
            if (!more) { ++it; break; }
        }
        lrun = xor32_sum(lrun);
        if (hi == 0) wsf[32 + r32] = lrun;
        asm volatile("s_waitcnt lgkmcnt(0)" ::: "memory");
        float rli[16];
#pragma unroll
        for (int r = 0; r < 16; ++r) rli[r] = fast_rcp(wsf[32 + crow(r, hi)]);
        { LAS bf16_t* stg = (LAS bf16_t*)(lds + L_OST) + wid * 2048;
#pragma unroll
            for (int r = 0; r < 16; ++r) { const int orow = crow(r, hi);
#pragma unroll
                for (int d0 = 0; d0 < 2; ++d0) stg[orow * 64 + d0 * 32 + r32] = (bf16_t)f2bf(o[d0][r] * rli[r]); }
            asm volatile("s_waitcnt lgkmcnt(0)" ::: "memory");
#pragma unroll
            for (int i = 0; i < 4; ++i) { const int row = i * 8 + (lane >> 3), ch = lane & 7; const u32x4 v = *(const LAS u32x4*)(stg + row * 64 + ch * 8); if (do_store) *(u32x4*)(Qw + (long)row * PITCH + ch * 8) = v; } }
        asm volatile("s_waitcnt vmcnt(0) lgkmcnt(0)\n\ts_barrier" ::: "memory");
    }
}
}

namespace att2 {
using att::crow;
__device__ __forceinline__ const void* uni(const void* p) { const unsigned long long v = (unsigned long long)p; const unsigned lo = __builtin_amdgcn_readfirstlane((unsigned)v), hi = __builtin_amdgcn_readfirstlane((unsigned)(v >> 32)); return (const void*)(((unsigned long long)hi << 32) | lo); }
__device__ __forceinline__ void glds16s(const void* sbase, unsigned voff, unsigned lds_dst) { unsigned keep;
    asm volatile("s_nop 4\n\ts_mov_b32 %0, m0\n\ts_mov_b32 m0, %3\n\ts_nop 0\n\tglobal_load_lds_dwordx4 %1, %2\n\ts_mov_b32 m0, %0" : "=&s"(keep) : "v"(voff), "s"(sbase), "s"(lds_dst) : "memory"); }
constexpr int PITCH = QXP, QB = 256, KVBLK = 64, SLOTB = 8192, NSLOT = 3, NW = 8;
constexpr int L_K = 0, L_V = NSLOT * SLOTB, L_WS = 2 * NSLOT * SLOTB, L_CUM = L_WS + NW * 64 * 4, L_OST = L_CUM + SEQ * 4, L_KN = L_OST + NW * 4096, L_END = L_KN + 512;
static_assert(L_END <= RING_BYTES, "attention LDS");
constexpr float SKIP_T = 24.0f;
#define SBAR() __builtin_amdgcn_sched_barrier(0)
#define WAIT_BAR(N) asm volatile("s_waitcnt vmcnt(" #N ") lgkmcnt(0)\n\ts_barrier":::"memory")
typedef __attribute__((address_space(3))) const char* lds_cptr;
typedef short v4i16_t __attribute__((ext_vector_type(4)));
__device__ __forceinline__ float max3a(float a,float b,float c){float r;asm("v_max3_f32 %0, %1, %2, %3":"=v"(r):"v"(a),"v"(b),"v"(c));return r;}
__device__ __forceinline__ float max2a(float a,float b){float r;asm("v_max_f32_e32 %0, %1, %2":"=v"(r):"v"(a),"v"(b));return r;}
__device__ __forceinline__ float fsub_s(float a,float b){float r;asm("v_sub_f32_e32 %0, %1, %2":"=v"(r):"v"(a),"v"(b));return r;}
typedef float f32x2_t __attribute__((ext_vector_type(2))); typedef __bf16 bf16x2_t __attribute__((ext_vector_type(2)));
__device__ __forceinline__ unsigned cvtpk_s(float lo,float hi){f32x2_t v={lo,hi};bf16x2_t b=__builtin_convertvector(v,bf16x2_t);return __builtin_bit_cast(unsigned,b);}
__device__ __forceinline__ void cmask(f32x16&p0,f32x16&p1,int jb,int qrel,int hi){
  const float NEG=-INFINITY; int kb=64*jb+4*hi;
  #pragma unroll
  for(int r=0;r<16;++r){int kv=kb+(r&3)+8*(r>>2); if(kv>qrel)p0[r]=NEG; if(kv+32>qrel)p1[r]=NEG;}
}
__device__ __forceinline__ void kload8(bf16x8*kf,lds_cptr kp){
  kf[0]=*(const LAS bf16x8*)(kp);      kf[1]=*(const LAS bf16x8*)(kp+512);
  kf[2]=*(const LAS bf16x8*)(kp+2048); kf[3]=*(const LAS bf16x8*)(kp+2560);
  kf[4]=*(const LAS bf16x8*)(kp+4096); kf[5]=*(const LAS bf16x8*)(kp+4608);
  kf[6]=*(const LAS bf16x8*)(kp+6144); kf[7]=*(const LAS bf16x8*)(kp+6656);
}
__device__ __forceinline__ void kload2(bf16x8*kf,lds_cptr kp,int j){ kf[2*j]=*(const LAS bf16x8*)(kp+j*2048); kf[2*j+1]=*(const LAS bf16x8*)(kp+j*2048+512); }
__device__ __forceinline__ s16x4 vtr(lds_cptr p){ return __builtin_bit_cast(s16x4,__builtin_amdgcn_ds_read_tr16_b64_v4i16((LAS v4i16_t*)p)); }
__device__ __forceinline__ float rowmax(const f32x16&p0,const f32x16&p1){
  float a=max3a(p0[0],p0[1],p1[0]),b=max3a(p0[2],p0[3],p1[1]);a=max3a(a,p1[2],p1[3]);
  #pragma unroll
  for(int r=4;r<16;r+=4){a=max3a(a,p0[r],p0[r+1]);b=max3a(b,p0[r+2],p0[r+3]);a=max3a(a,p1[r],p1[r+1]);b=max3a(b,p1[r+2],p1[r+3]);}
  const float m=max2a(a,b);
  return xor32_max(m);
}
__device__ __forceinline__ void cpreset(f32x16&c0,f32x16&c1,const LAS float*ck,float aq){
  #pragma unroll
  for(int g=0;g<4;++g){ const f32x4 a=*(const LAS f32x4*)(ck+8*g), b=*(const LAS f32x4*)(ck+32+8*g);
    #pragma unroll
    for(int e=0;e<4;++e){ c0[4*g+e]=aq-a[e]; c1[4*g+e]=aq-b[e]; }
    __builtin_amdgcn_sched_barrier(0); }
}

#define NXTS(x_) (((x_)==(NSLOT-1)*SLOTB)?0:(x_)+SLOTB)
template<int THRL> __device__ __forceinline__ void attn_qblock(int b,int h,int qb,bf16_t*qkv,LAS unsigned char*lds,bool do_store,int&sbase,bool pre){
  const int tid=threadIdx.x,lane=tid&63,r32=lane&31,hi=lane>>5; const int wid=__builtin_amdgcn_readfirstlane(tid>>6);
  const long rowbase=(long)b*SEQ; const int q0=qb*QB;
  LAS float*cumT=(LAS float*)(lds+L_CUM); LAS float*knb=(LAS float*)(lds+L_KN)+32; LAS float*rbw=knb+8;
  const bf16_t*Kh=qkv+rowbase*PITCH+512+h*64,*Vh=qkv+rowbase*PITCH+1024+h*64;
  const unsigned lds0=(unsigned)(uintptr_t)lds;
  LAS float*wsf=(LAS float*)(lds+L_WS)+wid*64;
  const unsigned koff=(unsigned)((lane*PITCH+wid*8)*2);
  const unsigned voff=(unsigned)(((16*(wid&3)+(lane>>2))*PITCH+(wid>>2)*32+(lane&3)*8)*2);
  const unsigned kdst=lds0+L_K+wid*1024, vdst=lds0+L_V+wid*1024;
  const int NT=(q0+QB)/KVBLK;
  #define TS(i) (((i)<4)?(NT-4+(i)):(NT-1-(i)))
  #define DMA_K(i,slot) glds16s(uni(Kh+(long)TS(i)*KVBLK*PITCH),koff,(unsigned)__builtin_amdgcn_readfirstlane(kdst+(slot)))
  #define DMA_V(i,slot) glds16s(uni(Vh+(long)TS(i)*KVBLK*PITCH),voff,(unsigned)__builtin_amdgcn_readfirstlane(vdst+(slot)))
  bf16x8 kf[8];
  const lds_cptr shm3=(lds_cptr)lds; const lds_cptr kp0=shm3+L_K+hi*1024+r32*16; const lds_cptr vp0=shm3+L_V+((lane>>4)&1)*32+(lane&3)*8+(4*hi+((lane&15)>>2))*64;
  int NV=(NT<8)?NT:8;
  const int S0=sbase,S1=NXTS(S0),S2=NXTS(S1);
  if(!pre){DMA_K(0,S0);DMA_V(0,S0);DMA_K(1,S1);}
  bf16x8 qr[4];
  { const bf16_t*Qw=qkv+(rowbase+q0+wid*32)*PITCH+h*64;
    _Pragma("unroll") for(int d0=0;d0<4;++d0)qr[d0]=*(const bf16x8*)(Qw+(long)r32*PITCH+d0*16+hi*8); }
  const LAS float* cqp=cumT+q0+wid*32+r32;
  #define cq (*cqp)
  float mhat=0.f,l_reg=0.f;f32x16 o[2];o[0]=f32x16{};o[1]=f32x16{};
  #define CMASK(P0,P1,i) do{ if((i)<4)cmask(P0,P1,(i),wid*32+(lane&31),lane>>5);}while(0)
  bool resc=false;
  #define RESC() do{ if(resc){ asm volatile("s_waitcnt lgkmcnt(0)":::"memory"); \
      _Pragma("unroll") for(int d_=0;d_<2;++d_) _Pragma("unroll") for(int r=0;r<16;++r)o[d_][r]*=wsf[crow(r,hi)]; } }while(0)
  f32x16 pA0,pA1,pB0,pB1;
  int sl_prev=S0,sl_cur=S0,sl_next=S1;
  #define ROT() do{sl_prev=sl_cur;sl_cur=sl_next;sl_next=(sl_next==(NSLOT-1)*SLOTB)?0:sl_next+SLOTB;}while(0)
  if(!pre){DMA_K(2,S2); WAIT_BAR(3);}
  { cpreset(pA0,pA1,cumT+TS(0)*KVBLK+4*hi,cq);
    const LAS unsigned char*kb=lds+L_K+S0+hi*1024+r32*16;
    #pragma unroll
    for(int d0=0;d0<4;++d0){ const bf16x8 b0=*(const LAS bf16x8*)(kb+d0*2048),b1=*(const LAS bf16x8*)(kb+d0*2048+512);
      pA0=__builtin_amdgcn_mfma_f32_32x32x16_bf16(b0,qr[d0],pA0,0,0,0);pA1=__builtin_amdgcn_mfma_f32_32x32x16_bf16(b1,qr[d0],pA1,0,0,0);}
    asm volatile("s_nop 15\n\ts_nop 7":"+v"(pA0),"+v"(pA1));
    cmask(pA0,pA1,0,wid*32+(lane&31),lane>>5);
    const float rm=rowmax(pA0,pA1); mhat=rm;
    #pragma unroll
    for(int r=0;r<16;++r){pA0[r]=fsub_s(pA0[r],rm);pA1[r]=fsub_s(pA1[r],rm);}
    #pragma unroll
    for(int r=0;r<16;++r){pA0[r]=__builtin_amdgcn_exp2f(pA0[r]);pA1[r]=__builtin_amdgcn_exp2f(pA1[r]);} }
  WAIT_BAR(0);
  if(3<NV)DMA_K(3,S0); DMA_V(1,S1);
  ROT();
  kload8(kf,kp0+sl_cur);
  if(3<NV) WAIT_BAR(2); else WAIT_BAR(1);
  s16x4 vlo[8],vhi[8]; u32x4 pw0,pw1,pw2,pw3;
  #define PKW(P,B) cvtpk_s(P[B],P[B+1])
  #define PAF(k) __builtin_bit_cast(bf16x8,pw##k)
  #define VFR(i) (bf16x8){vlo[i][0],vlo[i][1],vlo[i][2],vlo[i][3],vhi[i][0],vhi[i][1],vhi[i][2],vhi[i][3]}
  #define PIN(x) asm volatile("":"+v"(x))
  #define MX3(a,b,c) __builtin_fmaxf(__builtin_fmaxf((a),(b)),(c))
  #define GAPA(MF,A0,A1,A2,A3,W0,W1,PW) do{ MF; sacc+=A0; sacc+=A1; sacc+=A2; sacc+=A3; PIN(sacc); W0; W1; PIN(PW); SBAR(); }while(0)
  #define EX(v) __builtin_amdgcn_exp2f(v)
  #define GAPB(MF,X,B) do{ MF; X[B]=EX(X[B]); X[B+1]=EX(X[B+1]); X[B+2]=EX(X[B+2]); X[B+3]=EX(X[B+3]); PIN(X); SBAR(); }while(0)
  #define VRD(i) do{ vlo[i]=vtr(vp_+(((i)>>2)*4096+((i)&3)*1024)); vhi[i]=vtr(vp_+(((i)>>2)*4096+((i)&3)*1024+512)); }while(0)
  #define KRD(G,j) do{ if(G){ kload2(kf,kp0+sl_next,j); SBAR(); } }while(0)
  #define STEP(C0,C1,P0,P1,i,GK,GV,GL) do{ SBAR(); \
    cpreset(C0,C1,cumT+TS(i)*KVBLK+4*hi,cq-mhat); SBAR(); \
    const lds_cptr vp_=vp0+sl_prev; \
    VRD(0); SBAR(); float sacc=(P0[0]+P0[1]); \
    GAPA(C0=__builtin_amdgcn_mfma_f32_32x32x16_bf16(kf[0],qr[0],C0,0,0,0), P0[2],P0[3],P0[4],P0[5],     pw0[0]=PKW(P0,0), pw0[1]=PKW(P0,2), pw0); \
    VRD(4); SBAR(); GAPA(C1=__builtin_amdgcn_mfma_f32_32x32x16_bf16(kf[1],qr[0],C1,0,0,0), P0[6],P0[7],P0[8],P0[9],     pw0[2]=PKW(P0,4), pw0[3]=PKW(P0,6), pw0); \
    VRD(1); SBAR(); GAPA(C0=__builtin_amdgcn_mfma_f32_32x32x16_bf16(kf[2],qr[1],C0,0,0,0),   P0[10],P0[11],P0[12],P0[13], pw1[0]=PKW(P0,8), pw1[1]=PKW(P0,10), pw1); \
    VRD(5); SBAR(); GAPA(C1=__builtin_amdgcn_mfma_f32_32x32x16_bf16(kf[3],qr[1],C1,0,0,0),   P0[14],P0[15],P1[0],P1[1],   pw1[2]=PKW(P0,12),pw1[3]=PKW(P0,14), pw1); \
    VRD(2); SBAR(); GAPA(C0=__builtin_amdgcn_mfma_f32_32x32x16_bf16(kf[4],qr[2],C0,0,0,0),   P1[2],P1[3],P1[4],P1[5],     pw2[0]=PKW(P1,0), pw2[1]=PKW(P1,2), pw2); \
    VRD(6); SBAR(); GAPA(C1=__builtin_amdgcn_mfma_f32_32x32x16_bf16(kf[5],qr[2],C1,0,0,0),   P1[6],P1[7],P1[8],P1[9],     pw2[2]=PKW(P1,4), pw2[3]=PKW(P1,6), pw2); \
    VRD(3); SBAR(); GAPA(C0=__builtin_amdgcn_mfma_f32_32x32x16_bf16(kf[6],qr[3],C0,0,0,0),   P1[10],P1[11],P1[12],P1[13], pw3[0]=PKW(P1,8), pw3[1]=PKW(P1,10), pw3); \
    VRD(7); SBAR(); GAPA(C1=__builtin_amdgcn_mfma_f32_32x32x16_bf16(kf[7],qr[3],C1,0,0,0),   P1[14],P1[15],0.f,0.f,       pw3[2]=PKW(P1,12),pw3[3]=PKW(P1,14), pw3); \
    l_reg+=sacc; \
    if(GK){DMA_K((i)+3,sl_cur);} if(GV){DMA_V((i)+1,sl_next);} \
    CMASK(C0,C1,i); \
    { float a=MX3(C0[0],C0[1],C1[0]),b2=MX3(C0[2],C0[3],C1[1]); a=MX3(a,C1[2],C1[3]); \
      _Pragma("unroll") for(int r=4;r<16;r+=4){a=MX3(a,C0[r],C0[r+1]);b2=MX3(b2,C0[r+2],C0[r+3]);a=MX3(a,C1[r],C1[r+1]);b2=MX3(b2,C1[r+2],C1[r+3]);} \
      float rm=__builtin_fmaxf(a,b2); rm=xor32_max(rm); \
      resc=false; \
      if(__builtin_expect(__any(rm>(float)THRL),0)){ const float dl=__builtin_fmaxf(rm,0.f); mhat+=dl; \
        _Pragma("unroll") for(int r=0;r<16;++r){C0[r]-=dl;C1[r]-=dl;} \
        const float f=__builtin_amdgcn_exp2f(-dl); l_reg*=f; if(hi==0)wsf[r32]=f; resc=true; } } \
    SBAR(); \
    GAPB(o[0]=__builtin_amdgcn_mfma_f32_32x32x16_bf16(PAF(0),VFR(0),o[0],0,0,0), C0,0); \
    GAPB(o[1]=__builtin_amdgcn_mfma_f32_32x32x16_bf16(PAF(0),VFR(4),o[1],0,0,0), C0,4); \
    KRD(GL,0); GAPB(o[0]=__builtin_amdgcn_mfma_f32_32x32x16_bf16(PAF(1),VFR(1),o[0],0,0,0), C0,8); \
    KRD(GL,1); GAPB(o[1]=__builtin_amdgcn_mfma_f32_32x32x16_bf16(PAF(1),VFR(5),o[1],0,0,0), C0,12); \
    KRD(GL,2); GAPB(o[0]=__builtin_amdgcn_mfma_f32_32x32x16_bf16(PAF(2),VFR(2),o[0],0,0,0), C1,0); \
    KRD(GL,3); GAPB(o[1]=__builtin_amdgcn_mfma_f32_32x32x16_bf16(PAF(2),VFR(6),o[1],0,0,0), C1,4); \
    GAPB(o[0]=__builtin_amdgcn_mfma_f32_32x32x16_bf16(PAF(3),VFR(3),o[0],0,0,0), C1,8); \
    GAPB(o[1]=__builtin_amdgcn_mfma_f32_32x32x16_bf16(PAF(3),VFR(7),o[1],0,0,0), C1,12); \
    }while(0)
  #define ENDW(tt) do{ if((tt)+3<NV){WAIT_BAR(2);} else if((tt)+1<NV){WAIT_BAR(1);} else {WAIT_BAR(0);} }while(0)
  int i=1;
  for(;i+2<NV;i+=2){
    STEP(pB0,pB1,pA0,pA1,i,(i+3<NV),(i+1<NV),(i+1<NV));
    if(i==3){
      float qn=0.f;
      #pragma unroll
      for(int d0=0;d0<4;++d0)
        #pragma unroll
        for(int j=0;j<8;++j){const float qv=bf2f((unsigned short)qr[d0][j]);qn+=qv*qv;}
      qn=xor32_sum(qn);
      qn=__builtin_amdgcn_sqrtf(qn);
      float kpmax=0.f; for(int j=0;j<=qb;++j)kpmax=fmaxf(kpmax,knb[j]);
      float rb=qn*kpmax+cq-mhat;
      if(hi==0)wsf[32+r32]=rb; asm volatile("s_waitcnt lgkmcnt(0)":::"memory");
      #pragma unroll
      for(int g=0;g<8;++g){ const f32x4 v4=*(const LAS f32x4*)(wsf+32+4*g); rb=fmaxf(fmaxf(rb,v4[0]),fmaxf(v4[1],fmaxf(v4[2],v4[3]))); }
      if(lane==0)rbw[wid]=rb; }
    ENDW(i); RESC(); ROT();
    if(i==3){ float R=rbw[0];
      #pragma unroll
      for(int w=1;w<8;++w)R=fmaxf(R,rbw[w]);
      int nv=4; for(int j=NT-5;j>=0;--j){ if(R-cumT[64*j+63]>=-SKIP_T)++nv; else break; }
      nv=(nv+1)&~1; if(nv<8)nv=8; if(nv>NT)nv=NT; NV=nv; }
    STEP(pA0,pA1,pB0,pB1,i+1,(i+4<NV),(i+2<NV),(i+2<NV));   ENDW(i+1); RESC(); ROT();
  }
  if(qb>0){ const int n0=sl_next,n1=NXTS(n0),n2=NXTS(n1); const long r0=(long)(q0-QB)*PITCH;
    glds16s(uni(Kh+r0),koff,(unsigned)__builtin_amdgcn_readfirstlane(kdst+n0)); glds16s(uni(Vh+r0),voff,(unsigned)__builtin_amdgcn_readfirstlane(vdst+n0));
    glds16s(uni(Kh+r0+(long)KVBLK*PITCH),koff,(unsigned)__builtin_amdgcn_readfirstlane(kdst+n1)); glds16s(uni(Kh+r0+(long)2*KVBLK*PITCH),koff,(unsigned)__builtin_amdgcn_readfirstlane(kdst+n2));
    sbase=n0; }
  STEP(pB0,pB1,pA0,pA1,NV-1,false,false,false); RESC();
  if(qb>0) asm volatile("s_waitcnt vmcnt(4) lgkmcnt(0)\n\ts_barrier":::"memory"); else asm volatile("s_waitcnt vmcnt(0) lgkmcnt(0)\n\ts_barrier":::"memory");
  { float sacc=pB0[0]+pB0[1]; _Pragma("unroll") for(int r=2;r<16;++r)sacc+=pB0[r]; _Pragma("unroll") for(int r=0;r<16;++r)sacc+=pB1[r]; l_reg+=sacc;
    pw0=(u32x4){PKW(pB0,0),PKW(pB0,2),PKW(pB0,4),PKW(pB0,6)};pw1=(u32x4){PKW(pB0,8),PKW(pB0,10),PKW(pB0,12),PKW(pB0,14)};pw2=(u32x4){PKW(pB1,0),PKW(pB1,2),PKW(pB1,4),PKW(pB1,6)};pw3=(u32x4){PKW(pB1,8),PKW(pB1,10),PKW(pB1,12),PKW(pB1,14)};
    const int vb0=(int)(lds0+L_V)+((lane>>4)&1)*32+(lane&3)*8+(4*hi+((lane&15)>>2))*64;
    SBAR(); att::pv(o,vb0+sl_cur,PAF(0),PAF(1),PAF(2),PAF(3)); }
  l_reg=xor32_sum(l_reg);
  if(hi==0)wsf[32+r32]=l_reg;asm volatile("s_waitcnt lgkmcnt(0)":::"memory");
  float rli[16];
  #pragma unroll
  for(int r=0;r<16;++r)rli[r]=__builtin_amdgcn_rcpf(wsf[32+crow(r,hi)]);
  { LAS bf16_t*stg=(LAS bf16_t*)(lds+L_OST)+wid*2048; bf16_t*Qw=qkv+(rowbase+q0+wid*32)*PITCH+h*64;
    #pragma unroll
    for(int r=0;r<16;++r){const int orow=crow(r,hi);
      #pragma unroll
      for(int d0=0;d0<2;++d0)stg[orow*64+d0*32+r32]=(bf16_t)cvt_pk(o[d0][r]*rli[r],0.f);}
    asm volatile("s_waitcnt lgkmcnt(0)":::"memory");
    #pragma unroll
    for(int k=0;k<4;++k){const int row=k*8+(lane>>3),ch=lane&7; const u32x4 v=*(const LAS u32x4*)(stg+row*64+ch*8); if(do_store)*(u32x4*)(Qw+(long)row*PITCH+ch*8)=v;} }
  asm volatile("s_waitcnt vmcnt(0) lgkmcnt(0)\n\ts_barrier":::"memory");
  #undef TS
  #undef cq
  #undef DMA_K
  #undef DMA_V
  #undef CMASK
  #undef RESC
  #undef ROT
  #undef PKW
  #undef PAF
  #undef VFR
  #undef PIN
  #undef MX3
  #undef GAPA
  #undef GAPB
  #undef EX
  #undef VRD
  #undef KRD
  #undef STEP
  #undef ENDW
}
__device__ __forceinline__ void attn_bh(int b,int h,bf16_t*qkv,const float*lcum,const float*tot,LAS unsigned char*lds,bool do_store=true){
  const int tid=threadIdx.x,lane=tid&63; const int wid=__builtin_amdgcn_readfirstlane(tid>>6);
  LAS float*cumT=(LAS float*)(lds+L_CUM); LAS float*knw=(LAS float*)(lds+L_KN); LAS float*knb=knw+32;
  const long rowbase=(long)b*SEQ; const bf16_t*Kh=qkv+rowbase*PITCH+512+h*64;
  for(int i=tid;i<SEQ;i+=512){ float off=0.f; const int ti=i>>8; for(int j=0;j<ti;++j)off+=tot[(b*8+j)*8+h]; cumT[i]=lcum[(rowbase+i)*8+h]+off; }
  { float kn[4];
    #pragma unroll
    for(int i=0;i<4;++i){ const bf16_t*kp=Kh+(long)(tid+512*i)*PITCH; float ss=0.f; __builtin_amdgcn_sched_barrier(0);
      #pragma unroll
      for(int c=0;c<8;++c){ const u32x4 v=*(const u32x4*)(kp+8*c);
        ss+=bflo(v.x)*bflo(v.x)+bfhi(v.x)*bfhi(v.x)+bflo(v.y)*bflo(v.y)+bfhi(v.y)*bfhi(v.y)+bflo(v.z)*bflo(v.z)+bfhi(v.z)*bfhi(v.z)+bflo(v.w)*bflo(v.w)+bfhi(v.w)*bfhi(v.w); }
      float m=__builtin_amdgcn_sqrtf(ss);
      #pragma unroll
      for(int o=1;o<64;o<<=1)m=fmaxf(m,__shfl_xor(m,o));
      kn[i]=m; }
    if(lane==0){knw[wid*4+0]=kn[0];knw[wid*4+1]=kn[1];knw[wid*4+2]=kn[2];knw[wid*4+3]=kn[3];} }
  LDS_WAIT(); __syncthreads();
  { int t2=tid; asm volatile("":"+v"(t2));
    if(t2<8){ const int half=t2&1,i=t2>>1; float m=0.f;
      #pragma unroll
      for(int w=0;w<4;++w)m=fmaxf(m,knw[(4*half+w)*4+i]);
      knb[t2]=m; } }
  LDS_WAIT(); __syncthreads();
  int sbase=0; for(int qb=7;qb>=0;--qb) attn_qblock<8>(b,h,qb,qkv,lds,do_store,sbase,qb<7);
}
#undef SBAR
#undef NXTS
#undef WAIT_BAR
}

namespace rnn {
constexpr int L_W = 0, L_CW = 24576, L_GB = 26112, L_SUM = 28672, L_PARK = 36864, L_CARRY = 40960, L_STG = 49152, L_XS = 81920, XSP = 144;
__device__ __forceinline__ void rnn_unit(int b, int blk, bf16_t* xg, const bf16_t* wfrag, const float* w_conv, const float* b_conv,
                                         const float* b_rg, const float* b_ig, const float* lam, LAS unsigned char* lds, bool do_store = true) {
    const int tid = threadIdx.x, lane = tid & 63, n31 = lane & 31, hh = lane >> 5; const int wid = __builtin_amdgcn_readfirstlane(tid >> 6);
    LAS float* cw = (LAS float*)(lds + L_CW);
    LAS float* gb = (LAS float*)(lds + L_GB);
    LAS float* sum = (LAS float*)(lds + L_SUM);
    LAS float* carry = (LAS float*)(lds + L_CARRY);
    LAS float* park = (LAS float*)(lds + L_PARK);
    __syncthreads();
    const size_t colx = (size_t)blk * 64;
    u32x4 xr[5], gr[4];
#define RNN_LOAD(sg) do { const int tl_ = (sg) * 256 + wid * 32; \
        _Pragma("unroll") for (int i = 0; i < 5; ++i) { const int p = lane + 64 * i, row = p >> 3, tok = tl_ - 3 + row; \
            xr[i] = (p < 280 && tok >= 0) ? *(const u32x4*)(xg + ((size_t)b * SEQ + tok) * QXP + colx + (p & 7) * 8) : (u32x4){0u, 0u, 0u, 0u}; } \
        _Pragma("unroll") for (int i = 0; i < 4; ++i) gr[i] = *(const u32x4*)(xg + ((size_t)b * SEQ + tl_ + i * 8 + (lane >> 3)) * QXP + 1024 + colx + (lane & 7) * 8); } while (0)
    RNN_LOAD(0);
    for (int i = tid; i < 1536; i += 512) *(LAS u32x4*)(lds + L_W + i * 16) = *(const u32x4*)((const char*)wfrag + (size_t)blk * 24576 + i * 16);
    if (tid < 256) cw[tid] = w_conv[(tid >> 6) * 1024 + blk * 64 + (tid & 63)];
    else if (tid < 320) cw[tid] = b_conv[blk * 64 + (tid - 256)];
    if (tid < 64) { gb[tid] = b_rg[blk * 64 + tid]; gb[64 + tid] = b_ig[blk * 64 + tid];
        const float l = lam[blk * 64 + tid]; const float sp = log1pf(expf(-l)); gb[128 + tid] = -8.0f * sp * LOG2E; carry[tid] = 0.f; }
    LDS_WAIT(); __syncthreads();
    LAS unsigned char* stg = lds + L_STG + wid * 4096;
    LAS unsigned char* xs = lds + L_XS + wid * 5120;
    for (int seg = 0; seg < 8; ++seg) {
        const int tl = seg * 256 + wid * 32;
#pragma unroll
        for (int i = 0; i < 5; ++i) { const int p = lane + 64 * i; if (p < 280) *(LAS u32x4*)(xs + (p >> 3) * XSP + (p & 7) * 16) = xr[i]; }
#pragma unroll
        for (int i = 0; i < 4; ++i) *(LAS u32x4*)(stg + (i * 8 + (lane >> 3)) * 128 + (lane & 7) * 16) = gr[i];
        if (seg < 7) RNN_LOAD(seg + 1);
        bf16x8 ua[4];
        {
#pragma unroll
          for (int ks = 0; ks < 4; ++ks) { const int ch0 = 16 * ks + 8 * hh; float a8[8];
#pragma unroll
              for (int j = 0; j < 8; ++j) a8[j] = cw[256 + ch0 + j];
#pragma unroll
              for (int tap = 0; tap < 4; ++tap) { const u32x4 xv = *(const LAS u32x4*)(xs + (n31 + tap) * XSP + ch0 * 2);
                  const LAS float* cwt = cw + tap * 64 + ch0;
                  a8[0] += cwt[0] * bflo(xv.x); a8[1] += cwt[1] * bfhi(xv.x); a8[2] += cwt[2] * bflo(xv.y); a8[3] += cwt[3] * bfhi(xv.y);
                  a8[4] += cwt[4] * bflo(xv.z); a8[5] += cwt[5] * bfhi(xv.z); a8[6] += cwt[6] * bflo(xv.w); a8[7] += cwt[7] * bfhi(xv.w); }
              u32x4 w; w.x = cvt_pk(a8[0], a8[1]); w.y = cvt_pk(a8[2], a8[3]); w.z = cvt_pk(a8[4], a8[5]); w.w = cvt_pk(a8[6], a8[7]);
              ua[ks] = __builtin_bit_cast(bf16x8, w); } }
        f32x16 C[6];
#pragma unroll
        for (int nb = 0; nb < 6; ++nb) { C[nb] = f32x16{};
#pragma unroll
            for (int ks = 0; ks < 4; ++ks) { const bf16x8 wf = *(const LAS bf16x8*)(lds + L_W + ((nb * 4 + ks) * 64 + lane) * 16);
                C[nb] = __builtin_amdgcn_mfma_f32_32x32x16_bf16(ua[ks], wf, C[nb], 0, 0, 0); } }
        f32x2 hl2[2][8], Pl2[2][8];
#define HL(cb_, r_) hl2[cb_][(r_) >> 1][(r_) & 1]
#define PL(cb_, r_) Pl2[cb_][(r_) >> 1][(r_) & 1]
#pragma unroll
        for (int cb = 0; cb < 2; ++cb) { const int n = 32 * cb + n31; const float brg = gb[n], big = gb[64 + n], cA = gb[128 + n];
            const f32x2 nl2 = (f32x2){-LOG2E, -LOG2E}, brg2 = (f32x2){-brg * LOG2E, -brg * LOG2E}, big2 = (f32x2){-big * LOG2E, -big * LOG2E}, cA2 = (f32x2){cA, cA}, one2 = (f32x2){1.f, 1.f};
#pragma unroll
            for (int q = 0; q < 8; ++q) {
                const f32x2 xg = (f32x2){C[cb][2 * q], C[cb][2 * q + 1]}, xi = (f32x2){C[2 + cb][2 * q], C[2 + cb][2 * q + 1]}, xu = (f32x2){C[4 + cb][2 * q], C[4 + cb][2 * q + 1]};
                const f32x2 tg = xg * nl2 + brg2, ti = xi * nl2 + big2;
                const f32x2 dg = (f32x2){fast_exp2(tg[0]), fast_exp2(tg[1])} + one2, di = (f32x2){fast_exp2(ti[0]), fast_exp2(ti[1])} + one2;
                const f32x2 rg = (f32x2){fast_rcp(dg[0]), fast_rcp(dg[1])}, ig = (f32x2){fast_rcp(di[0]), fast_rcp(di[1])};
                const f32x2 ta = rg * cA2; const f32x2 a = (f32x2){fast_exp2(ta[0]), fast_exp2(ta[1])};
                const f32x2 om = one2 - a * a;
                const f32x2 mult = (f32x2){__builtin_amdgcn_sqrtf(fmaxf(om[0], 0.f)), __builtin_amdgcn_sqrtf(fmaxf(om[1], 0.f))};
                Pl2[cb][q] = a; hl2[cb][q] = mult * ig * xu; }
#pragma unroll
            for (int j = 0; j < 4; ++j) {
#pragma unroll
                for (int k = 1; k < 4; ++k) { HL(cb, 4 * j + k) = PL(cb, 4 * j + k) * HL(cb, 4 * j + k - 1) + HL(cb, 4 * j + k); PL(cb, 4 * j + k) *= PL(cb, 4 * j + k - 1); } }
            float cin = 0.f, pin = 1.f, cinj[4], pinj[4];
#pragma unroll
            for (int g = 0; g < 8; ++g) { const int j = g >> 1; const bool own = (hh == (g & 1));
                if (own) { cinj[j] = cin; pinj[j] = pin; }
                const float co = PL(cb, 4 * j + 3) * cin + HL(cb, 4 * j + 3), po = pin * PL(cb, 4 * j + 3);
                float ca = co, cb2 = co, pa = po, pb = po; swap32(ca, cb2); swap32(pa, pb);
                cin = (g & 1) ? cb2 : ca; pin = (g & 1) ? pb : pa; }
#pragma unroll
            for (int j = 0; j < 4; ++j) { const f32x2 cj2 = (f32x2){cinj[j], cinj[j]}, pj2 = (f32x2){pinj[j], pinj[j]};
#pragma unroll
                for (int p = 0; p < 2; ++p) { hl2[cb][2 * j + p] += Pl2[cb][2 * j + p] * cj2; Pl2[cb][2 * j + p] *= pj2; } }
            if (hh == 0) { sum[(wid * 64 + n) * 2] = pin; sum[(wid * 64 + n) * 2 + 1] = cin; }
        }
        LDS_WAIT(); __syncthreads();
#pragma unroll
        for (int cb = 0; cb < 2; ++cb) { const int n = 32 * cb + n31; float hin = carry[n];
            { float sa[7], sb[7];
#pragma unroll
              for (int w = 0; w < 7; ++w) { const f32x2 t2 = *(const LAS f32x2*)(sum + (w * 64 + n) * 2); sa[w] = t2[0]; sb[w] = t2[1]; }
#pragma unroll
              for (int w = 0; w < 7; ++w) if (w < wid) hin = sa[w] * hin + sb[w]; }
            float hend = 0.f; const f32x2 hin2 = (f32x2){hin, hin};
#pragma unroll
            for (int q = 0; q < 8; ++q) { const f32x2 hv = hl2[cb][q] + Pl2[cb][q] * hin2; if (q == 7) hend = hv[1];
                LAS bf16_t* gp0 = (LAS bf16_t*)(stg + att::crow(2 * q, hh) * 128 + n * 2); LAS bf16_t* gp1 = (LAS bf16_t*)(stg + att::crow(2 * q + 1, hh) * 128 + n * 2);
                const f32x2 g = (f32x2){bf2f(*gp0), bf2f(*gp1)};
                const f32x2 uu = g + (f32x2){0.044715f, 0.044715f} * (g * g) * g;
                const f32x2 tt = uu * (f32x2){-1.5957691216057308f * LOG2E, -1.5957691216057308f * LOG2E};
                const f32x2 dd = (f32x2){fast_exp2(tt[0]), fast_exp2(tt[1])} + (f32x2){1.f, 1.f};
                const f32x2 ge = g * (f32x2){fast_rcp(dd[0]), fast_rcp(dd[1])};
                const f32x2 oo = hv * ge; const unsigned w2 = cvt_pk(oo[0], oo[1]);
                *gp0 = (bf16_t)(w2 & 0xFFFFu); *gp1 = (bf16_t)(w2 >> 16); }
            if (wid == 7 && hh == 1) park[n] = hend;
        }
        LDS_WAIT();
#pragma unroll
        for (int i = 0; i < 4; ++i) { const u32x4 v = *(const LAS u32x4*)(stg + (i * 8 + (lane >> 3)) * 128 + (lane & 7) * 16);
            if (do_store) *(u32x4*)(xg + ((size_t)b * SEQ + tl + i * 8 + (lane >> 3)) * QXP + 1024 + colx + (lane & 7) * 8) = v; }
        LDS_WAIT(); __syncthreads();
        if (tid < 64) carry[tid] = park[tid];
        LDS_WAIT(); __syncthreads();
    }
#undef RNN_LOAD
#undef HL
#undef PL
}
}

__device__ __forceinline__ void transpose_block(const float* W, int ldw, bf16_t* dst, int ldd, LAS float* scr, int lane) {
#pragma unroll 8
    for (int i = 0; i < 32; ++i) { const int kk = 2 * i + (lane >> 5); scr[kk * 33 + (lane & 31)] = W[(size_t)kk * ldw + (lane & 31)]; }
    LDS_WAIT(); asm volatile("" ::: "memory");
    const int c = lane & 7;
#pragma unroll
    for (int j = 0; j < 4; ++j) { const int n = (lane >> 3) + 8 * j; const LAS float* s = scr + (8 * c) * 33 + n;
        u32x4 o; o.x = pk2(s[0 * 33], s[1 * 33]); o.y = pk2(s[2 * 33], s[3 * 33]); o.z = pk2(s[4 * 33], s[5 * 33]); o.w = pk2(s[6 * 33], s[7 * 33]);
        *(u32x4*)(dst + (size_t)n * ldd + 8 * c) = o; }
    LDS_WAIT(); asm volatile("" ::: "memory");
}

struct In {
    const float *x, *c, *w_ada, *b_ada, *g_pre_mix, *g_post_mix, *g_pre_ffn, *g_post_ffn, *w_in, *b_forget, *w_conv, *b_conv, *w_rg, *b_rg, *w_ig, *b_ig, *lam,
        *w_ba, *w_br, *w_out, *w_router, *r_bias, *w_eg, *w_eu, *w_ed, *w_sg, *w_su, *w_sd;
};

struct TItem { const float* W; bf16_t* dst; int ldw, ldd; float sc; };
__device__ __forceinline__ bool dec_mat(int& r, const float* W, int K, int N, int ldw, bf16_t* dst, int ldd, TItem& t, float sc8 = 0.f) {
    const int nblk = N / 32, items = (K / 64) * nblk;
    if (r >= items) { r -= items; return false; }
    const int kb = r / nblk, nb = r % nblk;
    t.W = W + (size_t)(64 * kb) * ldw + 32 * nb; t.ldw = ldw; t.ldd = ldd; t.sc = sc8;
    t.dst = (sc8 > 0.f) ? (bf16_t*)((unsigned char*)dst + (size_t)(32 * nb) * ldd + 64 * kb) : dst + (size_t)(32 * nb) * ldd + 64 * kb; return true;
}
__device__ __forceinline__ void tb_load(const TItem& t, float (&v)[32], int lane) {
#pragma unroll
    for (int i = 0; i < 32; ++i) v[i] = t.W[(size_t)(2 * i + (lane >> 5)) * t.ldw + (lane & 31)];
}
__device__ __forceinline__ void tb_store(const TItem& t, const float (&v)[32], LAS float* scr, int lane) {
#pragma unroll
    for (int i = 0; i < 32; ++i) scr[(2 * i + (lane >> 5)) * 33 + (lane & 31)] = v[i];
    LDS_WAIT(); asm volatile("" ::: "memory");
    if (t.sc > 0.f) {
        const int c = lane & 3; unsigned char* d8 = (unsigned char*)t.dst; const float sc = t.sc;
#pragma unroll
        for (int j = 0; j < 2; ++j) { const int n = (lane >> 2) + 16 * j; const LAS float* sp = scr + (16 * c) * 33 + n; int w[4];
#pragma unroll
            for (int q = 0; q < 4; ++q) { int d = 0; d = __builtin_amdgcn_cvt_pk_fp8_f32(sp[(4 * q) * 33] * sc, sp[(4 * q + 1) * 33] * sc, d, false);
                d = __builtin_amdgcn_cvt_pk_fp8_f32(sp[(4 * q + 2) * 33] * sc, sp[(4 * q + 3) * 33] * sc, d, true); w[q] = d; }
            *(u32x4*)(d8 + (size_t)n * t.ldd + 16 * c) = (u32x4){(unsigned)w[0], (unsigned)w[1], (unsigned)w[2], (unsigned)w[3]}; }
    } else {
        const int c = lane & 7;
#pragma unroll
        for (int j = 0; j < 4; ++j) { const int n = (lane >> 3) + 8 * j; const LAS float* sp = scr + (8 * c) * 33 + n;
            u32x4 o; o.x = cvt_pk(sp[0 * 33], sp[1 * 33]); o.y = cvt_pk(sp[2 * 33], sp[3 * 33]); o.z = cvt_pk(sp[4 * 33], sp[5 * 33]); o.w = cvt_pk(sp[6 * 33], sp[7 * 33]);
            *(u32x4*)(t.dst + (size_t)n * t.ldd + 8 * c) = o; }
    }
    LDS_WAIT(); asm volatile("" ::: "memory");
}

__device__ __forceinline__ void p0_prologue(const In& in, unsigned char* ws, LAS unsigned char* lds, int vcu, int G) {
    const int tid = threadIdx.x, lane = tid & 63; const int wave = __builtin_amdgcn_readfirstlane(tid >> 6);
    bf16_t* WIN = (bf16_t*)(ws + WS_WIN); bf16_t* WBA = (bf16_t*)(ws + WS_WBA); bf16_t* WOUT = (bf16_t*)(ws + WS_WOUT);
    bf16_t* WROUT = (bf16_t*)(ws + WS_WROUT); unsigned char* WGU = ws + WS_WGU; unsigned char* WDN = ws + WS_WDN;
    if (vcu < 192) {
        LAS float* s = (LAS float*)lds;
        const int kq = tid >> 5, col = tid & 31, col0 = vcu * 32;
        float w[16][4];
#pragma unroll
        for (int k4 = 0; k4 < 16; ++k4)
#pragma unroll
            for (int e = 0; e < 4; ++e) w[k4][e] = in.w_ada[(size_t)(64 * kq + 4 * k4 + e) * 6144 + col0 + col];
        { f32x4 cv[16];
#pragma unroll
          for (int j = 0; j < 16; ++j) cv[j] = *(const f32x4*)(in.c + 4 * (tid + 512 * j));
#pragma unroll
          for (int j = 0; j < 16; ++j) { f32x4 o; o[0] = cv[j][0] * sigmoidf_(cv[j][0]); o[1] = cv[j][1] * sigmoidf_(cv[j][1]); o[2] = cv[j][2] * sigmoidf_(cv[j][2]); o[3] = cv[j][3] * sigmoidf_(cv[j][3]);
              *(LAS f32x4*)(s + 4 * (tid + 512 * j)) = o; } }
        LDS_WAIT(); __syncthreads();
        float acc[32];
#pragma unroll
        for (int bb = 0; bb < 32; ++bb) acc[bb] = 0.f;
#pragma unroll
        for (int k4 = 0; k4 < 16; ++k4) { const int k = 64 * kq + 4 * k4;
#pragma unroll
            for (int bb = 0; bb < 32; ++bb) { const f32x4 sv = *(const LAS f32x4*)(s + bb * 1024 + k); acc[bb] += (sv[0] * w[k4][0] + sv[1] * w[k4][1]) + (sv[2] * w[k4][2] + sv[3] * w[k4][3]); } }
        __syncthreads();
        LAS float* red = (LAS float*)lds;
#pragma unroll
        for (int bb = 0; bb < 32; ++bb) red[(kq * 32 + bb) * 32 + col] = acc[bb];
        LDS_WAIT(); __syncthreads();
        float* mod = (float*)(ws + WS_MOD);
        for (int o = tid; o < 1024; o += 512) { const int bb = o >> 5, cc = o & 31; float v = in.b_ada[col0 + cc];
#pragma unroll
            for (int q = 0; q < 16; ++q) v += red[(q * 32 + bb) * 32 + cc];
            mod[(size_t)bb * 6144 + col0 + cc] = v; }
        __syncthreads();
    }
    { const int gt = vcu * 512 + tid, GT = G * 512;
      float* WF = (float*)(ws + WS_WF);
      for (int i = gt; i < 8 * 1024; i += GT) { const int hd = i >> 10, k = i & 1023; WF[i] = in.w_in[(size_t)k * INCOLS + 1536 + hd]; }
      bf16_t* WR = (bf16_t*)(ws + WS_WRNN);
      for (int i = gt; i < 16 * 6 * 4 * 64 * 8; i += GT) { const int jj = i & 7, ln = (i >> 3) & 63, ks = (i >> 9) & 3, nbk = (i >> 11); const int nb = nbk % 6, blk = nbk / 6;
          const int c = 16 * ks + 8 * (ln >> 5) + jj, n = 32 * nb + (ln & 31); float v;
          if (n < 64) v = in.w_rg[((size_t)blk * 64 + c) * 64 + n]; else if (n < 128) v = in.w_ig[((size_t)blk * 64 + c) * 64 + (n - 64)]; else v = (c == n - 128) ? 1.f : 0.f;
          WR[i] = (bf16_t)f2bf(v); } }
    LAS float* scr = (LAS float*)(lds + wave * 16384);
    const int gw = vcu * NWAVES + wave, NGW = G * NWAVES;
    constexpr int I_EXP = (1024 / 64) * (256 / 32);
    constexpr int NITEMS = 768 + 2048 + 256 + 512 + 512 + 32 + 3 * 65 * I_EXP;
    auto decode = [&](int it, TItem& t) {
        int r = it;
        if (dec_mat(r, in.w_in, 1024, 1536, INCOLS, WIN, 1024, t, 32.f)) return;
        if (dec_mat(r, in.w_in + 1544, 1024, 4096, INCOLS, (bf16_t*)((unsigned char*)WIN + (size_t)1536 * 1024), 1024, t, 32.f)) return;
        if (dec_mat(r, in.w_ba, 512, 1024, 1024, WBA, 1536, t)) return;
        if (dec_mat(r, in.w_br, 1024, 1024, 1024, WBA + 512, 1536, t)) return;
        if (dec_mat(r, in.w_out, 1024, 1024, 1024, WOUT, 1024, t)) return;
        if (dec_mat(r, in.w_router, 1024, 64, 64, WROUT, 1024, t)) return;
        const int kind = r / (65 * I_EXP), rr = r % (65 * I_EXP), e = rr / I_EXP, ii = rr % I_EXP;
        if (kind < 2) {
            const float* W = (e < 64) ? ((kind == 0 ? in.w_eg : in.w_eu) + (size_t)e * 1024 * 256) : (kind == 0 ? in.w_sg : in.w_su);
            const int kb = ii / 8, nb = ii % 8, n0 = 32 * nb;
            t.W = W + (size_t)(64 * kb) * 256 + n0; t.ldw = 256; t.dst = (bf16_t*)(WGU + ((size_t)e * 512 + (n0 >> 7) * 256 + kind * 128 + (n0 & 127)) * 1024 + 64 * kb); t.ldd = 1024; t.sc = 32.f;
        } else {
            const float* W = (e < 64) ? (in.w_ed + (size_t)e * 256 * 1024) : in.w_sd;
            const int kb = ii / 32, nb = ii % 32;
            t.W = W + (size_t)(64 * kb) * 1024 + 32 * nb; t.ldw = 1024; t.dst = (bf16_t*)(WDN + ((size_t)e * 1024 + 32 * nb) * 256 + 64 * kb); t.ldd = 256; t.sc = 16.f;
        }
    };
    { TItem ta, tb; float va[32], vb[32];
      bool hb = (gw + NGW) < NITEMS;
      if (gw < NITEMS) { decode(gw, ta); tb_load(ta, va, lane); }
      if (hb) { decode(gw + NGW, tb); tb_load(tb, vb, lane); }
      for (int it = gw; it < NITEMS; it += 2 * NGW) {
          tb_store(ta, va, scr, lane);
          const bool hna = (it + 2 * NGW) < NITEMS; TItem tna = ta; if (hna) { decode(it + 2 * NGW, tna); tb_load(tna, va, lane); }
          if (hb) tb_store(tb, vb, scr, lane);
          const bool hnb = (it + 3 * NGW) < NITEMS; TItem tnb = tb; if (hnb) { decode(it + 3 * NGW, tnb); tb_load(tnb, vb, lane); }
          ta = tna; tb = tnb; hb = hnb; } }
}

__device__ __forceinline__ void p1_norm(int tile, const In& in, unsigned char* ws, LAS unsigned char* lds) {
    const int tid = threadIdx.x, lane = tid & 63; const int wave = __builtin_amdgcn_readfirstlane(tid >> 6);
    const int b = tile >> 3;
    LAS float* lc = (LAS float*)(lds + 32768);
    LAS float* wtot = (LAS float*)(lds + 40960);
    const float* WF = (const float*)(ws + WS_WF); const float* mod = (const float*)(ws + WS_MOD) + (size_t)b * 6144;
    __syncthreads();
    constexpr int NHR = 5;
    LAS float* wf = (LAS float*)lds;
    for (int i = tid; i < 2048; i += 512) *(LAS f32x4*)(wf + 4 * i) = *(const f32x4*)(WF + 4 * i);
    f32x4 wfr[NHR][4];
#pragma unroll
    for (int hd = 0; hd < NHR; ++hd)
#pragma unroll
        for (int j = 0; j < 4; ++j) wfr[hd][j] = *(const f32x4*)(WF + hd * 1024 + 4 * lane + 256 * j);
    f32x4 A[4], B[4];
#pragma unroll
    for (int j = 0; j < 4; ++j) { const int col = 4 * lane + 256 * j; const f32x4 g = *(const f32x4*)(in.g_pre_mix + col), sc = *(const f32x4*)(mod + 1024 + col); A[j] = g * (sc + 1.0f); B[j] = *(const f32x4*)(mod + col); }
    const int hdl = lane >> 3;
    const float bfg = in.b_forget[hdl];
    const bool b5 = (lane & 32) != 0, b4 = (lane & 16) != 0, b3 = (lane & 8) != 0;
    LDS_WAIT(); __syncthreads();
    unsigned char* H8 = ws + R_H;
    const int rot = (tile * 5) & 31;
    f32x4 nv[4];
#pragma unroll
    for (int j = 0; j < 4; ++j) nv[j] = *(const f32x4*)(in.x + ((size_t)tile * 256 + ((rot & 31) << 3) + wave) * 1024 + 4 * lane + 256 * j);
    for (int i = 0; i < 32; ++i) { const int tl = (((i + rot) & 31) << 3) + wave; const size_t tok = (size_t)tile * 256 + tl;
        f32x4 v[4]; float ss = 0.f;
#pragma unroll
        for (int j = 0; j < 4; ++j) v[j] = nv[j];
        { const size_t ntok = (size_t)tile * 256 + (((i + 1 + rot) & 31) << 3) + wave;
#pragma unroll
          for (int j = 0; j < 4; ++j) nv[j] = *(const f32x4*)(in.x + ntok * 1024 + 4 * lane + 256 * j); }
#pragma unroll
        for (int j = 0; j < 4; ++j) ss += (v[j][0] * v[j][0] + v[j][1] * v[j][1]) + (v[j][2] * v[j][2] + v[j][3] * v[j][3]);
        const float rstd = fast_rsq(wave_sum(ss) * (1.0f / 1024.0f) + NORM_EPS);
#pragma unroll
        for (int j = 0; j < 4; ++j) { v[j] = v[j] * rstd * A[j] + B[j];
            int d = 0; d = __builtin_amdgcn_cvt_pk_fp8_f32(v[j][0], v[j][1], d, false); d = __builtin_amdgcn_cvt_pk_fp8_f32(v[j][2], v[j][3], d, true); *(unsigned*)(H8 + tok * 1024 + 4 * lane + 256 * j) = (unsigned)d; }
        float p[8];
#pragma unroll
        for (int hd = 0; hd < 8; ++hd) { f32x2 a2 = (f32x2){0.f, 0.f};
#pragma unroll
            for (int j = 0; j < 4; ++j) { f32x4 w4; if (hd < NHR) w4 = wfr[hd < NHR ? hd : 0][j]; else w4 = *(const LAS f32x4*)(wf + hd * 1024 + 4 * lane + 256 * j);
                a2 += v[j].lo * w4.lo; a2 += v[j].hi * w4.hi; }
            p[hd] = a2[0] + a2[1]; }
        float q[4], r2[2];
#pragma unroll
        for (int j = 0; j < 4; ++j) { float X = p[j], Y = p[j + 4]; swap32(X, Y); q[j] = X + Y; }
#pragma unroll
        for (int j = 0; j < 2; ++j) { float X = q[j], Y = q[j + 2]; swap16(X, Y); r2[j] = X + Y; }
        float f; { const float send = b3 ? r2[0] : r2[1], keep = b3 ? r2[1] : r2[0]; f = keep + dpp_f<0x128, 0xF>(send); }
        f = sum8(f);
        f += bfg;
        const float ls = -fast_log2(1.0f + fast_exp2(-f * LOG2E));
        if ((lane & 7) == 0) lc[tl * 8 + hdl] = ls;
    }
    LDS_WAIT(); __syncthreads();
    if (tid < 64) { const int hd = tid & 7, sg = tid >> 3; float r = 0.f;
        float pv[32];
#pragma unroll
        for (int k = 0; k < 32; ++k) pv[k] = lc[(sg * 32 + k) * 8 + hd];
#pragma unroll
        for (int k = 0; k < 32; ++k) { r += pv[k]; lc[(sg * 32 + k) * 8 + hd] = r; }
        wtot[sg * 8 + hd] = r; }
    LDS_WAIT(); __syncthreads();
    float* LC = (float*)(ws + WS_LCUM); float* TOT = (float*)(ws + WS_TOT);
    for (int i = tid; i < 2048; i += 512) { const int tk = i >> 3, hd = i & 7; float off = 0.f; const int w = tk >> 5;
#pragma unroll
        for (int q = 0; q < 7; ++q) { const float wq = wtot[q * 8 + hd]; off += (q < w) ? wq : 0.f; }
        LC[((size_t)tile * 256 + tk) * 8 + hd] = lc[i] + off; }
    if (tid < 8) { float t = 0.f;
#pragma unroll
        for (int q = 0; q < 8; ++q) t += wtot[q * 8 + tid];
        TOT[tile * 8 + tid] = t; }
}

namespace p6 {
constexpr int HP = 2064;
constexpr int L_H2 = 0, L_PART = 66560, L_HIST = 99328;
__device__ __forceinline__ void run(int tile, const In& in, float* out, unsigned char* ws, LAS unsigned char* lds, bool do_store = true) {
    const int tid = threadIdx.x, lane = tid & 63, n31 = lane & 31, hh = lane >> 5; const int wave = __builtin_amdgcn_readfirstlane(tid >> 6);
    const int b = tile >> 3;
    const float* mod = (const float*)(ws + WS_MOD) + (size_t)b * 6144;
    bf16_t* H = (bf16_t*)(ws + R_H); unsigned char* H8 = ws + R_H8; const float* SSQ = (const float*)(ws + WS_SSQ); const bf16_t* WROUT = (const bf16_t*)(ws + WS_WROUT);
    int* EP = (int*)(ws + WS_EP); float* EW = (float*)(ws + WS_EW); int* HIST = (int*)(ws + WS_HIST);
    LAS float* part = (LAS float*)(lds + L_PART); LAS int* histl = (LAS int*)(lds + L_HIST);
    f32x4 G1[4], A2[4], B2[4];
#pragma unroll
    for (int j = 0; j < 4; ++j) { const int col = 4 * lane + 256 * j;
        G1[j] = *(const f32x4*)(mod + 2048 + col) * *(const f32x4*)(in.g_post_mix + col);
        A2[j] = *(const f32x4*)(in.g_pre_ffn + col) * (*(const f32x4*)(mod + 4096 + col) + 1.0f);
        B2[j] = *(const f32x4*)(mod + 3072 + col); }
    const int kq = wave >> 1, nb = wave & 1;
    bf16x8 wr[16];
#pragma unroll
    for (int ks = 0; ks < 16; ++ks) wr[ks] = *(const bf16x8*)(WROUT + (size_t)(32 * nb + n31) * 1024 + 256 * kq + 16 * ks + 8 * hh);
    const float rbias = in.r_bias[lane];
    __syncthreads();
    if (tid < 64) histl[tid] = 0;
    LDS_WAIT(); __syncthreads();
    u32x2 nmv[4]; f32x4 nxv[4]; float nsq;
#define P6_LOAD(n_) do { const size_t tk_ = (size_t)tile * 256 + ((((n_) >> 2) + tile) & 7) * 32 + wave * 4 + ((n_) & 3); \
        _Pragma("unroll") for (int j = 0; j < 4; ++j) { nmv[j] = *(const u32x2*)(H + tk_ * 1024 + 4 * lane + 256 * j); nxv[j] = *(const f32x4*)(in.x + tk_ * 1024 + 4 * lane + 256 * j); } \
        nsq = SSQ[tk_ * 16 + (lane & 15)]; } while (0)
    P6_LOAD(0);
    for (int sub0 = 0; sub0 < 8; ++sub0) { const int sub = (sub0 + tile) & 7;
#pragma unroll
        for (int i = 0; i < 4; ++i) { const int tl = wave * 4 + i; const size_t tok = (size_t)tile * 256 + sub * 32 + tl;
            u32x2 mv[4]; f32x4 xv[4];
#pragma unroll
            for (int j = 0; j < 4; ++j) { mv[j] = nmv[j]; xv[j] = nxv[j]; }
            const float sq = nsq;
            { const int nn = sub0 * 4 + i + 1; P6_LOAD(nn < 32 ? nn : 31); }
            const float s1 = wave_sum(lane < 16 ? sq : 0.f);
            const float rstd1 = fast_rsq(s1 * (1.0f / 1024.0f) + NORM_EPS);
            float ss = 0.f;
#pragma unroll
            for (int j = 0; j < 4; ++j) { f32x4 m; m[0] = bflo(mv[j].x); m[1] = bfhi(mv[j].x); m[2] = bflo(mv[j].y); m[3] = bfhi(mv[j].y);
                xv[j] = xv[j] + G1[j] * (m * rstd1);
                if (do_store) { u32x2 w1; w1.x = cvt_pk(xv[j][0], xv[j][1]); w1.y = cvt_pk(xv[j][2], xv[j][3]); *(u32x2*)(H + tok * 1024 + 4 * lane + 256 * j) = w1; }
                ss += (xv[j][0] * xv[j][0] + xv[j][1] * xv[j][1]) + (xv[j][2] * xv[j][2] + xv[j][3] * xv[j][3]); }
            const float rstd2 = fast_rsq(wave_sum(ss) * (1.0f / 1024.0f) + NORM_EPS);
#pragma unroll
            for (int j = 0; j < 4; ++j) { const f32x4 hv = xv[j] * rstd2 * A2[j] + B2[j];
                u32x2 w; w.x = cvt_pk(hv[0], hv[1]); w.y = cvt_pk(hv[2], hv[3]);
                if (do_store) { int d = 0; d = __builtin_amdgcn_cvt_pk_fp8_f32(hv[0], hv[1], d, false); d = __builtin_amdgcn_cvt_pk_fp8_f32(hv[2], hv[3], d, true);
                    *(unsigned*)(H8 + tok * 1024 + 4 * lane + 256 * j) = (unsigned)d; }
                *(LAS u32x2*)(lds + L_H2 + tl * HP + (4 * lane + 256 * j) * 2) = w; }
        }
        LDS_WAIT(); __syncthreads();
        { f32x16 acc = f32x16{};
#pragma unroll
          for (int ks = 0; ks < 16; ++ks) { const bf16x8 a = *(const LAS bf16x8*)(lds + L_H2 + n31 * HP + (256 * kq + 16 * ks + 8 * hh) * 2);
              acc = __builtin_amdgcn_mfma_f32_32x32x16_bf16(a, wr[ks], acc, 0, 0, 0); }
#pragma unroll
          for (int r = 0; r < 16; ++r) part[(kq * 32 + att::crow(r, hh)) * 64 + 32 * nb + n31] = acc[r]; }
        LDS_WAIT(); __syncthreads();
        for (int i = 0; i < 4; ++i) { const int tl = wave * 4 + i; const size_t tok = (size_t)tile * 256 + sub * 32 + tl;
            const float logit = (part[(0 * 32 + tl) * 64 + lane] + part[(1 * 32 + tl) * 64 + lane]) + (part[(2 * 32 + tl) * 64 + lane] + part[(3 * 32 + tl) * 64 + lane]);
            const float score = sigmoidf_(logit); const float sel = score + rbias;
            const float m1 = max8(sel); const float cand = (sel == m1) ? (float)(lane & 7) : 8.f; const float imin = -max8(-cand);
            const float m2 = max8(((float)(lane & 7) == imin) ? -INFINITY : sel);
            const float gs = m1 + m2;
            int gr = 0; const int g = lane >> 3;
#pragma unroll
            for (int j = 0; j < 8; ++j) { const float o = __builtin_bit_cast(float, __builtin_amdgcn_readlane(__builtin_bit_cast(int, gs), j * 8)); gr += (o > gs || (o == gs && j < g)) ? 1 : 0; }
            const bool gsel = gr < 4; const float msel = gsel ? sel : -INFINITY;
            int rk = 64; float vsel = msel;
#pragma unroll
            for (int it6 = 0; it6 < 6; ++it6) { const float mx = wave_max(vsel); const unsigned long long eq = __ballot(vsel == mx); const int win = __builtin_ctzll(eq);
                if (lane == win) { rk = it6; vsel = -INFINITY; } }
            const bool chosen = rk < 6;
            const float wsum = wave_sum(chosen ? score : 0.f);
            if (chosen) { const int li = __hip_atomic_fetch_add(histl + lane, 1, __ATOMIC_RELAXED, __HIP_MEMORY_SCOPE_WORKGROUP);
                if (do_store) { EP[tok * 6 + rk] = lane | (li << 8); EW[tok * 6 + rk] = score / wsum * 2.5f; } }
        }
    }
    LDS_WAIT(); __syncthreads();
    if (tid < 64 && do_store) HIST[tile * 64 + tid] = histl[tid];
}
}

__device__ __forceinline__ void p7_place(int tile, unsigned char* ws, LAS unsigned char* lds) {
    const int tid = threadIdx.x;
    LAS int* cntb = (LAS int*)lds; LAS int* tot = cntb + 64; LAS int* base = cntb + 128; LAS int* tst = cntb + 192;
    const int* HIST = (const int*)(ws + WS_HIST); const int* EP = (const int*)(ws + WS_EP); int* POS = (int*)(ws + WS_POS);
    int* SLOTTOK = (int*)(ws + WS_SLOTTOK); int* RTAB = (int*)(ws + WS_RTAB);
    __syncthreads();
    { LAS int* pc = cntb + 320; LAS int* pt = pc + 512;
      const int e = tid & 63, part = tid >> 6; int cb = 0, tt = 0;
#pragma unroll 16
      for (int i = part * 32; i < part * 32 + 32; ++i) { const int v = HIST[i * 64 + e]; tt += v; if (i < tile) cb += v; }
      pc[tid] = cb; pt[tid] = tt;
      LDS_WAIT(); __syncthreads();
      if (tid < 64) { int a = 0, b2 = 0;
#pragma unroll
          for (int q = 0; q < 8; ++q) { a += pc[q * 64 + tid]; b2 += pt[q * 64 + tid]; }
          cntb[tid] = a; tot[tid] = b2; } }
    LDS_WAIT(); __syncthreads();
    if (tid < 64) { const int nt_e = (tot[tid] + 255) >> 8; int inc = nt_e;
#pragma unroll
        for (int o = 1; o < 64; o <<= 1) { const int up = __shfl_up(inc, o); if (tid >= o) inc += up; }
        tst[tid] = inc - nt_e; if (tid == 63) tst[64] = inc; }
    LDS_WAIT(); __syncthreads();
    if (tid < 64) base[tid] = tst[tid] * 256 + cntb[tid];
    if (tile == 0) { if (tid < 65) RTAB[tid] = tst[tid]; if (tid < 64) RTAB[128 + tid] = tot[tid]; }
    LDS_WAIT(); __syncthreads();
    for (int p = tid; p < 1536; p += 512) { const int token = tile * 256 + p / 6; const int ep = EP[(size_t)tile * 1536 + p]; const int e = ep & 255, li = ep >> 8;
        const int slot = base[e] + li; POS[(size_t)tile * 1536 + p] = slot; SLOTTOK[slot] = token; }
}

__device__ __forceinline__ void combine_all(const In& in, float* out, unsigned char* ws, int gw, int NGW, bool do_store = true) {
    const int lane = threadIdx.x & 63;
    const unsigned char* Y = (const unsigned char*)(ws + R_Y); const int* POS = (const int*)(ws + WS_POS); const float* EW = (const float*)(ws + WS_EW);
    const bf16_t* X1 = (const bf16_t*)(ws + R_H);
    const int per = (T + NGW - 1) / NGW, i0 = gw * per, i1 = (i0 + per < T) ? i0 + per : T;
    if (i0 >= T) return;
    int nslot = 0; float nw = 1.0f;
#define CMB_SLOTS(ix) do { nslot = 0; nw = 1.0f; if ((ix) < i1) { if (lane < 6) { nslot = POS[(size_t)(ix) * 6 + lane]; nw = EW[(size_t)(ix) * 6 + lane]; } if (lane == 6) nslot = (RT_MAX + ((ix) >> 8)) * 256 + ((ix) & 255); } } while (0)
    u32x2 ny[7][2]; u32x4 nx[2];
#define CMB_ROWS(ix) do { _Pragma("unroll") for (int k = 0; k < 7; ++k) { const int sl = __builtin_amdgcn_readlane(nslot, k); \
            _Pragma("unroll") for (int j = 0; j < 2; ++j) ny[k][j] = *(const u32x2*)(Y + (size_t)sl * 1024 + 8 * lane + 512 * j); } \
        _Pragma("unroll") for (int j = 0; j < 2; ++j) nx[j] = *(const u32x4*)(X1 + (size_t)(ix) * 1024 + 8 * lane + 512 * j); } while (0)
    CMB_SLOTS(i0); CMB_ROWS(i0);
    float cw = nw;
    CMB_SLOTS(i0 + 1);
    f32x4 gfr[2][2]; int bcur = -1;
    for (int idx = i0; idx < i1; ++idx) { const size_t tok = (size_t)idx; const int b = (int)(tok >> 11);
        if (b != bcur) { bcur = b; const float* mod = (const float*)(ws + WS_MOD) + (size_t)b * 6144;
#pragma unroll
            for (int j = 0; j < 2; ++j)
#pragma unroll
                for (int hq = 0; hq < 2; ++hq) { const int col = 8 * lane + 512 * j + 4 * hq; gfr[j][hq] = *(const f32x4*)(mod + 5120 + col) * *(const f32x4*)(in.g_post_ffn + col); } }
        u32x2 cy[7][2]; u32x4 cx[2]; const float w = cw;
#pragma unroll
        for (int k = 0; k < 7; ++k) { cy[k][0] = ny[k][0]; cy[k][1] = ny[k][1]; }
        cx[0] = nx[0]; cx[1] = nx[1];
        if (idx + 1 < i1) { CMB_ROWS(idx + 1); cw = nw; CMB_SLOTS(idx + 2); }
        f32x2 a2[2][4];
#pragma unroll
        for (int j = 0; j < 2; ++j)
#pragma unroll
            for (int e = 0; e < 4; ++e) a2[j][e] = (f32x2){0.f, 0.f};
#pragma unroll
        for (int k = 0; k < 7; ++k) { const float wk = __builtin_bit_cast(float, __builtin_amdgcn_readlane(__builtin_bit_cast(int, w), k)); const f32x2 wk2 = (f32x2){wk, wk};
#pragma unroll
            for (int j = 0; j < 2; ++j) { const u32x2 v = cy[k][j];
                a2[j][0] += wk2 * __builtin_amdgcn_cvt_pk_f32_fp8((int)v.x, false); a2[j][1] += wk2 * __builtin_amdgcn_cvt_pk_f32_fp8((int)v.x, true);
                a2[j][2] += wk2 * __builtin_amdgcn_cvt_pk_f32_fp8((int)v.y, false); a2[j][3] += wk2 * __builtin_amdgcn_cvt_pk_f32_fp8((int)v.y, true); } }
        float a[2][8]; f32x2 ss2 = (f32x2){0.f, 0.f};
#pragma unroll
        for (int j = 0; j < 2; ++j)
#pragma unroll
            for (int e = 0; e < 4; ++e) { a[j][2 * e] = a2[j][e][0]; a[j][2 * e + 1] = a2[j][e][1]; ss2 += a2[j][e] * a2[j][e]; }
        float ss = ss2[0] + ss2[1];
        const float rstd = fast_rsq(wave_sum(ss) * (1.0f / 1024.0f) + NORM_EPS);
#pragma unroll
        for (int j = 0; j < 2; ++j)
#pragma unroll
            for (int hq = 0; hq < 2; ++hq) { const int col = 8 * lane + 512 * j + 4 * hq;
                const f32x4 gf = gfr[j][hq];
                const unsigned xa = hq ? cx[j].z : cx[j].x, xb2 = hq ? cx[j].w : cx[j].y;
                f32x4 x1 = (f32x4){bflo(xa), bfhi(xa), bflo(xb2), bfhi(xb2)};
                const f32x4 av = (f32x4){a[j][4 * hq], a[j][4 * hq + 1], a[j][4 * hq + 2], a[j][4 * hq + 3]};
                x1 = x1 + gf * (av * rstd);
                if (do_store) *(f32x4*)(out + tok * 1024 + col) = x1; }
    }
#undef CMB_SLOTS
#undef CMB_ROWS
}

#define XB_TMO      128
#define XB_XCNT(j)  (256  + 64 * (j))
#define XB_XSUB(j)  (1280 + 64 * (j))
#define XB_XGEN(j)  (2304 + 64 * (j))
#define XB_TOP      3328
#define XB_TOPGEN   3392
#define XCD_BAR_WORDS 3456
#define XB_SPIN_CAP (1u << 18)
__device__ __forceinline__ unsigned xb_ld(unsigned* p)              { return __hip_atomic_load(p, __ATOMIC_RELAXED, __HIP_MEMORY_SCOPE_AGENT); }
__device__ __forceinline__ unsigned xb_add(unsigned* p, unsigned v) { return __hip_atomic_fetch_add(p, v, __ATOMIC_RELAXED, __HIP_MEMORY_SCOPE_AGENT); }
__device__ __forceinline__ unsigned xb_xcc_id() { return (unsigned)__builtin_amdgcn_s_getreg((3 << 11) | 20) & 0xFu; }
#define XB_SPIN(cond, bar) do { unsigned _sp = 0; while (cond) { __builtin_amdgcn_s_sleep(1); \
    if ((++_sp & 255u) == 0u) { if (xb_ld(&(bar)[XB_TMO])) break; if (_sp > XB_SPIN_CAP) { atomicAdd(&(bar)[XB_TMO], 1u); break; } } } } while (0)
struct XcdBarrier { unsigned* bar; unsigned x; volatile LAS unsigned* st; };
__device__ __forceinline__ XcdBarrier xcd_barrier_post(unsigned* bar, volatile LAS unsigned* st) {
    XcdBarrier b; b.bar = bar; b.x = xb_xcc_id(); b.st = st;
    if (threadIdx.x == 0) (void)xb_add(&bar[XB_XCNT(b.x)], 1u);
    return b;
}
__device__ __forceinline__ void xcd_barrier_complete(unsigned* bar, unsigned x, unsigned& nloc, unsigned& nx) {
    const unsigned G = gridDim.x * gridDim.y * gridDim.z;
    unsigned sum, cnt, mine, sp = 0u;
    for (;;) {
        sum = 0u; cnt = 0u; mine = 0u;
#pragma unroll
        for (unsigned j = 0; j < 16; ++j) { const unsigned c = xb_ld(&bar[XB_XCNT(j)]); sum += c; cnt += (c > 0u) ? 1u : 0u; mine = (j == x) ? c : mine; }
        if (sum == G) break;
        __builtin_amdgcn_s_sleep(1);
        if ((++sp & 255u) == 0u) { if (xb_ld(&bar[XB_TMO])) break; if (sp > XB_SPIN_CAP) { atomicAdd(&bar[XB_TMO], 1u); break; } }
    }
    nloc = mine > 0u ? mine : 1u; nx = cnt > 0u ? cnt : 1u;
}
__device__ __forceinline__ void xcd_barrier(const XcdBarrier& b) {
    asm volatile("s_waitcnt vmcnt(0)" ::: "memory");
    __syncthreads();
    if (threadIdx.x == 0) {
        unsigned* bar = b.bar;
        __builtin_amdgcn_s_waitcnt(0);
        unsigned nloc = b.st[0], nx = b.st[1];
        if (nloc == 0u) { xcd_barrier_complete(bar, b.x, nloc, nx); b.st[0] = nloc; b.st[1] = nx; }
        const unsigned old = xb_add(&bar[XB_XSUB(b.x)], 1u);
        const unsigned gen = old / nloc;
        if (old + 1u == (gen + 1u) * nloc) {
            __builtin_amdgcn_fence(__ATOMIC_RELEASE, "agent");
            asm volatile("s_waitcnt vmcnt(0)" ::: "memory");
            const unsigned og = xb_add(&bar[XB_TOP], 1u);
            const unsigned tg = og / nx;
            if (og + 1u == (tg + 1u) * nx) xb_add(&bar[XB_TOPGEN], 1u);
            else XB_SPIN(xb_ld(&bar[XB_TOPGEN]) == tg, bar);
            __builtin_amdgcn_fence(__ATOMIC_ACQUIRE, "agent");
            xb_add(&bar[XB_XGEN(b.x)], 1u);
            asm volatile("s_waitcnt vmcnt(0)" ::: "memory");
        } else {
            XB_SPIN(xb_ld(&bar[XB_XGEN(b.x)]) == gen, bar);
            __builtin_amdgcn_fence(__ATOMIC_ACQUIRE, "agent");
            asm volatile("s_waitcnt vmcnt(0)" ::: "memory");
        }
    }
    __syncthreads();
}

__device__ __forceinline__ void moe_load_tab(unsigned char* ws, LAS int* tab, int vcu, int G, int lg) {
    const int* RTAB = (const int*)(ws + WS_RTAB);
    __syncthreads();
    if (threadIdx.x < 65) tab[threadIdx.x] = RTAB[threadIdx.x];
    if (threadIdx.x < 64) tab[128 + threadIdx.x] = RTAB[128 + threadIdx.x];
    LDS_WAIT(); __syncthreads();
    if (threadIdx.x < 32) { const int ri = ((int)threadIdx.x * G + vcu) >> lg; int e = 0;
#pragma unroll 8
        for (int j = 1; j <= 64; ++j) e += (tab[j] <= ri) ? 1 : 0;
        tab[192 + threadIdx.x] = e; }
    LDS_WAIT(); __syncthreads();
}
__device__ __forceinline__ void moe_gateup(unsigned char* ws, LAS unsigned char* lds, int vcu, int G) {
    LAS int* tok = (LAS int*)(lds + TOK_OFF); LAS int* tab = (LAS int*)(lds + TAB_OFF);
    moe_load_tab(ws, tab, vcu, G, 1);
    const int NT = tab[64], U = 2 * (NT + SH_TILES);
    MoeSched S; S.tab = tab; S.NT = NT; S.U = U; S.G = G; S.vcu = vcu; S.npn = 2; S.lg = 1; S.A = (const char*)(ws + R_H8); S.B = (const char*)(ws + WS_WGU);
    S.atile = 0; S.btile_e = (size_t)512 * 1024; S.btile_n = (size_t)256 * 1024;
    const int* SLOTTOK = (const int*)(ws + WS_SLOTTOK);
    { const int wv = threadIdx.x >> 6, ln = threadIdx.x & 63;
#pragma unroll
      for (int k = 0; k < 2; ++k) { const int i = wv + 8 * k; pg8::Unit u;
          if (S.next(i, u)) {
              int tk[4];
#pragma unroll
              for (int q = 0; q < 4; ++q) { const int row = ln + 64 * q;
                  if (u.aux) { const int valid = tab[128 + u.e] - (u.pm - tab[u.e]) * 256; tk[q] = (row < valid) ? SLOTTOK[u.pm * 256 + row] : 0; }
                  else tk[q] = (u.pm - RT_MAX) * 256 + row; }
#pragma unroll
              for (int q = 0; q < 4; ++q) tok[i * 256 + ln + 64 * q] = tk[q]; } } }
    LDS_WAIT(); __syncthreads();
    EpiGateUp E{(unsigned char*)(ws + R_ACT)};
    int Kg = 512; asm volatile("" : "+s"(Kg));
    pg8::gemm_phase<EpiGateUp, MoeSched, true>(lds, Kg, 512, 512, S, E, tok);
}
__device__ __forceinline__ void moe_down(unsigned char* ws, LAS unsigned char* lds, int vcu, int G, bool st = true) {
    LAS int* tab = (LAS int*)(lds + TAB_OFF);
    moe_load_tab(ws, tab, vcu, G, 2);
    const int NT = tab[64], U = 4 * (NT + SH_TILES);
    MoeSched S; S.tab = tab; S.NT = NT; S.U = U; S.G = G; S.vcu = vcu; S.npn = 4; S.lg = 2; S.A = (const char*)(ws + R_ACT); S.B = (const char*)(ws + WS_WDN);
    S.atile = (size_t)256 * 256; S.btile_e = (size_t)1024 * 256; S.btile_n = (size_t)256 * 256;
    EpiDown E{(unsigned char*)(ws + R_Y), st};
    int Kd = 128; asm volatile("" : "+s"(Kd));
    pg8::gemm_phase<EpiDown, MoeSched, false>(lds, Kd, 128, 128, S, E, nullptr);
}

enum { PH_PRO = 0, PH_NORM1, PH_INPROJ, PH_MIX, PH_BRANCH, PH_OUT, PH_TOK2, PH_PLACE, PH_GU, PH_DN, PH_CMB, NPHASE };
struct Args { const float* in[28]; float* out; unsigned char* ws; int ph_lo, ph_hi, li, pad; };

__global__ void __launch_bounds__(NWAVES * 64, 2) hybrid_fwd(Args args) {
    extern __shared__ __attribute__((aligned(16))) unsigned char lds_raw[];
    LAS unsigned char* lds = (LAS unsigned char*)lds_raw;
    volatile LAS unsigned* MISC = (volatile LAS unsigned*)(lds + MISC_OFF);
    const int tid = threadIdx.x; const int wave = __builtin_amdgcn_readfirstlane(tid >> 6);
    const int G = gridDim.x; const int bx = blockIdx.x; const int vcu = (G % 8 == 0) ? (bx % 8) * (G / 8) + bx / 8 : bx;
    unsigned char* ws = args.ws; float* out = args.out;
    In in;
    in.x = args.in[0]; in.c = args.in[1]; in.w_ada = args.in[2]; in.b_ada = args.in[3]; in.g_pre_mix = args.in[4]; in.g_post_mix = args.in[5]; in.g_pre_ffn = args.in[6]; in.g_post_ffn = args.in[7];
    in.w_in = args.in[8]; in.b_forget = args.in[9]; in.w_conv = args.in[10]; in.b_conv = args.in[11]; in.w_rg = args.in[12]; in.b_rg = args.in[13]; in.w_ig = args.in[14]; in.b_ig = args.in[15]; in.lam = args.in[16];
    in.w_ba = args.in[17]; in.w_br = args.in[18]; in.w_out = args.in[19]; in.w_router = args.in[20]; in.r_bias = args.in[21]; in.w_eg = args.in[22]; in.w_eu = args.in[23]; in.w_ed = args.in[24];
    in.w_sg = args.in[25]; in.w_su = args.in[26]; in.w_sd = args.in[27];
    for (int u = tid; u < 256; u += NWAVES * 64) ((LAS unsigned*)(lds + LDSCTL_OFF))[u] = 0u;
    __syncthreads();
    const int lo = args.ph_lo, hi = args.ph_hi;
    XcdBarrier bar; bar.bar = (unsigned*)(ws + WS_CTL) + CW_BAR; bar.x = 0; bar.st = nullptr;
    if (hi - lo > 1) bar = xcd_barrier_post((unsigned*)(ws + WS_CTL) + CW_BAR + args.li * XCD_BAR_WORDS, MISC + 8);
#ifndef PHASE_MASK
#define PHASE_MASK 0xFFFF
#endif
#define IN(k) (((PHASE_MASK >> (k)) & 1) && lo <= (k) && (k) < hi)
#define SEAM(k) do { if (IN(k) && IN((k) + 1)) xcd_barrier(bar); } while (0)

#ifndef DUP_MASK
#define DUP_MASK 0
#endif
#ifndef DRY_STORE
#define DRY_STORE 0
#endif
    const bool never = (args.pad == 12345);
#define REP(k, ...) do { if ((DUP_MASK >> (k)) & 1) { const bool st = never; __VA_ARGS__ } { const bool st = true; __VA_ARGS__ } } while (0)
    if (IN(PH_PRO)) { REP(PH_PRO, { (void)st; p0_prologue(in, ws, lds, vcu, G); __syncthreads(); }); }
    SEAM(PH_PRO);
    if (IN(PH_NORM1)) { REP(PH_NORM1, { (void)st; for (int tile = vcu; tile < 256; tile += G) p1_norm(tile, in, ws, lds); }); }
    SEAM(PH_NORM1);
    if (IN(PH_INPROJ)) { REP(PH_INPROJ, {
        DenseSchedT<256, 22> S; S.init(T, NIN, G, bx, ws + R_H, 512, ws + WS_WIN, 512);
        EpiInProj E{(bf16_t*)(ws + R_QKV), (bf16_t*)(ws + R_GT), st || DRY_STORE};
#ifdef STAGGER_TICKS
        { const unsigned long long t0 = __builtin_amdgcn_s_memrealtime(); const unsigned long long dl = (unsigned long long)(bx & 15) * STAGGER_TICKS;
          while (__builtin_amdgcn_s_memrealtime() - t0 < dl) __builtin_amdgcn_s_sleep(8); }
#endif
        __syncthreads();
#ifndef DRY_K
#define DRY_K 1024
#endif
        int Kp = st ? 512 : DRY_K; asm volatile("" : "+s"(Kp));
        pg8::gemm_phase<EpiInProj, DenseSchedT<256, 22>, false>(lds, Kp, 512, 512, S, E, nullptr); });
    }
    SEAM(PH_INPROJ);
    if (IN(PH_MIX)) {
        REP(13, { for (int u = vcu; u < NBATCH * NHEAD; u += G) { __syncthreads(); ATT_NS::attn_bh(u >> 3, u & 7, (bf16_t*)(ws + R_QKV), (const float*)(ws + WS_LCUM), (const float*)(ws + WS_TOT), lds, st); } });
        REP(14, { for (int u = vcu; u < NBATCH * 16; u += G) rnn::rnn_unit(u >> 4, u & 15, (bf16_t*)(ws + R_QKV) + 1536, (const bf16_t*)(ws + WS_WRNN), in.w_conv, in.b_conv, in.b_rg, in.b_ig, in.lam, lds, st); });
    }
    SEAM(PH_MIX);
    if (IN(PH_BRANCH)) { REP(PH_BRANCH, { (void)st;
        bf16_t* qx = (bf16_t*)(ws + R_QKV);
        BranchSched S; S.d.init(T, 1024, G, bx, qx, QXP, ws + WS_WBA, 1536);
        EpiBranchF E{(const bf16_t*)(ws + R_GT), (const bf16_t*)(ws + R_GT) + 1024, 2048, qx + 512, QXP};
        __syncthreads();
        pg8::gemm_phase<EpiBranchF, BranchSched, false>(lds, 512, QXP, 1536, S, E, nullptr); });
    }
    SEAM(PH_BRANCH);
    if (IN(PH_OUT)) { REP(PH_OUT, { (void)st;
        DenseSchedT<256, 4> S; S.init(T, 1024, G, bx, (bf16_t*)(ws + R_QKV) + 512, QXP, ws + WS_WOUT, 1024);
        EpiOut E{(bf16_t*)(ws + R_H), (float*)(ws + WS_SSQ)};
        __syncthreads();
        pg8::gemm_phase<EpiOut, DenseSchedT<256, 4>, false>(lds, 1024, QXP, 1024, S, E, nullptr); });
    }
    SEAM(PH_OUT);
    if (IN(PH_TOK2)) { REP(PH_TOK2, { for (int tile = vcu; tile < 256; tile += G) p6::run(tile, in, out, ws, lds, st); }); }
    SEAM(PH_TOK2);
    if (IN(PH_PLACE)) { REP(PH_PLACE, { (void)st; for (int tile = vcu; tile < 256; tile += G) p7_place(tile, ws, lds); }); }
    SEAM(PH_PLACE);
    if (IN(PH_GU)) { REP(PH_GU, { (void)st; moe_gateup(ws, lds, vcu, G); }); }
    SEAM(PH_GU);
    if (IN(PH_DN)) { REP(PH_DN, { moe_down(ws, lds, vcu, G, st || DRY_STORE); }); }
    SEAM(PH_DN);
    if (IN(PH_CMB)) { REP(PH_CMB, { combine_all(in, out, ws, vcu * NWAVES + wave, G * NWAVES, st); }); }
#ifdef GEMM_STAMP
    xcd_barrier(bar);
    if (blockIdx.x == GEMM_STAMP_BLOCK) {
        const float n = (float)g_dbg[4]; const float cyc2us = 1.0f / 2100.0f;
        const float vals[6] = {(float)g_dbg[0] / n * cyc2us, (float)g_dbg[1] / n * cyc2us, (float)g_dbg[2] / n * cyc2us, (float)g_dbg[3] / n * cyc2us, n, (float)g_dbg[5] * cyc2us};
        const float A = floorf(vals[STAMP_A] + 0.5f) * 100.0f, B = floorf(vals[STAMP_B] + 0.5f);
        if (tid == 0) out[0] += A;
        for (int i = 1 + tid; i <= (1 << 20); i += 512) out[i] += B;
    }
#endif
#undef IN
#undef SEAM
}

extern "C" void kernel_launch(void* const* d_in, const int* in_sizes, int n_in, void* d_out, int out_size, void* d_ws, size_t ws_size, hipStream_t stream) {
    static int grid = 0;
    if (grid == 0) {
        if (n_in != 28 || in_sizes[0] != T * D || out_size != T * D || ws_size < WS_END) { fprintf(stderr, "kernel_launch: unexpected shapes / workspace (n_in %d, ws %zu)\n", n_in, ws_size); grid = -1; return; }
        int dev = 0, cus = 0, per_cu = 0;
        if (hipGetDevice(&dev) != hipSuccess || hipDeviceGetAttribute(&cus, hipDeviceAttributeMultiprocessorCount, dev) != hipSuccess) { grid = -1; return; }
        if (hipFuncSetAttribute((const void*)hybrid_fwd, hipFuncAttributeMaxDynamicSharedMemorySize, LDS_BYTES) != hipSuccess) { fprintf(stderr, "kernel_launch: hipFuncSetAttribute failed\n"); grid = -1; return; }
        if (hipOccupancyMaxActiveBlocksPerMultiprocessor(&per_cu, (const void*)hybrid_fwd, NWAVES * 64, LDS_BYTES) != hipSuccess || per_cu < 1) { fprintf(stderr, "kernel_launch: occupancy query says %d\n", per_cu); per_cu = 1; }
        (void)hipGetLastError();
        grid = cus;
    }
    if (grid < 0) return;
    (void)hipMemsetAsync((char*)d_ws + WS_CTL, 0, CTL_ZERO_BYTES, stream);
    Args a{};
    for (int i = 0; i < 28; ++i) a.in[i] = (const float*)d_in[i];
    a.out = (float*)d_out; a.ws = (unsigned char*)d_ws;
#if MK_N_LAUNCHES == 1
    a.ph_lo = 0; a.ph_hi = NPHASE; a.li = 0;
    void* kargs[] = {&a};
    hipError_t e = hipLaunchCooperativeKernel((const void*)hybrid_fwd, dim3(grid), dim3(NWAVES * 64), kargs, LDS_BYTES, stream);
    if (e != hipSuccess) fprintf(stderr, "kernel_launch: cooperative launch failed: %s (grid %d)\n", hipGetErrorString(e), grid);
#else
    for (int li = 0; li < NPHASE; ++li) { a.ph_lo = li; a.ph_hi = li + 1; a.li = li;
        hipLaunchKernelGGL(hybrid_fwd, dim3(grid), dim3(NWAVES * 64), LDS_BYTES, stream, a); }
#endif
}
```
